# Optimizing an MI355X kernel written in HIP

```python
import jax, jax.numpy as jnp
from jax import lax
import numpy as np

D_MODEL = 1024
BATCH = 16
SEQ = 2048
DEPTH = 1

D_PLE = 256
D_CONV = 512
CONV_WIDTH = 31
N_HEADS = 8
HEAD_DIM = 64
D_ATTN = N_HEADS * HEAD_DIM
D_KV = HEAD_DIM
N_IDX_HEADS = 8
IDX_DIM = 64
TOPK_MAX = 256
Q_BLOCK = 128
EPS = 1e-6

COL_SIZES = (
    ("conv_in", 2 * D_CONV),
    ("conv_z", D_CONV),
    ("q", D_ATTN),
    ("k", D_KV),
    ("v", D_KV),
    ("attn_z", D_ATTN),
    ("idx_q", N_IDX_HEADS * IDX_DIM),
    ("idx_k", IDX_DIM),
    ("idx_w", N_IDX_HEADS),
    ("gate_a", D_MODEL),
    ("gate_b", D_MODEL),
)
D_IN_TOTAL = 2 * D_CONV + D_CONV + D_ATTN + 2 * D_KV + D_ATTN + N_IDX_HEADS * IDX_DIM + IDX_DIM + N_IDX_HEADS + 2 * D_MODEL

kernel_name = "hybrid_conformer_dsa_gated_block"


def rms_norm(x, g):
    xf = x.astype(jnp.float32)
    y = xf * lax.rsqrt(jnp.mean(xf * xf, axis=-1, keepdims=True) + EPS) * g.astype(jnp.float32)
    return y.astype(x.dtype)


def layer_norm(x, g, b):
    xf = x.astype(jnp.float32)
    mu = jnp.mean(xf, axis=-1, keepdims=True)
    var = jnp.mean(jnp.square(xf - mu), axis=-1, keepdims=True)
    y = (xf - mu) * lax.rsqrt(var + EPS) * g.astype(jnp.float32) + b.astype(jnp.float32)
    return y.astype(x.dtype)


def split_cols(u):
    out, off = {}, 0
    for name, size in COL_SIZES:
        out[name] = u[..., off:off + size]
        off += size
    return out


def causal_depthwise_conv(u, w, b):
    C = u.shape[-1]
    y = lax.conv_general_dilated(
        u.astype(w.dtype), w.reshape(CONV_WIDTH, 1, C),
        window_strides=(1,), padding=[(CONV_WIDTH - 1, 0)],
        dimension_numbers=("NWC", "WIO", "NWC"), feature_group_count=C)
    return y + b


def conformer_branch(cols, conv_w, conv_b, ln_g, ln_b):
    val, gate = jnp.split(cols["conv_in"], 2, axis=-1)
    u = val * jax.nn.sigmoid(gate)
    c = causal_depthwise_conv(u, conv_w, conv_b)
    c = jax.nn.silu(layer_norm(c, ln_g, ln_b))
    return c * jax.nn.silu(cols["conv_z"])


def dsa_sparse_attention(q, k, v, q_idx, k_idx, w_idx):
    B, L = q.shape[0], q.shape[1]
    n_keep = min(TOPK_MAX, L // 4)
    nb = L // Q_BLOCK
    slopes = 2.0 ** (-8.0 * jnp.arange(1, N_HEADS + 1, dtype=jnp.float32) / N_HEADS)
    key_pos = jnp.arange(L, dtype=jnp.int32)

    def to_blocks(a):
        return jnp.moveaxis(a.reshape((B, nb, Q_BLOCK) + a.shape[2:]), 1, 0)

    def block(args):
        qb, qib, wb, t0 = args
        tq = t0 + jnp.arange(Q_BLOCK, dtype=jnp.int32)
        dots = jnp.einsum("bqhd,bsd->bqhs", qib, k_idx).astype(jnp.float32) * (IDX_DIM ** -0.5)
        w_f = wb.astype(jnp.float32) * (N_IDX_HEADS ** -0.5)
        score = jnp.einsum("bqh,bqhs->bqs", w_f, jax.nn.relu(dots))
        causal = key_pos[None, :] <= tq[:, None]
        score = jnp.where(causal[None], score, -jnp.inf)
        _, sel = lax.top_k(score, n_keep)
        gather = jax.vmap(lambda kv_b, idx_b: kv_b[idx_b])
        k_sel = gather(k, sel)
        v_sel = gather(v, sel)
        logits = jnp.einsum("bqhd,bqkd->bqhk", qb, k_sel).astype(jnp.float32) * (HEAD_DIM ** -0.5)
        dist = (tq[None, :, None] - sel).astype(jnp.float32)
        logits = logits - slopes[None, None, :, None] * dist[:, :, None, :]
        valid = sel <= tq[None, :, None]
        logits = jnp.where(valid[:, :, None, :], logits, -jnp.inf)
        probs = jax.nn.softmax(logits, axis=-1)
        o = jnp.einsum("bqhk,bqkd->bqhd", probs, v_sel.astype(jnp.float32))
        return o.astype(qb.dtype)

    t0s = jnp.arange(nb, dtype=jnp.int32) * Q_BLOCK
    out = lax.map(block, (to_blocks(q), to_blocks(q_idx), to_blocks(w_idx), t0s))
    return jnp.moveaxis(out, 0, 1).reshape(B, L, N_HEADS * HEAD_DIM)


def attention_branch(cols):
    B, L = cols["q"].shape[0], cols["q"].shape[1]
    q = cols["q"].reshape(B, L, N_HEADS, HEAD_DIM)
    q_idx = cols["idx_q"].reshape(B, L, N_IDX_HEADS, IDX_DIM)
    o = dsa_sparse_attention(q, cols["k"], cols["v"], q_idx, cols["idx_k"], cols["idx_w"])
    return o * jax.nn.silu(cols["attn_z"])


def setup_inputs(seed: int = 0) -> dict:
    key = jax.random.key(seed)
    ks = jax.random.split(key, 16)
    f32 = jnp.float32
    nrm = lambda k, shape, scale: jax.random.normal(k, shape, f32) * scale
    return {
        "x": nrm(ks[0], (BATCH, SEQ, D_MODEL), 1.0),
        "p": nrm(ks[1], (DEPTH, BATCH, SEQ, D_PLE), 1.0),
        "norm_g": 1.0 + nrm(ks[2], (DEPTH, D_MODEL), 0.02),
        "w_in": nrm(ks[3], (DEPTH, D_MODEL, D_IN_TOTAL), D_MODEL ** -0.5),
        "conv_w": nrm(ks[4], (DEPTH, CONV_WIDTH, D_CONV), CONV_WIDTH ** -0.5),
        "conv_b": nrm(ks[5], (DEPTH, D_CONV), 0.01),
        "conv_ln_g": 1.0 + nrm(ks[6], (DEPTH, D_CONV), 0.02),
        "conv_ln_b": nrm(ks[7], (DEPTH, D_CONV), 0.01),
        "w_a_out": nrm(ks[8], (DEPTH, D_CONV, D_MODEL), D_CONV ** -0.5),
        "w_b_out": nrm(ks[9], (DEPTH, D_ATTN, D_MODEL), D_ATTN ** -0.5),
        "w_o": nrm(ks[10], (DEPTH, D_MODEL, D_MODEL), D_MODEL ** -0.5),
        "ple_norm_g": 1.0 + nrm(ks[11], (DEPTH, D_MODEL), 0.02),
        "w_ple_gate": nrm(ks[12], (DEPTH, D_MODEL, D_MODEL), D_MODEL ** -0.5),
        "w_ple_proj": nrm(ks[13], (DEPTH, D_PLE, D_MODEL), D_PLE ** -0.5),
        "final_g": 1.0 + nrm(ks[14], (D_MODEL,), 0.02),
    }


def reference(x, p, norm_g, w_in, conv_w, conv_b, conv_ln_g, conv_ln_b, w_a_out, w_b_out,
              w_o, ple_norm_g, w_ple_gate, w_ple_proj, final_g):
    for i in range(DEPTH):
        h = rms_norm(x, norm_g[i])
        cols = split_cols(jnp.einsum("bld,de->ble", h, w_in[i]))
        y_a = conformer_branch(cols, conv_w[i], conv_b[i], conv_ln_g[i], conv_ln_b[i])
        y_b = attention_branch(cols)
        merged = (jax.nn.sigmoid(cols["gate_a"]) * jnp.einsum("blc,cd->bld", y_a, w_a_out[i])
                  + jax.nn.sigmoid(cols["gate_b"]) * jnp.einsum("blc,cd->bld", y_b, w_b_out[i]))
        x = x + jnp.einsum("bld,de->ble", merged, w_o[i])
        ple_gate = jax.nn.sigmoid(jnp.einsum("bld,de->ble", rms_norm(x, ple_norm_g[i]), w_ple_gate[i]))
        x = x + ple_gate * jnp.einsum("blp,pd->bld", p[i], w_ple_proj[i])
    return rms_norm(x, final_g)
```

```cpp
#include <hip/hip_runtime.h>
#include <cstdint>
#include <cstdio>

typedef unsigned short bf16_t;
typedef float f32x4 __attribute__((ext_vector_type(4)));
typedef unsigned u32x4 __attribute__((ext_vector_type(4)));
typedef unsigned u32x2 __attribute__((ext_vector_type(2)));

constexpr int NB = 16, SEQ = 2048, D = 1024, M = NB * SEQ;
constexpr int DPLE = 256, DC = 512, CWID = 31, NH = 8, HD = 64, TOPK = 256;
constexpr int NIN = 5320, NINP = 5376;
constexpr float EPS = 1e-6f;

constexpr size_t MiB = 1u << 20;
constexpr size_t WS_CTL = 0;
constexpr size_t WS_WIN = 2 * MiB;
constexpr size_t WS_WA = 13 * MiB;
constexpr size_t WS_WB = 14 * MiB;
constexpr size_t WS_WO = 15 * MiB;
constexpr size_t WS_WG = 17 * MiB;
constexpr size_t WS_WP = 19 * MiB;
constexpr size_t WS_RINV = 20 * MiB;
constexpr size_t WS_XB = 32 * MiB;
constexpr size_t WS_YA = 32 * MiB, WS_YB = 64 * MiB;
constexpr size_t WS_PB = 96 * MiB;
constexpr size_t WS_CIN = 112 * MiB;
constexpr size_t WS_MRG = 112 * MiB;
constexpr size_t WS_CZ = 176 * MiB;
constexpr size_t WS_Q = 208 * MiB;
constexpr size_t WS_X1B = 176 * MiB;
constexpr size_t WS_AZ = 240 * MiB;
constexpr size_t WS_IQ = 272 * MiB;
constexpr size_t WS_SM = 304 * MiB;
constexpr size_t WS_GA = 320 * MiB;
constexpr size_t WS_PP = 320 * MiB;
constexpr size_t WS_GB = 384 * MiB;
constexpr size_t WS_END = 448 * MiB;
constexpr size_t CTL_SS1 = 0;
constexpr size_t CTL_SS2 = 256 * 1024;

__device__ __forceinline__ float bf2f(bf16_t h) { return __uint_as_float(((unsigned)h) << 16); }
__device__ __forceinline__ bf16_t f2bf(float f) { unsigned u = __float_as_uint(f); return (bf16_t)((u + 0x7fffu + ((u >> 16) & 1u)) >> 16); }
__device__ __forceinline__ unsigned pk2(float lo, float hi) { return (unsigned)f2bf(lo) | ((unsigned)f2bf(hi) << 16); }
__device__ __forceinline__ float sigmoidf_(float x) { return 1.f / (1.f + __expf(-x)); }
__device__ __forceinline__ float siluf_(float x) { return x * sigmoidf_(x); }
__device__ __forceinline__ float wave_sum(float v) {
#pragma unroll
    for (int o = 1; o < 64; o <<= 1) v += __shfl_xor(v, o);
    return v;
}

__host__ __device__ __forceinline__ int inmap(int n) {
    if (n < 2048) return n;
    if (n < 2560) return 2176 + (n - 2048);
    if (n < 3072) return 2688 + (n - 2560);
    if (n < 3328) { const int j = n - 3072;
        if (j < 64) return 2048 + j; if (j < 128) return 2112 + (j - 64); if (j < 192) return 3200 + (j - 128); if (j < 200) return 3264 + (j - 192); return -1; }
    if (n < 4352) return 3272 + (n - 3328);
    return 4296 + (n - 4352);
}

template <bool MAP>
__global__ void __launch_bounds__(256) k_prep_w(const float* __restrict__ W, const float* __restrict__ gain, bf16_t* __restrict__ Wt, int K, int Nsrc, int Ndst) {
    __shared__ float tile[32][33];
    const int n0 = blockIdx.x * 32, k0 = blockIdx.y * 32, tx = threadIdx.x & 31, ty = threadIdx.x >> 5;
#pragma unroll
    for (int i = 0; i < 4; ++i) { const int k = k0 + ty + 8 * i; const int n = n0 + tx; const int e = MAP ? inmap(n) : n;
        float v = 0.f; if (e >= 0 && e < Nsrc) v = W[(size_t)k * Nsrc + e] * (gain ? gain[k] : 1.f);
        tile[ty + 8 * i][tx] = v; }
    __syncthreads();
#pragma unroll
    for (int i = 0; i < 4; ++i) { const int n = n0 + ty + 8 * i; Wt[(size_t)n * K + k0 + tx] = f2bf(tile[tx][ty + 8 * i]); }
}

__global__ void __launch_bounds__(512) k_prep_x(const float* __restrict__ x, const float* __restrict__ p, bf16_t* __restrict__ xb, bf16_t* __restrict__ pb, float* __restrict__ rinv, float* __restrict__ ss1, float* __restrict__ ss2) {
    const int lane = threadIdx.x & 63, gw = blockIdx.x * 8 + (threadIdx.x >> 6), ngw = gridDim.x * 8;
    for (int m = gw; m < M; m += ngw) {
        const f32x4* xr = (const f32x4*)(x + (size_t)m * D) + lane; f32x4 v[4]; float s = 0.f;
#pragma unroll
        for (int j = 0; j < 4; ++j) { v[j] = xr[64 * j]; s += (v[j].x * v[j].x + v[j].y * v[j].y) + (v[j].z * v[j].z + v[j].w * v[j].w); }
        s = wave_sum(s);
        if (lane == 0) { rinv[m] = rsqrtf(s * (1.f / D) + EPS); ss1[m] = 0.f; ss2[m] = 0.f; }
        u32x2* o = (u32x2*)(xb + (size_t)m * D) + lane;
#pragma unroll
        for (int j = 0; j < 4; ++j) { u32x2 w; w.x = pk2(v[j].x, v[j].y); w.y = pk2(v[j].z, v[j].w); o[64 * j] = w; }
        const f32x4 pv = ((const f32x4*)(p + (size_t)m * DPLE))[lane];
        u32x2 w; w.x = pk2(pv.x, pv.y); w.y = pk2(pv.z, pv.w); ((u32x2*)(pb + (size_t)m * DPLE))[lane] = w;
    }
}

template <class Epi>
__global__ void __launch_bounds__(256) k_gemm(const bf16_t* __restrict__ A, const bf16_t* __restrict__ Bt, int K, Epi E) {
    __shared__ float As[64][33], Bs[64][33];
    const int tid = threadIdx.x, tx = tid & 15, ty = tid >> 4, m0 = blockIdx.y * 64, n0 = blockIdx.x * 64;
    float acc[4][4];
#pragma unroll
    for (int i = 0; i < 4; ++i)
#pragma unroll
        for (int j = 0; j < 4; ++j) acc[i][j] = 0.f;
    const int lr = tid >> 2, lc = (tid & 3) * 8;
    for (int k0 = 0; k0 < K; k0 += 32) {
        const u32x4 av = *(const u32x4*)(A + (size_t)(m0 + lr) * K + k0 + lc), bv = *(const u32x4*)(Bt + (size_t)(n0 + lr) * K + k0 + lc);
        const unsigned aw[4] = {av.x, av.y, av.z, av.w}, bw[4] = {bv.x, bv.y, bv.z, bv.w};
#pragma unroll
        for (int i = 0; i < 4; ++i) { As[lr][lc + 2 * i] = __uint_as_float(aw[i] << 16); As[lr][lc + 2 * i + 1] = __uint_as_float(aw[i] & 0xffff0000u);
                                      Bs[lr][lc + 2 * i] = __uint_as_float(bw[i] << 16); Bs[lr][lc + 2 * i + 1] = __uint_as_float(bw[i] & 0xffff0000u); }
        __syncthreads();
#pragma unroll 8
        for (int kk = 0; kk < 32; ++kk) { float a[4], b[4];
#pragma unroll
            for (int i = 0; i < 4; ++i) { a[i] = As[ty * 4 + i][kk]; b[i] = Bs[tx * 4 + i][kk]; }
#pragma unroll
            for (int i = 0; i < 4; ++i)
#pragma unroll
                for (int j = 0; j < 4; ++j) acc[i][j] = fmaf(a[i], b[j], acc[i][j]); }
        __syncthreads();
    }
#pragma unroll
    for (int i = 0; i < 4; ++i)
#pragma unroll
        for (int j = 0; j < 4; ++j) E(m0 + ty * 4 + i, n0 + tx * 4 + j, acc[i][j]);
}

struct EpiInProj {
    const float* rinv; unsigned char* ws;
    __device__ __forceinline__ void operator()(int m, int n, float acc) const {
        const float v = acc * rinv[m]; bf16_t* dst; int ld, c;
        if (n < 1024) { dst = (bf16_t*)(ws + WS_CIN); ld = 1024; c = n; }
        else if (n < 1536) { dst = (bf16_t*)(ws + WS_CZ); ld = 512; c = n - 1024; }
        else if (n < 2048) { dst = (bf16_t*)(ws + WS_Q); ld = 512; c = n - 1536; }
        else if (n < 2560) { dst = (bf16_t*)(ws + WS_AZ); ld = 512; c = n - 2048; }
        else if (n < 3072) { dst = (bf16_t*)(ws + WS_IQ); ld = 512; c = n - 2560; }
        else if (n < 3328) { dst = (bf16_t*)(ws + WS_SM); ld = 256; c = n - 3072; }
        else if (n < 4352) { dst = (bf16_t*)(ws + WS_GA); ld = 1024; c = n - 3328; }
        else { dst = (bf16_t*)(ws + WS_GB); ld = 1024; c = n - 4352; }
        dst[(size_t)m * ld + c] = f2bf(v);
    }
};
struct EpiOutA {
    const bf16_t* ga; float* part;
    __device__ __forceinline__ void operator()(int m, int n, float acc) const { part[(size_t)m * D + n] = sigmoidf_(bf2f(ga[(size_t)m * D + n])) * acc; }
};
struct EpiOutB {
    const bf16_t* gb; const float* part; bf16_t* mrg;
    __device__ __forceinline__ void operator()(int m, int n, float acc) const { const size_t i = (size_t)m * D + n; mrg[i] = f2bf(part[i] + sigmoidf_(bf2f(gb[i])) * acc); }
};
struct EpiWo {
    const float* x; float* out; bf16_t* x1b; float* ss1;
    __device__ __forceinline__ void operator()(int m, int n, float acc) const { const size_t i = (size_t)m * D + n; const float v = x[i] + acc; out[i] = v; x1b[i] = f2bf(v); atomicAdd(ss1 + m, v * v); }
};
struct EpiPP {
    bf16_t* pp;
    __device__ __forceinline__ void operator()(int m, int n, float acc) const { pp[(size_t)m * D + n] = f2bf(acc); }
};
struct EpiGate {
    float* out; const bf16_t* pp; const float* ss1; float* ss2;
    __device__ __forceinline__ void operator()(int m, int n, float acc) const { const size_t i = (size_t)m * D + n; const float r1 = rsqrtf(ss1[m] * (1.f / D) + EPS);
        const float v = out[i] + sigmoidf_(r1 * acc) * bf2f(pp[i]); out[i] = v; atomicAdd(ss2 + m, v * v); }
};

constexpr int CF_TOK = 128, CF_CH = 16;
__global__ void __launch_bounds__(512) k_conformer(const bf16_t* __restrict__ cin, const bf16_t* __restrict__ cz, const float* __restrict__ conv_w, const float* __restrict__ conv_b,
                                                   const float* __restrict__ ln_g, const float* __restrict__ ln_b, bf16_t* __restrict__ ya) {
    __shared__ float red[8][2 * CF_CH];
    const int ch = threadIdx.x, lane = ch & 63, wv = ch >> 6;
    float w[CWID];
#pragma unroll
    for (int j = 0; j < CWID; ++j) w[j] = conv_w[j * DC + ch];
    const float cb = conv_b[ch], g = ln_g[ch], bb = ln_b[ch];
    for (int item = blockIdx.x; item < M / CF_TOK; item += gridDim.x) {
        const int b = item / (SEQ / CF_TOK), t0 = (item % (SEQ / CF_TOK)) * CF_TOK; const size_t rowb = (size_t)b * SEQ;
        float u[CF_CH + CWID - 1];
#pragma unroll
        for (int i = 0; i < CWID - 1; ++i) { const int t = t0 - (CWID - 1) + i; float v = 0.f;
            if (t >= 0) { const float a = bf2f(cin[(rowb + t) * 1024 + ch]), gt = bf2f(cin[(rowb + t) * 1024 + 512 + ch]); v = a * sigmoidf_(gt); }
            u[i] = v; }
        for (int tc = t0; tc < t0 + CF_TOK; tc += CF_CH) {
#pragma unroll
            for (int i = 0; i < CF_CH; ++i) { const size_t r = (rowb + tc + i) * 1024; const float a = bf2f(cin[r + ch]), gt = bf2f(cin[r + 512 + ch]); u[CWID - 1 + i] = a * sigmoidf_(gt); }
            float c[CF_CH];
#pragma unroll
            for (int i = 0; i < CF_CH; ++i) { float s = cb;
#pragma unroll
                for (int j = 0; j < CWID; ++j) s = fmaf(w[j], u[i + j], s);
                c[i] = s; }
#pragma unroll
            for (int i = 0; i < CF_CH; ++i) { const float s1 = wave_sum(c[i]), s2 = wave_sum(c[i] * c[i]); if (lane == 0) { red[wv][2 * i] = s1; red[wv][2 * i + 1] = s2; } }
            __syncthreads();
#pragma unroll
            for (int i = 0; i < CF_CH; ++i) { float s1 = 0.f, s2 = 0.f;
#pragma unroll
                for (int q = 0; q < 8; ++q) { s1 += red[q][2 * i]; s2 += red[q][2 * i + 1]; }
                const float mu = s1 * (1.f / DC), var = fmaxf(s2 * (1.f / DC) - mu * mu, 0.f), rs = rsqrtf(var + EPS);
                const float y = (c[i] - mu) * rs * g + bb; const float z = bf2f(cz[(rowb + tc + i) * DC + ch]);
                ya[(rowb + tc + i) * DC + ch] = f2bf(siluf_(y) * siluf_(z)); }
            __syncthreads();
#pragma unroll
            for (int i = 0; i < CWID - 1; ++i) u[i] = u[i + CF_CH];
        }
    }
}

__device__ __forceinline__ unsigned sortkey(float f) { const unsigned u = __float_as_uint(f + 0.f); return (u & 0x80000000u) ? ~u : (u | 0x80000000u); }
__global__ void __launch_bounds__(256) k_attn_naive(const bf16_t* __restrict__ qb, const bf16_t* __restrict__ iq, const bf16_t* __restrict__ sm, const bf16_t* __restrict__ az, bf16_t* __restrict__ yb) {
    __shared__ float qi[8][64], qq[8][64], wi[8];
    __shared__ unsigned keys[SEQ];
    __shared__ int sel[TOPK];
    __shared__ float pr[8][TOPK];
    __shared__ int cnts[8];
    __shared__ int nsel_s, base_s;
    const int tid = threadIdx.x, lane = tid & 63, wv = tid >> 6;
    const int m = blockIdx.x, b = m / SEQ, t = m % SEQ, n = t + 1; const size_t rowb = (size_t)b * SEQ;
    for (int i = tid; i < 512; i += 256) { qi[i >> 6][i & 63] = bf2f(iq[(size_t)m * 512 + i]); qq[i >> 6][i & 63] = bf2f(qb[(size_t)m * 512 + i]); }
    if (tid < 8) wi[tid] = bf2f(sm[(size_t)m * 256 + 192 + tid]) * 0.35355339059327373f;
    if (tid == 0) nsel_s = 0;
    __syncthreads();
    for (int s = tid; s < n; s += 256) {
        const bf16_t* kr = sm + (rowb + s) * 256 + 128; float kf[64];
#pragma unroll
        for (int c = 0; c < 8; ++c) { const u32x4 v = ((const u32x4*)kr)[c]; const unsigned wd[4] = {v.x, v.y, v.z, v.w};
#pragma unroll
            for (int e = 0; e < 4; ++e) { kf[c * 8 + 2 * e] = __uint_as_float(wd[e] << 16); kf[c * 8 + 2 * e + 1] = __uint_as_float(wd[e] & 0xffff0000u); } }
        float sc = 0.f;
#pragma unroll
        for (int h = 0; h < 8; ++h) { float d = 0.f;
#pragma unroll
            for (int e = 0; e < 64; ++e) d = fmaf(qi[h][e], kf[e], d);
            sc = fmaf(wi[h], fmaxf(d * 0.125f, 0.f), sc); }
        keys[s] = sortkey(sc);
    }
    __syncthreads();
    if (n <= TOPK) { for (int s = tid; s < n; s += 256) sel[s] = s; if (tid == 0) nsel_s = n; __syncthreads(); }
    else {
        unsigned prefix = 0u;
        for (int bit = 31; bit >= 0; --bit) { const unsigned cand = prefix | (1u << bit); int c = 0;
            for (int s = tid; s < n; s += 256) c += (keys[s] >= cand) ? 1 : 0;
            c = (int)wave_sum((float)c);
            if (lane == 0) cnts[wv] = c;
            __syncthreads();
            const int tot = cnts[0] + cnts[1] + cnts[2] + cnts[3];
            __syncthreads();
            if (tot >= TOPK) prefix = cand; }
        int c = 0; for (int s = tid; s < n; s += 256) c += (keys[s] > prefix) ? 1 : 0;
        c = (int)wave_sum((float)c); if (lane == 0) cnts[wv] = c; __syncthreads();
        const int ngt = cnts[0] + cnts[1] + cnts[2] + cnts[3]; const int need = TOPK - ngt;
        __syncthreads();
        if (tid == 0) base_s = 0;
        __syncthreads();
        for (int s0 = 0; s0 < n; s0 += 256) { const int s = s0 + tid; const bool in = s < n; const unsigned k = in ? keys[s] : 0u; const bool gt = in && k > prefix, eq = in && k == prefix;
            const unsigned long long be = __ballot(eq); const int rank_w = __popcll(be & ((1ull << lane) - 1ull));
            if (lane == 0) cnts[4 + wv] = __popcll(be);
            __syncthreads();
            int before = base_s; for (int q = 0; q < wv; ++q) before += cnts[4 + q];
            const bool take = gt || (eq && (before + rank_w) < need);
            if (take) { const int pos = atomicAdd(&nsel_s, 1); if (pos < TOPK) sel[pos] = s; }
            __syncthreads();
            if (tid == 0) base_s += cnts[4] + cnts[5] + cnts[6] + cnts[7];
            __syncthreads(); }
    }
    const int nsel = nsel_s < TOPK ? nsel_s : TOPK;
    { const int j = tid; float lg[8];
      if (j < nsel) { const int s = sel[j]; const bf16_t* kr = sm + (rowb + s) * 256; float kf[64];
#pragma unroll
          for (int c = 0; c < 8; ++c) { const u32x4 v = ((const u32x4*)kr)[c]; const unsigned wd[4] = {v.x, v.y, v.z, v.w};
#pragma unroll
              for (int e = 0; e < 4; ++e) { kf[c * 8 + 2 * e] = __uint_as_float(wd[e] << 16); kf[c * 8 + 2 * e + 1] = __uint_as_float(wd[e] & 0xffff0000u); } }
#pragma unroll
          for (int h = 0; h < 8; ++h) { float d = 0.f;
#pragma unroll
              for (int e = 0; e < 64; ++e) d = fmaf(qq[h][e], kf[e], d);
              lg[h] = d * 0.125f - exp2f(-(float)(h + 1)) * (float)(t - s); } }
      else {
#pragma unroll
          for (int h = 0; h < 8; ++h) lg[h] = -INFINITY; }
#pragma unroll
      for (int h = 0; h < 8; ++h) pr[h][j] = lg[h]; }
    __syncthreads();
#pragma unroll
    for (int hh = 0; hh < 2; ++hh) { const int h = 2 * wv + hh; float v[4]; float mx = -INFINITY;
#pragma unroll
        for (int i = 0; i < 4; ++i) { v[i] = pr[h][lane + 64 * i]; mx = fmaxf(mx, v[i]); }
#pragma unroll
        for (int o = 1; o < 64; o <<= 1) mx = fmaxf(mx, __shfl_xor(mx, o));
        float s = 0.f;
#pragma unroll
        for (int i = 0; i < 4; ++i) { v[i] = __expf(v[i] - mx); s += v[i]; }
        s = wave_sum(s); const float inv = 1.f / s;
#pragma unroll
        for (int i = 0; i < 4; ++i) pr[h][lane + 64 * i] = v[i] * inv; }
    __syncthreads();
    { const int h = tid >> 5, d = 2 * (tid & 31); float o0 = 0.f, o1 = 0.f;
      for (int j = 0; j < nsel; ++j) { const unsigned vv = *(const unsigned*)(sm + (rowb + sel[j]) * 256 + 64 + d); const float pj = pr[h][j];
          o0 = fmaf(pj, __uint_as_float(vv << 16), o0); o1 = fmaf(pj, __uint_as_float(vv & 0xffff0000u), o1); }
      const unsigned zz = *(const unsigned*)(az + (size_t)m * 512 + h * 64 + d);
      const float z0 = __uint_as_float(zz << 16), z1 = __uint_as_float(zz & 0xffff0000u);
      *(unsigned*)(yb + (size_t)m * 512 + h * 64 + d) = pk2(o0 * siluf_(z0), o1 * siluf_(z1)); }
}

__global__ void __launch_bounds__(512) k_final(float* __restrict__ out, const float* __restrict__ ss2, const float* __restrict__ fg) {
    const int lane = threadIdx.x & 63, gw = blockIdx.x * 8 + (threadIdx.x >> 6), ngw = gridDim.x * 8;
    for (int m = gw; m < M; m += ngw) { const float r = rsqrtf(ss2[m] * (1.f / D) + EPS); f32x4* o = (f32x4*)(out + (size_t)m * D) + lane;
#pragma unroll
        for (int j = 0; j < 4; ++j) { const f32x4 gv = ((const f32x4*)fg)[lane + 64 * j]; f32x4 v = o[64 * j]; v = v * r * gv; o[64 * j] = v; } }
}

extern "C" void kernel_launch(void* const* d_in, const int* in_sizes, int n_in, void* d_out, int out_size, void* d_ws, size_t ws_size, hipStream_t stream) {
    if (n_in != 15 || out_size != M * D || ws_size < WS_END) { fprintf(stderr, "kernel_launch: unexpected sizes n_in %d out %d ws %zu\n", n_in, out_size, ws_size); return; }
    const float* x = (const float*)d_in[0]; const float* p = (const float*)d_in[1]; const float* norm_g = (const float*)d_in[2]; const float* w_in = (const float*)d_in[3];
    const float* conv_w = (const float*)d_in[4]; const float* conv_b = (const float*)d_in[5]; const float* ln_g = (const float*)d_in[6]; const float* ln_b = (const float*)d_in[7];
    const float* w_a = (const float*)d_in[8]; const float* w_b = (const float*)d_in[9]; const float* w_o = (const float*)d_in[10]; const float* ple_g = (const float*)d_in[11];
    const float* w_pg = (const float*)d_in[12]; const float* w_pp = (const float*)d_in[13]; const float* fin_g = (const float*)d_in[14];
    unsigned char* ws = (unsigned char*)d_ws; float* out = (float*)d_out;
    bf16_t* Win = (bf16_t*)(ws + WS_WIN); bf16_t* Wa = (bf16_t*)(ws + WS_WA); bf16_t* Wb = (bf16_t*)(ws + WS_WB); bf16_t* Wo = (bf16_t*)(ws + WS_WO); bf16_t* Wg = (bf16_t*)(ws + WS_WG); bf16_t* Wp = (bf16_t*)(ws + WS_WP);
    float* rinv = (float*)(ws + WS_RINV); float* ss1 = (float*)(ws + WS_CTL + CTL_SS1); float* ss2 = (float*)(ws + WS_CTL + CTL_SS2);
    bf16_t* xb = (bf16_t*)(ws + WS_XB); bf16_t* pb = (bf16_t*)(ws + WS_PB);
    k_prep_w<true><<<dim3(NINP / 32, D / 32), 256, 0, stream>>>(w_in, norm_g, Win, D, NIN, NINP);
    k_prep_w<false><<<dim3(D / 32, DC / 32), 256, 0, stream>>>(w_a, nullptr, Wa, DC, D, D);
    k_prep_w<false><<<dim3(D / 32, DC / 32), 256, 0, stream>>>(w_b, nullptr, Wb, DC, D, D);
    k_prep_w<false><<<dim3(D / 32, D / 32), 256, 0, stream>>>(w_o, nullptr, Wo, D, D, D);
    k_prep_w<false><<<dim3(D / 32, D / 32), 256, 0, stream>>>(w_pg, ple_g, Wg, D, D, D);
    k_prep_w<false><<<dim3(D / 32, DPLE / 32), 256, 0, stream>>>(w_pp, nullptr, Wp, DPLE, D, D);
    k_prep_x<<<1024, 512, 0, stream>>>(x, p, xb, pb, rinv, ss1, ss2);
    k_gemm<EpiInProj><<<dim3(NINP / 64, M / 64), 256, 0, stream>>>(xb, Win, D, EpiInProj{rinv, ws});
    k_conformer<<<M / CF_TOK, 512, 0, stream>>>((const bf16_t*)(ws + WS_CIN), (const bf16_t*)(ws + WS_CZ), conv_w, conv_b, ln_g, ln_b, (bf16_t*)(ws + WS_YA));
    k_attn_naive<<<M, 256, 0, stream>>>((const bf16_t*)(ws + WS_Q), (const bf16_t*)(ws + WS_IQ), (const bf16_t*)(ws + WS_SM), (const bf16_t*)(ws + WS_AZ), (bf16_t*)(ws + WS_YB));
    k_gemm<EpiOutA><<<dim3(D / 64, M / 64), 256, 0, stream>>>((const bf16_t*)(ws + WS_YA), Wa, DC, EpiOutA{(const bf16_t*)(ws + WS_GA), out});
    k_gemm<EpiOutB><<<dim3(D / 64, M / 64), 256, 0, stream>>>((const bf16_t*)(ws + WS_YB), Wb, DC, EpiOutB{(const bf16_t*)(ws + WS_GB), out, (bf16_t*)(ws + WS_MRG)});
    k_gemm<EpiWo><<<dim3(D / 64, M / 64), 256, 0, stream>>>((const bf16_t*)(ws + WS_MRG), Wo, D, EpiWo{x, out, (bf16_t*)(ws + WS_X1B), ss1});
    k_gemm<EpiPP><<<dim3(D / 64, M / 64), 256, 0, stream>>>(pb, Wp, DPLE, EpiPP{(bf16_t*)(ws + WS_PP)});
    k_gemm<EpiGate><<<dim3(D / 64, M / 64), 256, 0, stream>>>((const bf16_t*)(ws + WS_X1B), Wg, D, EpiGate{out, (const bf16_t*)(ws + WS_PP), ss1, ss2});
    k_final<<<1024, 512, 0, stream>>>(out, ss2, fin_g);
}
```

```cpp
#include <hip/hip_runtime.h>
#include <cstdint>
#include <cstdio>

typedef unsigned short bf16_t;
typedef float f32x4 __attribute__((ext_vector_type(4)));
typedef unsigned u32x4 __attribute__((ext_vector_type(4)));
typedef unsigned u32x2 __attribute__((ext_vector_type(2)));
#define GAS __attribute__((address_space(1)))
#define LAS __attribute__((address_space(3)))
#define LDS_WAIT() asm volatile("s_waitcnt lgkmcnt(0)" ::: "memory")
#define VM_WAIT() asm volatile("s_waitcnt vmcnt(0)" ::: "memory")

constexpr int NB = 16, SEQ = 2048, D = 1024, M = NB * SEQ;
constexpr int DPLE = 256, DC = 512, CWID = 31, NH = 8, HD = 64, TOPK = 256;
constexpr int NIN = 5320, NINP = 5376;
constexpr float EPS = 1e-6f;

constexpr size_t MiB = 1u << 20;
constexpr size_t WS_CTL = 0;
constexpr size_t CTL_ZERO_BYTES = 64 * 1024;
constexpr int CW_BAR = 4096;
constexpr size_t WS_WIN = 2 * MiB;
constexpr size_t WS_WA = 13 * MiB;
constexpr size_t WS_WB = 14 * MiB;
constexpr size_t WS_WO = 15 * MiB;
constexpr size_t WS_WG = 17 * MiB;
constexpr size_t WS_WP = 19 * MiB;
constexpr size_t WS_RINV = 20 * MiB;
constexpr size_t WS_SSP1 = 22 * MiB;
constexpr size_t WS_SSP2 = 24 * MiB;
constexpr size_t WS_XB = 32 * MiB;
constexpr size_t WS_YA = 32 * MiB, WS_YB = 64 * MiB;
constexpr size_t WS_PB = 96 * MiB;
constexpr size_t WS_CIN = 112 * MiB;
constexpr size_t WS_MRG = 112 * MiB;
constexpr size_t WS_CZ = 176 * MiB;
constexpr size_t WS_Q = 208 * MiB;
constexpr size_t WS_X1B = 176 * MiB;
constexpr size_t WS_AZ = 240 * MiB;
constexpr size_t WS_IQ = 272 * MiB;
constexpr size_t WS_SM = 304 * MiB;
constexpr size_t WS_GA = 320 * MiB;
constexpr size_t WS_PP = 320 * MiB;
constexpr size_t WS_GB = 384 * MiB;
constexpr size_t WS_END = 448 * MiB;

__device__ __forceinline__ float bf2f(bf16_t h) { return __uint_as_float(((unsigned)h) << 16); }
__device__ __forceinline__ bf16_t f2bf(float f) { unsigned u = __float_as_uint(f); return (bf16_t)((u + 0x7fffu + ((u >> 16) & 1u)) >> 16); }
__device__ __forceinline__ unsigned pk2(float lo, float hi) { return (unsigned)f2bf(lo) | ((unsigned)f2bf(hi) << 16); }
__device__ __forceinline__ float bflo(unsigned w) { return __uint_as_float(w << 16); }
__device__ __forceinline__ float bfhi(unsigned w) { return __uint_as_float(w & 0xffff0000u); }
__device__ __forceinline__ float sigmoidf_(float x) { return 1.f / (1.f + __expf(-x)); }
__device__ __forceinline__ float siluf_(float x) { return x * sigmoidf_(x); }
__device__ __forceinline__ float wave_sum(float v) {
#pragma unroll
    for (int o = 1; o < 64; o <<= 1) v += __shfl_xor(v, o);
    return v;
}

__host__ __device__ __forceinline__ int inmap(int n) {
    if (n < 2048) return n;
    if (n < 2560) return 2176 + (n - 2048);
    if (n < 3072) return 2688 + (n - 2560);
    if (n < 3328) { const int j = n - 3072;
        if (j < 64) return 2048 + j; if (j < 128) return 2112 + (j - 64); if (j < 192) return 3200 + (j - 128); if (j < 200) return 3264 + (j - 192); return -1; }
    if (n < 4352) return 3272 + (n - 3328);
    return 4296 + (n - 4352);
}
namespace pg8 {
#define PG8_LAS __attribute__((address_space(3)))
typedef unsigned short bf16_t;
typedef short bf16x8 __attribute__((ext_vector_type(8)));
typedef float f32x4 __attribute__((ext_vector_type(4)));
typedef unsigned u32x4 __attribute__((ext_vector_type(4)));
constexpr int BM = 256, BK = 64, HALF = 128, HTB = HALF * BK * 2  , STAGE_BYTES = 8 * HTB, NXCD = 8, WGM = 8;

__host__ __device__ __forceinline__ int lds_byte(int r, int c) { const int st = (r >> 4) * 2 + (c >> 5), rr = r & 15, cc = c & 31, ob = rr * 64 + cc * 2; return st * 1024 + (ob ^ (((ob >> 9) & 1) << 5)); }
__host__ __device__ __forceinline__ void stage_rc(int b, int& R, int& C) { const int st = b / 1024, sb = b % 1024, swz = sb ^ (((sb >> 9) & 1) << 5); R = (st >> 1) * 16 + swz / 64; C = (st & 1) * 32 + (swz % 64) / 2; }
__host__ __device__ __forceinline__ int perm32(int rho) { const int n = rho >> 4, i = rho & 15; return 8 * (i >> 2) + 4 * n + (i & 3); }

struct Unit { int pm, pn; };
struct Gemm { const bf16_t* A; const bf16_t* Bt; int M, N, K; };

struct StaticOrder {
    int nM, nN, nwg, G, c;
    __host__ __device__ void init(int M, int N, int G_, int c_) { nM = M / BM; nN = N / BM; nwg = nM * nN; G = G_; c = c_; }
    __host__ __device__ bool next(int i, Unit& u) const {
        const long L = (long)i * G + c; if (L >= nwg) return false;
        int wgid = (int)L; { const int q = nwg / NXCD, r = nwg % NXCD, xcd = wgid % NXCD, off = wgid / NXCD; wgid = (xcd < r ? xcd * (q + 1) : r * (q + 1) + (xcd - r) * q) + off; }
        const int nig = WGM * nN, gid = wgid / nig, fm = gid * WGM, gsz = (nM - fm) < WGM ? (nM - fm) : WGM;
        u.pm = fm + ((wgid % nig) % gsz); u.pn = (wgid % nig) / gsz; return true;
    }
    __device__ __forceinline__ void a_ready(const Unit&) const {}
    __device__ __forceinline__ void done(const Unit&) const {}
};
__device__ __forceinline__ unsigned cvt_pk_bf16(float lo, float hi) { unsigned r; asm volatile("v_cvt_pk_bf16_f32 %0, %1, %2" : "=v"(r) : "v"(lo), "v"(hi)); return r; }
struct EpiInProj {
    static constexpr bool PERM = true, AFTER_DRAIN = false;
    const float* rinv; unsigned char* ws;
    __device__ __forceinline__ void operator()(const f32x4 (&acc)[2][2][4][2], const Unit& u, int wr, int wc, int fr, int fq) const {
        size_t off; int ld, colt; const int pn = u.pn;
        if (pn < 4) { off = WS_CIN; ld = 1024; colt = pn * 256; }
        else if (pn < 6) { off = WS_CZ; ld = 512; colt = (pn - 4) * 256; }
        else if (pn < 8) { off = WS_Q; ld = 512; colt = (pn - 6) * 256; }
        else if (pn < 10) { off = WS_AZ; ld = 512; colt = (pn - 8) * 256; }
        else if (pn < 12) { off = WS_IQ; ld = 512; colt = (pn - 10) * 256; }
        else if (pn < 13) { off = WS_SM; ld = 256; colt = 0; }
        else if (pn < 17) { off = WS_GA; ld = 1024; colt = (pn - 13) * 256; }
        else { off = WS_GB; ld = 1024; colt = (pn - 17) * 256; }
        bf16_t* base = (bf16_t*)(ws + off);
        const int row0 = u.pm * BM + wr * 64 + fr, col0 = colt + wc * 32 + 8 * fq;
#pragma unroll
        for (int ai = 0; ai < 2; ++ai)
#pragma unroll
            for (int m = 0; m < 4; ++m) { const int row = row0 + ai * HALF + m * 16; const float r = rinv[row]; bf16_t* rowp = base + (size_t)row * ld + col0;
#pragma unroll
                for (int bj = 0; bj < 2; ++bj) { const f32x4 v0 = acc[ai][bj][m][0] * r, v1 = acc[ai][bj][m][1] * r;
                    u32x4 w; w.x = cvt_pk_bf16(v0[0], v0[1]); w.y = cvt_pk_bf16(v0[2], v0[3]); w.z = cvt_pk_bf16(v1[0], v1[1]); w.w = cvt_pk_bf16(v1[2], v1[3]);
                    *(u32x4*)(rowp + bj * HALF) = w; } }
    }
};
__device__ __forceinline__ f32x4 sig4lo(unsigned a, unsigned b) { return (f32x4){sigmoidf_(bflo(a)), sigmoidf_(bfhi(a)), sigmoidf_(bflo(b)), sigmoidf_(bfhi(b))}; }
struct EpiOutA {
    static constexpr bool PERM = true, AFTER_DRAIN = false;
    const bf16_t* ga; float* part;
    __device__ __forceinline__ void operator()(const f32x4 (&acc)[2][2][4][2], const Unit& u, int wr, int wc, int fr, int fq) const {
        const int row0 = u.pm * BM + wr * 64 + fr, col0 = u.pn * BM + wc * 32 + 8 * fq;
#pragma unroll
        for (int ai = 0; ai < 2; ++ai)
#pragma unroll
            for (int m = 0; m < 4; ++m) { const size_t idx = (size_t)(row0 + ai * HALF + m * 16) * D + col0;
#pragma unroll
                for (int bj = 0; bj < 2; ++bj) { const u32x4 g = *(const u32x4*)(ga + idx + bj * HALF);
                    *(f32x4*)(part + idx + bj * HALF) = sig4lo(g.x, g.y) * acc[ai][bj][m][0]; *(f32x4*)(part + idx + bj * HALF + 4) = sig4lo(g.z, g.w) * acc[ai][bj][m][1]; } }
    }
};
struct EpiOutB {
    static constexpr bool PERM = true, AFTER_DRAIN = false;
    const bf16_t* gb; const float* part; bf16_t* mrg;
    __device__ __forceinline__ void operator()(const f32x4 (&acc)[2][2][4][2], const Unit& u, int wr, int wc, int fr, int fq) const {
        const int row0 = u.pm * BM + wr * 64 + fr, col0 = u.pn * BM + wc * 32 + 8 * fq;
#pragma unroll
        for (int ai = 0; ai < 2; ++ai)
#pragma unroll
            for (int m = 0; m < 4; ++m) { const size_t idx = (size_t)(row0 + ai * HALF + m * 16) * D + col0;
#pragma unroll
                for (int bj = 0; bj < 2; ++bj) { const u32x4 g = *(const u32x4*)(gb + idx + bj * HALF);
                    const f32x4 v0 = *(const f32x4*)(part + idx + bj * HALF) + sig4lo(g.x, g.y) * acc[ai][bj][m][0], v1 = *(const f32x4*)(part + idx + bj * HALF + 4) + sig4lo(g.z, g.w) * acc[ai][bj][m][1];
                    u32x4 w; w.x = cvt_pk_bf16(v0[0], v0[1]); w.y = cvt_pk_bf16(v0[2], v0[3]); w.z = cvt_pk_bf16(v1[0], v1[1]); w.w = cvt_pk_bf16(v1[2], v1[3]);
                    *(u32x4*)(mrg + idx + bj * HALF) = w; } }
    }
};
__device__ __forceinline__ float sq4(const f32x4 v) { return (v[0] * v[0] + v[1] * v[1]) + (v[2] * v[2] + v[3] * v[3]); }
struct EpiWo {
    static constexpr bool PERM = true, AFTER_DRAIN = false;
    const float* x; float* out; bf16_t* x1b; float* ssp;
    __device__ __forceinline__ void operator()(const f32x4 (&acc)[2][2][4][2], const Unit& u, int wr, int wc, int fr, int fq) const {
        const int row0 = u.pm * BM + wr * 64 + fr, col0 = u.pn * BM + wc * 32 + 8 * fq;
#pragma unroll
        for (int ai = 0; ai < 2; ++ai)
#pragma unroll
            for (int m = 0; m < 4; ++m) { const int row = row0 + ai * HALF + m * 16; const size_t idx = (size_t)row * D + col0; float s = 0.f;
#pragma unroll
                for (int bj = 0; bj < 2; ++bj) { const f32x4 v0 = *(const f32x4*)(x + idx + bj * HALF) + acc[ai][bj][m][0], v1 = *(const f32x4*)(x + idx + bj * HALF + 4) + acc[ai][bj][m][1];
                    *(f32x4*)(out + idx + bj * HALF) = v0; *(f32x4*)(out + idx + bj * HALF + 4) = v1; s += sq4(v0) + sq4(v1);
                    u32x4 w; w.x = cvt_pk_bf16(v0[0], v0[1]); w.y = cvt_pk_bf16(v0[2], v0[3]); w.z = cvt_pk_bf16(v1[0], v1[1]); w.w = cvt_pk_bf16(v1[2], v1[3]);
                    *(u32x4*)(x1b + idx + bj * HALF) = w; }
                s += __shfl_xor(s, 16); s += __shfl_xor(s, 32);
                if (fq == 0) ssp[(size_t)row * 16 + u.pn * 4 + wc] = s; }
    }
};
struct EpiPP {
    static constexpr bool PERM = true, AFTER_DRAIN = false;
    bf16_t* pp;
    __device__ __forceinline__ void operator()(const f32x4 (&acc)[2][2][4][2], const Unit& u, int wr, int wc, int fr, int fq) const {
        const int row0 = u.pm * BM + wr * 64 + fr, col0 = u.pn * BM + wc * 32 + 8 * fq;
#pragma unroll
        for (int ai = 0; ai < 2; ++ai)
#pragma unroll
            for (int m = 0; m < 4; ++m) { const size_t idx = (size_t)(row0 + ai * HALF + m * 16) * D + col0;
#pragma unroll
                for (int bj = 0; bj < 2; ++bj) { const f32x4 v0 = acc[ai][bj][m][0], v1 = acc[ai][bj][m][1];
                    u32x4 w; w.x = cvt_pk_bf16(v0[0], v0[1]); w.y = cvt_pk_bf16(v0[2], v0[3]); w.z = cvt_pk_bf16(v1[0], v1[1]); w.w = cvt_pk_bf16(v1[2], v1[3]);
                    *(u32x4*)(pp + idx + bj * HALF) = w; } }
    }
};
struct EpiGate {
    static constexpr bool PERM = true, AFTER_DRAIN = false;
    float* out; const bf16_t* pp; const float* ssp1; float* ssp2;
    __device__ __forceinline__ void operator()(const f32x4 (&acc)[2][2][4][2], const Unit& u, int wr, int wc, int fr, int fq) const {
        const int row0 = u.pm * BM + wr * 64 + fr, col0 = u.pn * BM + wc * 32 + 8 * fq;
#pragma unroll
        for (int ai = 0; ai < 2; ++ai)
#pragma unroll
            for (int m = 0; m < 4; ++m) { const int row = row0 + ai * HALF + m * 16; const size_t idx = (size_t)row * D + col0;
                const f32x4* sp = (const f32x4*)(ssp1 + (size_t)row * 16); const f32x4 t4 = (sp[0] + sp[1]) + (sp[2] + sp[3]);
                const float r1 = rsqrtf(((t4[0] + t4[1]) + (t4[2] + t4[3])) * (1.f / D) + EPS); float s = 0.f;
#pragma unroll
                for (int bj = 0; bj < 2; ++bj) { const u32x4 pw = *(const u32x4*)(pp + idx + bj * HALF); const f32x4 a0 = acc[ai][bj][m][0] * r1, a1 = acc[ai][bj][m][1] * r1;
                    const f32x4 g0 = (f32x4){sigmoidf_(a0[0]), sigmoidf_(a0[1]), sigmoidf_(a0[2]), sigmoidf_(a0[3])}, g1 = (f32x4){sigmoidf_(a1[0]), sigmoidf_(a1[1]), sigmoidf_(a1[2]), sigmoidf_(a1[3])};
                    const f32x4 p0 = (f32x4){bflo(pw.x), bfhi(pw.x), bflo(pw.y), bfhi(pw.y)}, p1 = (f32x4){bflo(pw.z), bfhi(pw.z), bflo(pw.w), bfhi(pw.w)};
                    const f32x4 v0 = *(const f32x4*)(out + idx + bj * HALF) + g0 * p0, v1 = *(const f32x4*)(out + idx + bj * HALF + 4) + g1 * p1;
                    *(f32x4*)(out + idx + bj * HALF) = v0; *(f32x4*)(out + idx + bj * HALF + 4) = v1; s += sq4(v0) + sq4(v1); }
                s += __shfl_xor(s, 16); s += __shfl_xor(s, 32);
                if (fq == 0) ssp2[(size_t)row * 16 + u.pn * 4 + wc] = s; }
    }
};
template <class Epi, class Sched, bool ALIGN_EPI = false, bool SP2 = false>
__device__ __forceinline__ void gemm_phase(PG8_LAS unsigned char* lds, const Gemm g, const Sched& S, const Epi& E) {
    int tid_ = threadIdx.x; asm volatile("" : "+v"(tid_));
    const int tid = tid_, wid = __builtin_amdgcn_readfirstlane(tid >> 6), lane = tid & 63, wr = wid >> 2, wc = wid & 3, fr = lane & 15, fq = lane >> 4;
    int K_ = g.K; asm volatile("" : "+s"(K_));
    const int K = K_, nt = K / BK;
    unsigned voffA[2], voffB[2];
#pragma unroll
    for (int i = 0; i < 2; ++i) { int R, C; stage_rc(tid * 16 + i * 8192, R, C); const int Rb = Epi::PERM ? ((R & ~31) + perm32(R & 31)) : R;
        voffA[i] = (unsigned)(R * K + C) * 2u; voffB[i] = (unsigned)(Rb * K + C) * 2u; }
    const size_t kstep = (size_t)(BK * 2);
    const size_t hstep = (size_t)HALF * K * 2;
    const size_t tstep = 2 * hstep;
    const unsigned ldsw = (unsigned)wid * 1024u;
    const int aoff = lds_byte(wr * 64 + fr, fq * 8), boff = lds_byte(wc * 32 + fr, fq * 8);
#define PG8_SA(b, h) (((b) * 2 + (h)) * HTB)
#define PG8_SB(b, h) ((4 + (b) * 2 + (h)) * HTB)
#define PG8_STAGE(bufoff, gbase, voff) do { _Pragma("unroll") for (int _i = 0; _i < 2; ++_i) \
        __builtin_amdgcn_global_load_lds((const unsigned*)((const char*)(gbase) + (voff)[_i]), (PG8_LAS unsigned*)(lds + (bufoff) + ldsw + _i * 8192), 16, 0, 0); } while (0)
#define PG8_LDA(dst, b, h) do { _Pragma("unroll") for (int m = 0; m < 4; ++m) _Pragma("unroll") for (int k = 0; k < 2; ++k) dst[m][k] = *(const PG8_LAS bf16x8*)(lds + PG8_SA(b, h) + aoff + m * 2048 + k * 1024); } while (0)
#define PG8_LDB(dst, b, h) do { _Pragma("unroll") for (int n = 0; n < 2; ++n) _Pragma("unroll") for (int k = 0; k < 2; ++k) dst[n][k] = *(const PG8_LAS bf16x8*)(lds + PG8_SB(b, h) + boff + n * 2048 + k * 1024); } while (0)
#define PG8_MMA(ai, bj, At, Bt) do { __builtin_amdgcn_s_setprio(1); _Pragma("unroll") for (int m = 0; m < 4; ++m) _Pragma("unroll") for (int n = 0; n < 2; ++n) _Pragma("unroll") for (int k = 0; k < 2; ++k) \
        acc[ai][bj][m][n] = __builtin_amdgcn_mfma_f32_16x16x32_bf16(Bt[n][k], At[m][k], acc[ai][bj][m][n], 0, 0, 0); __builtin_amdgcn_s_setprio(0); } while (0)
#define PG8_WAIT_V(n) asm volatile("s_waitcnt vmcnt(" #n ")" ::: "memory")
#define PG8_WAIT_L(n) asm volatile("s_waitcnt lgkmcnt(" #n ")" ::: "memory")
#define PG8_BAR __builtin_amdgcn_s_barrier()
#define PG8_SCHED __builtin_amdgcn_sched_barrier(0)
    Unit cur, nxt; int ui = 0;
    if (!S.next(0, cur)) return;
    f32x4 acc[2][2][4][2];
#pragma unroll
    for (int a = 0; a < 2; ++a)
#pragma unroll
        for (int b = 0; b < 2; ++b)
#pragma unroll
            for (int m = 0; m < 4; ++m)
#pragma unroll
                for (int n = 0; n < 2; ++n) acc[a][b][m][n] = (f32x4){0.f, 0.f, 0.f, 0.f};
    bf16x8 At[4][2], B0[2][2], B1[2][2];
    const char* cA = (const char*)g.A + (size_t)cur.pm * tstep; const char* cB = (const char*)g.Bt + (size_t)cur.pn * tstep;
    S.a_ready(cur);
    if constexpr (SP2) {
        PG8_STAGE(PG8_SB(0, 0), cB, voffB); PG8_STAGE(PG8_SB(0, 1), cB + hstep, voffB); PG8_STAGE(PG8_SA(0, 0), cA, voffA); PG8_STAGE(PG8_SA(0, 1), cA + hstep, voffA);
        if (wr == 1) PG8_BAR;
        PG8_WAIT_V(2); PG8_BAR;
        PG8_STAGE(PG8_SB(1, 0), cB + kstep, voffB); PG8_STAGE(PG8_SA(1, 0), cA + kstep, voffA); PG8_STAGE(PG8_SB(1, 1), cB + hstep + kstep, voffB);
        PG8_WAIT_V(6); PG8_BAR;
    } else {
        PG8_STAGE(PG8_SB(0, 0), cB, voffB); PG8_STAGE(PG8_SA(0, 0), cA, voffA); PG8_STAGE(PG8_SB(0, 1), cB + hstep, voffB); PG8_STAGE(PG8_SA(0, 1), cA + hstep, voffA);
        if (wr == 1) PG8_BAR;
        PG8_WAIT_V(4); PG8_BAR;
        PG8_STAGE(PG8_SB(1, 0), cB + kstep, voffB); PG8_STAGE(PG8_SA(1, 0), cA + kstep, voffA); PG8_STAGE(PG8_SB(1, 1), cB + hstep + kstep, voffB);
        PG8_WAIT_V(6); PG8_BAR;
    }
    for (;;) {
        const bool has_next = S.next(ui + 1, nxt);
        const char* nA = has_next ? (const char*)g.A + (size_t)nxt.pm * tstep : cA; const char* nB = has_next ? (const char*)g.Bt + (size_t)nxt.pn * tstep : cB;
        for (int t = 0; t < nt; t += 2) {
            const bool last = (t == nt - 2);
            const char* a1 = cA + (size_t)(t + 1) * kstep;
            const char* a2 = last ? nA : cA + (size_t)(t + 2) * kstep; const char* b2 = last ? nB : cB + (size_t)(t + 2) * kstep;
            const char* a3 = a2 + kstep; const char* b3 = b2 + kstep;
            if (last && has_next) S.a_ready(nxt);
            if constexpr (SP2) {
            PG8_LDB(B0, 0, 0); PG8_LDB(B1, 0, 1); PG8_SCHED; PG8_LDA(At, 0, 0); PG8_STAGE(PG8_SA(1, 1), a1 + hstep, voffA);
            PG8_WAIT_V(8); PG8_WAIT_L(0); PG8_BAR; PG8_MMA(0, 0, At, B0); PG8_MMA(0, 1, At, B1); PG8_BAR; PG8_SCHED;
            PG8_LDA(At, 0, 1); PG8_STAGE(PG8_SB(0, 0), b2, voffB); PG8_STAGE(PG8_SB(0, 1), b2 + hstep, voffB); PG8_STAGE(PG8_SA(0, 0), a2, voffA);
            PG8_WAIT_V(8); PG8_WAIT_L(0); PG8_BAR; PG8_MMA(1, 0, At, B0); PG8_MMA(1, 1, At, B1); PG8_BAR; PG8_SCHED;
            PG8_LDB(B0, 1, 0); PG8_LDB(B1, 1, 1); PG8_SCHED; PG8_LDA(At, 1, 0); PG8_STAGE(PG8_SA(0, 1), a2 + hstep, voffA);
            PG8_WAIT_V(8); PG8_WAIT_L(0); PG8_BAR; PG8_MMA(0, 0, At, B0); PG8_MMA(0, 1, At, B1); PG8_BAR; PG8_SCHED;
            PG8_LDA(At, 1, 1); PG8_STAGE(PG8_SB(1, 0), b3, voffB); PG8_STAGE(PG8_SB(1, 1), b3 + hstep, voffB); PG8_STAGE(PG8_SA(1, 0), a3, voffA);
            PG8_WAIT_V(8); PG8_WAIT_L(0); PG8_BAR; PG8_MMA(1, 0, At, B0); PG8_MMA(1, 1, At, B1); PG8_BAR; PG8_SCHED;
            } else {
            PG8_LDB(B0, 0, 0); PG8_SCHED; PG8_LDA(At, 0, 0); PG8_STAGE(PG8_SA(1, 1), a1 + hstep, voffA);
            PG8_WAIT_L(8); PG8_BAR; PG8_WAIT_L(0); PG8_MMA(0, 0, At, B0); PG8_BAR; PG8_SCHED;
            PG8_LDB(B1, 0, 1); PG8_STAGE(PG8_SB(0, 0), b2, voffB);
            PG8_BAR; PG8_WAIT_L(0); PG8_MMA(0, 1, At, B1); PG8_BAR;
            PG8_LDA(At, 0, 1); PG8_STAGE(PG8_SA(0, 0), a2, voffA);
            PG8_BAR; PG8_WAIT_L(0); PG8_MMA(1, 0, At, B0); PG8_BAR; PG8_SCHED;
            PG8_STAGE(PG8_SB(0, 1), b2 + hstep, voffB);
            PG8_WAIT_V(6); PG8_BAR; PG8_MMA(1, 1, At, B1); PG8_BAR;
            PG8_LDB(B0, 1, 0); PG8_SCHED; PG8_LDA(At, 1, 0); PG8_STAGE(PG8_SA(0, 1), a2 + hstep, voffA);
            PG8_WAIT_L(8); PG8_BAR; PG8_WAIT_L(0); PG8_MMA(0, 0, At, B0); PG8_BAR; PG8_SCHED;
            PG8_LDB(B1, 1, 1); PG8_STAGE(PG8_SB(1, 0), b3, voffB);
            PG8_BAR; PG8_WAIT_L(0); PG8_MMA(0, 1, At, B1); PG8_BAR;
            PG8_LDA(At, 1, 1); PG8_STAGE(PG8_SA(1, 0), a3, voffA);
            PG8_BAR; PG8_WAIT_L(0); PG8_MMA(1, 0, At, B0); PG8_BAR; PG8_SCHED;
            PG8_STAGE(PG8_SB(1, 1), b3 + hstep, voffB);
            PG8_WAIT_V(6); PG8_BAR; PG8_MMA(1, 1, At, B1); PG8_BAR;
            }
        }
        if constexpr (ALIGN_EPI) { if (wr == 0) PG8_BAR; }
        if constexpr (!Epi::AFTER_DRAIN) { E(acc, cur, wr, wc, fr, fq); S.done(cur); }
        if (!has_next) break;
#pragma unroll
        for (int a = 0; a < 2; ++a)
#pragma unroll
            for (int b = 0; b < 2; ++b)
#pragma unroll
                for (int m = 0; m < 4; ++m)
#pragma unroll
                    for (int n = 0; n < 2; ++n) acc[a][b][m][n] = (f32x4){0.f, 0.f, 0.f, 0.f};
        cur = nxt; cA = nA; cB = nB; ++ui;
        if constexpr (ALIGN_EPI) { if (wr == 1) PG8_BAR; }
    }
    PG8_WAIT_V(0);
    if constexpr (!ALIGN_EPI) { if (wr == 0) PG8_BAR; }
    PG8_BAR;
    if constexpr (Epi::AFTER_DRAIN) { E.fused(acc, cur, wr, wc, fr, fq, lds, wid, lane); S.done(cur); }
#undef PG8_SA
#undef PG8_SB
#undef PG8_STAGE
#undef PG8_LDA
#undef PG8_LDB
#undef PG8_MMA
#undef PG8_WAIT_V
#undef PG8_WAIT_L
#undef PG8_BAR
#undef PG8_SCHED
}
}
#define XB_TMO      128
#define XB_XCNT(j)  (256  + 64 * (j))
#define XB_XSUB(j)  (1280 + 64 * (j))
#define XB_XGEN(j)  (2304 + 64 * (j))
#define XB_TOP      3328
#define XB_TOPGEN   3392
#define XCD_BAR_WORDS 3456
#define XB_SPIN_CAP (1u << 18)

__device__ __forceinline__ unsigned xb_ld(unsigned* p)              { return __hip_atomic_load(p, __ATOMIC_RELAXED, __HIP_MEMORY_SCOPE_AGENT); }
__device__ __forceinline__ unsigned xb_add(unsigned* p, unsigned v) { return __hip_atomic_fetch_add(p, v, __ATOMIC_RELAXED, __HIP_MEMORY_SCOPE_AGENT); }
__device__ __forceinline__ unsigned xb_xcc_id() { return (unsigned)__builtin_amdgcn_s_getreg((3 << 11) | 20) & 0xFu; }
#define XB_SPIN(cond, bar) do { unsigned _sp = 0; while (cond) { __builtin_amdgcn_s_sleep(1); \
    if ((++_sp & 255u) == 0u) { if (xb_ld(&(bar)[XB_TMO])) break; if (_sp > XB_SPIN_CAP) { atomicAdd(&(bar)[XB_TMO], 1u); break; } } } } while (0)

struct XcdBarrier {
    unsigned* bar; unsigned x;
    volatile LAS unsigned* st;
};

__device__ __forceinline__ XcdBarrier xcd_barrier_post(unsigned* bar, volatile LAS unsigned* st) {
    XcdBarrier b; b.bar = bar; b.x = xb_xcc_id(); b.st = st;
    if (threadIdx.x == 0) (void)xb_add(&bar[XB_XCNT(b.x)], 1u);
    return b;
}
__device__ __forceinline__ void xcd_barrier_complete(unsigned* bar, unsigned x, unsigned& nloc, unsigned& nx) {
    const unsigned G = gridDim.x * gridDim.y * gridDim.z;
    unsigned sum, cnt, mine, sp = 0u;
    for (;;) {
        sum = 0u; cnt = 0u; mine = 0u;
#pragma unroll
        for (unsigned j = 0; j < 16; ++j) { const unsigned c = xb_ld(&bar[XB_XCNT(j)]); sum += c; cnt += (c > 0u) ? 1u : 0u; mine = (j == x) ? c : mine; }
        if (sum == G) break;
        __builtin_amdgcn_s_sleep(1);
        if ((++sp & 255u) == 0u) { if (xb_ld(&bar[XB_TMO])) break; if (sp > XB_SPIN_CAP) { atomicAdd(&bar[XB_TMO], 1u); break; } }
    }
    nloc = mine > 0u ? mine : 1u; nx = cnt > 0u ? cnt : 1u;
}

__device__ __forceinline__ void xcd_barrier(const XcdBarrier& b) {
    asm volatile("s_waitcnt vmcnt(0)" ::: "memory");
    __syncthreads();
    if (threadIdx.x == 0) {
        unsigned* bar = b.bar;
        __builtin_amdgcn_s_waitcnt(0);
        unsigned nloc = b.st[0], nx = b.st[1];
        if (nloc == 0u) { xcd_barrier_complete(bar, b.x, nloc, nx); b.st[0] = nloc; b.st[1] = nx; }
        const unsigned old = xb_add(&bar[XB_XSUB(b.x)], 1u);
        const unsigned gen = old / nloc;
        if (old + 1u == (gen + 1u) * nloc) {
            __builtin_amdgcn_fence(__ATOMIC_RELEASE, "agent");
            asm volatile("s_waitcnt vmcnt(0)" ::: "memory");
            const unsigned og = xb_add(&bar[XB_TOP], 1u);
            const unsigned tg = og / nx;
            if (og + 1u == (tg + 1u) * nx) xb_add(&bar[XB_TOPGEN], 1u);
            else XB_SPIN(xb_ld(&bar[XB_TOPGEN]) == tg, bar);
            __builtin_amdgcn_fence(__ATOMIC_ACQUIRE, "agent");
            xb_add(&bar[XB_XGEN(b.x)], 1u);
            asm volatile("s_waitcnt vmcnt(0)" ::: "memory");
        } else {
            XB_SPIN(xb_ld(&bar[XB_XGEN(b.x)]) == gen, bar);
            __builtin_amdgcn_fence(__ATOMIC_ACQUIRE, "agent");
            asm volatile("s_waitcnt vmcnt(0)" ::: "memory");
        }
    }
    __syncthreads();
}
constexpr int NWAVES = 8;
constexpr int RING_OFF = 0, RING_BYTES = 131072;
constexpr int LDSCTL_OFF = RING_BYTES, MISC_OFF = LDSCTL_OFF + 320;
constexpr int LDS_BYTES = 147456;

struct Frame {
    LAS unsigned char* lds; volatile LAS unsigned* MISC;
    int tid, lane, wave, G, vcu;
    const float* in[15]; float* out; unsigned char* ws;
};

__device__ __forceinline__ void prep_w_item(const float* W, const float* gain, int K, int Nsrc, bool map, bf16_t* Wt, LAS float* scr, int item, int nblk, int lane) {
    const int kb = item / nblk, nb = item % nblk, k0 = 64 * kb, n0 = 32 * nb;
    const int nn = n0 + (lane & 31); const int e = map ? inmap(nn) : nn;
#pragma unroll 8
    for (int i = 0; i < 32; ++i) { const int kk = 2 * i + (lane >> 5); float v = 0.f;
        if (e >= 0) v = W[(size_t)(k0 + kk) * Nsrc + e] * (gain ? gain[k0 + kk] : 1.f);
        scr[kk * 33 + (lane & 31)] = v; }
    LDS_WAIT(); asm volatile("" ::: "memory");
    const int c = lane & 7;
#pragma unroll
    for (int j = 0; j < 4; ++j) { const int n = (lane >> 3) + 8 * j; const LAS float* s = scr + (8 * c) * 33 + n;
        u32x4 o; o.x = pk2(s[0 * 33], s[1 * 33]); o.y = pk2(s[2 * 33], s[3 * 33]); o.z = pk2(s[4 * 33], s[5 * 33]); o.w = pk2(s[6 * 33], s[7 * 33]);
        *(u32x4*)(Wt + (size_t)(n0 + n) * K + k0 + 8 * c) = o; }
    LDS_WAIT(); asm volatile("" ::: "memory");
}
__device__ __forceinline__ void p0_prep(Frame& F) {
    LAS float* scr = (LAS float*)(F.lds + RING_OFF + F.wave * 16384);
    int tid_ = threadIdx.x; asm volatile("" : "+v"(tid_));
    const int lane = tid_ & 63, gw = F.vcu * NWAVES + __builtin_amdgcn_readfirstlane(tid_ >> 6), NGW = F.G * NWAVES;
    unsigned char* ws = F.ws;
    constexpr int I_IN = (D / 64) * (NINP / 32), I_A = (DC / 64) * (D / 32), I_O = (D / 64) * (D / 32), I_P = (DPLE / 64) * (D / 32);
    constexpr int NITEMS = I_IN + 2 * I_A + 2 * I_O + I_P;
    for (int it = gw; it < NITEMS; it += NGW) {
        int r = it;
        if (r < I_IN) { prep_w_item(F.in[3], F.in[2], D, NIN, true, (bf16_t*)(ws + WS_WIN), scr, r, NINP / 32, lane); continue; } r -= I_IN;
        if (r < I_A) { prep_w_item(F.in[8], nullptr, DC, D, false, (bf16_t*)(ws + WS_WA), scr, r, D / 32, lane); continue; } r -= I_A;
        if (r < I_A) { prep_w_item(F.in[9], nullptr, DC, D, false, (bf16_t*)(ws + WS_WB), scr, r, D / 32, lane); continue; } r -= I_A;
        if (r < I_O) { prep_w_item(F.in[10], nullptr, D, D, false, (bf16_t*)(ws + WS_WO), scr, r, D / 32, lane); continue; } r -= I_O;
        if (r < I_O) { prep_w_item(F.in[12], F.in[11], D, D, false, (bf16_t*)(ws + WS_WG), scr, r, D / 32, lane); continue; } r -= I_O;
        prep_w_item(F.in[13], nullptr, DPLE, D, false, (bf16_t*)(ws + WS_WP), scr, r, D / 32, lane);
    }
    const float* x = F.in[0]; const float* p = F.in[1]; bf16_t* xb = (bf16_t*)(ws + WS_XB); bf16_t* pb = (bf16_t*)(ws + WS_PB); float* rinv = (float*)(ws + WS_RINV);
    for (int m = gw; m < M; m += NGW) {
        const f32x4* xr = (const f32x4*)(x + (size_t)m * D) + lane; f32x4 v[4]; float s = 0.f;
#pragma unroll
        for (int j = 0; j < 4; ++j) { v[j] = xr[64 * j]; s += (v[j].x * v[j].x + v[j].y * v[j].y) + (v[j].z * v[j].z + v[j].w * v[j].w); }
        s = wave_sum(s);
        if (lane == 0) rinv[m] = rsqrtf(s * (1.f / D) + EPS);
        u32x2* o = (u32x2*)(xb + (size_t)m * D) + lane;
#pragma unroll
        for (int j = 0; j < 4; ++j) { u32x2 w; w.x = pk2(v[j].x, v[j].y); w.y = pk2(v[j].z, v[j].w); o[64 * j] = w; }
        const f32x4 pv = ((const f32x4*)(p + (size_t)m * DPLE))[lane];
        u32x2 w; w.x = pk2(pv.x, pv.y); w.y = pk2(pv.z, pv.w); ((u32x2*)(pb + (size_t)m * DPLE))[lane] = w;
    }
}

constexpr int CF_TOK = 128, CF_CH = 16;
__device__ __forceinline__ void p2_conformer(Frame& F) {
    LAS float* red = (LAS float*)(F.lds + RING_OFF);
    const bf16_t* cin = (const bf16_t*)(F.ws + WS_CIN); const bf16_t* cz = (const bf16_t*)(F.ws + WS_CZ); bf16_t* ya = (bf16_t*)(F.ws + WS_YA);
    const float* conv_w = F.in[4];
    int tid_ = threadIdx.x; asm volatile("" : "+v"(tid_));
    const int ch = tid_, lane = tid_ & 63, wv = __builtin_amdgcn_readfirstlane(tid_ >> 6);
    float w[CWID];
#pragma unroll
    for (int j = 0; j < CWID; ++j) w[j] = conv_w[j * DC + ch];
    const float cb = F.in[5][ch], g = F.in[6][ch], bb = F.in[7][ch];
    for (int item = F.vcu; item < M / CF_TOK; item += F.G) {
        const int b = item / (SEQ / CF_TOK), t0 = (item % (SEQ / CF_TOK)) * CF_TOK; const size_t rowb = (size_t)b * SEQ;
        float u[CF_CH + CWID - 1];
#pragma unroll
        for (int i = 0; i < CWID - 1; ++i) { const int t = t0 - (CWID - 1) + i; float v = 0.f;
            if (t >= 0) { const float a = bf2f(cin[(rowb + t) * 1024 + ch]), gt = bf2f(cin[(rowb + t) * 1024 + 512 + ch]); v = a * sigmoidf_(gt); }
            u[i] = v; }
        for (int tc = t0; tc < t0 + CF_TOK; tc += CF_CH) {
#pragma unroll
            for (int i = 0; i < CF_CH; ++i) { const size_t r = (rowb + tc + i) * 1024; const float a = bf2f(cin[r + ch]), gt = bf2f(cin[r + 512 + ch]); u[CWID - 1 + i] = a * sigmoidf_(gt); }
            float c[CF_CH];
#pragma unroll
            for (int i = 0; i < CF_CH; ++i) { float s = cb;
#pragma unroll
                for (int j = 0; j < CWID; ++j) s = fmaf(w[j], u[i + j], s);
                c[i] = s; }
#pragma unroll
            for (int i = 0; i < CF_CH; ++i) { const float s1 = wave_sum(c[i]), s2 = wave_sum(c[i] * c[i]); if (lane == 0) { red[wv * 32 + 2 * i] = s1; red[wv * 32 + 2 * i + 1] = s2; } }
            __syncthreads();
#pragma unroll
            for (int i = 0; i < CF_CH; ++i) { float s1 = 0.f, s2 = 0.f;
#pragma unroll
                for (int q = 0; q < 8; ++q) { s1 += red[q * 32 + 2 * i]; s2 += red[q * 32 + 2 * i + 1]; }
                const float mu = s1 * (1.f / DC), var = fmaxf(s2 * (1.f / DC) - mu * mu, 0.f), rs = rsqrtf(var + EPS);
                const float y = (c[i] - mu) * rs * g + bb; const float z = bf2f(cz[(rowb + tc + i) * DC + ch]);
                ya[(rowb + tc + i) * DC + ch] = f2bf(siluf_(y) * siluf_(z)); }
            __syncthreads();
#pragma unroll
            for (int i = 0; i < CWID - 1; ++i) u[i] = u[i + CF_CH];
        }
    }
}

__device__ __forceinline__ unsigned sortkey(float f) { const unsigned u = __float_as_uint(f + 0.f); return (u & 0x80000000u) ? ~u : (u | 0x80000000u); }
__device__ __forceinline__ void p2_attn_naive(Frame& F) {
    const bf16_t* qb = (const bf16_t*)(F.ws + WS_Q); const bf16_t* iq = (const bf16_t*)(F.ws + WS_IQ); const bf16_t* sm = (const bf16_t*)(F.ws + WS_SM); const bf16_t* az = (const bf16_t*)(F.ws + WS_AZ); bf16_t* yb = (bf16_t*)(F.ws + WS_YB);
    int tid_ = threadIdx.x; asm volatile("" : "+v"(tid_));
    const int half = tid_ >> 8, tid = tid_ & 255, lane = tid_ & 63, wv = (tid_ >> 6) & 3;
    LAS unsigned char* base = F.lds + RING_OFF + half * 24576;
    LAS float* qi = (LAS float*)base;
    LAS float* qq = (LAS float*)(base + 2048);
    LAS float* wi = (LAS float*)(base + 4096);
    LAS int* cnts = (LAS int*)(base + 4096 + 32);
    LAS int* nselp = (LAS int*)(base + 4096 + 64);
    LAS unsigned* keys = (LAS unsigned*)(base + 4352);
    LAS int* sel = (LAS int*)(base + 4352 + 8192);
    LAS float* pr = (LAS float*)(base + 4352 + 8192 + 1024);
    const int per_cu = M / F.G;
    for (int itq = 0; itq < per_cu; itq += 2) {
        const int m = F.vcu + F.G * (itq + half), b = m / SEQ, t = m % SEQ, n = t + 1; const size_t rowb = (size_t)b * SEQ;
        __syncthreads();
        for (int i = tid; i < 512; i += 256) { qi[i] = bf2f(iq[(size_t)m * 512 + i]); qq[i] = bf2f(qb[(size_t)m * 512 + i]); }
        if (tid < 8) wi[tid] = bf2f(sm[(size_t)m * 256 + 192 + tid]) * 0.35355339059327373f;
        if (tid == 0) { nselp[0] = 0; nselp[1] = 0; }
        __syncthreads();
        for (int s = tid; s < n; s += 256) {
            const bf16_t* kr = sm + (rowb + s) * 256 + 128; float dd[8];
#pragma unroll
            for (int h = 0; h < 8; ++h) dd[h] = 0.f;
#pragma unroll 1
            for (int c = 0; c < 8; ++c) { const u32x4 v = ((const u32x4*)kr)[c]; const float kf[8] = {bflo(v.x), bfhi(v.x), bflo(v.y), bfhi(v.y), bflo(v.z), bfhi(v.z), bflo(v.w), bfhi(v.w)};
#pragma unroll
                for (int h = 0; h < 8; ++h)
#pragma unroll
                    for (int e = 0; e < 8; ++e) dd[h] = fmaf(qi[h * 64 + c * 8 + e], kf[e], dd[h]); }
            float sc = 0.f;
#pragma unroll
            for (int h = 0; h < 8; ++h) sc = fmaf(wi[h], fmaxf(dd[h] * 0.125f, 0.f), sc);
            keys[s] = sortkey(sc);
        }
        __syncthreads();
        unsigned prefix = 0u;
        for (int bit = 31; bit >= 0; --bit) { const unsigned cand = prefix | (1u << bit); int c = 0;
            for (int s = tid; s < n; s += 256) c += (keys[s] >= cand) ? 1 : 0;
            c = (int)wave_sum((float)c);
            if (lane == 0) cnts[wv] = c;
            __syncthreads();
            const int tot = cnts[0] + cnts[1] + cnts[2] + cnts[3];
            __syncthreads();
            if (tot >= TOPK) prefix = cand; }
        int c = 0; for (int s = tid; s < n; s += 256) c += (keys[s] > prefix) ? 1 : 0;
        c = (int)wave_sum((float)c); if (lane == 0) cnts[wv] = c; __syncthreads();
        const int ngt = cnts[0] + cnts[1] + cnts[2] + cnts[3]; const int need = TOPK - ngt;
        __syncthreads();
        for (int s0 = 0; s0 < SEQ; s0 += 256) { const int s = s0 + tid; const bool in = s < n; const unsigned k = in ? keys[s] : 0u; const bool gt = in && k > prefix, eq = in && k == prefix;
            const unsigned long long be = __ballot(eq); const int rank_w = __popcll(be & ((1ull << lane) - 1ull));
            if (lane == 0) cnts[4 + wv] = __popcll(be);
            __syncthreads();
            int before = nselp[1]; for (int q = 0; q < wv; ++q) before += cnts[4 + q];
            const bool take = gt || (eq && (before + rank_w) < need);
            if (take) { const int pos = atomicAdd((int*)&nselp[0], 1); if (pos < TOPK) sel[pos] = s; }
            __syncthreads();
            if (tid == 0) nselp[1] += cnts[4] + cnts[5] + cnts[6] + cnts[7];
            __syncthreads(); }
        const int nsel = nselp[0] < TOPK ? nselp[0] : TOPK;
        { const int j = tid; float lg[8];
          if (j < nsel) { const int s = sel[j]; const bf16_t* kr = sm + (rowb + s) * 256; float dd[8];
#pragma unroll
              for (int h = 0; h < 8; ++h) dd[h] = 0.f;
#pragma unroll 1
              for (int c2 = 0; c2 < 8; ++c2) { const u32x4 v = ((const u32x4*)kr)[c2]; const float kf[8] = {bflo(v.x), bfhi(v.x), bflo(v.y), bfhi(v.y), bflo(v.z), bfhi(v.z), bflo(v.w), bfhi(v.w)};
#pragma unroll
                  for (int h = 0; h < 8; ++h)
#pragma unroll
                      for (int e = 0; e < 8; ++e) dd[h] = fmaf(qq[h * 64 + c2 * 8 + e], kf[e], dd[h]); }
#pragma unroll
              for (int h = 0; h < 8; ++h) lg[h] = dd[h] * 0.125f - exp2f(-(float)(h + 1)) * (float)(t - s); }
          else {
#pragma unroll
              for (int h = 0; h < 8; ++h) lg[h] = -INFINITY; }
#pragma unroll
          for (int h = 0; h < 8; ++h) pr[h * 256 + j] = lg[h]; }
        __syncthreads();
#pragma unroll
        for (int hh = 0; hh < 2; ++hh) { const int h = 2 * wv + hh; float v[4]; float mx = -INFINITY;
#pragma unroll
            for (int i = 0; i < 4; ++i) { v[i] = pr[h * 256 + lane + 64 * i]; mx = fmaxf(mx, v[i]); }
#pragma unroll
            for (int o = 1; o < 64; o <<= 1) mx = fmaxf(mx, __shfl_xor(mx, o));
            float s = 0.f;
#pragma unroll
            for (int i = 0; i < 4; ++i) { v[i] = __expf(v[i] - mx); s += v[i]; }
            s = wave_sum(s); const float inv = 1.f / s;
#pragma unroll
            for (int i = 0; i < 4; ++i) pr[h * 256 + lane + 64 * i] = v[i] * inv; }
        __syncthreads();
        { const int h = tid >> 5, d = 2 * (tid & 31); float o0 = 0.f, o1 = 0.f;
          for (int j = 0; j < nsel; ++j) { const unsigned vv = *(const unsigned*)(sm + (rowb + sel[j]) * 256 + 64 + d); const float pj = pr[h * 256 + j];
              o0 = fmaf(pj, bflo(vv), o0); o1 = fmaf(pj, bfhi(vv), o1); }
          const unsigned zz = *(const unsigned*)(az + (size_t)m * 512 + h * 64 + d);
          *(unsigned*)(yb + (size_t)m * 512 + h * 64 + d) = pk2(o0 * siluf_(bflo(zz)), o1 * siluf_(bfhi(zz))); }
    }
    __syncthreads();
}

__device__ __forceinline__ void p6_final(Frame& F) {
    float* out = F.out; const float* ssp2 = (const float*)(F.ws + WS_SSP2); const float* fg = F.in[14];
    int tid_ = threadIdx.x; asm volatile("" : "+v"(tid_));
    const int lane = tid_ & 63, gw = F.vcu * NWAVES + __builtin_amdgcn_readfirstlane(tid_ >> 6), NGW = F.G * NWAVES;
    for (int m = gw; m < M; m += NGW) { float s = (lane < 16) ? ssp2[(size_t)m * 16 + lane] : 0.f; s = wave_sum(s);
        const float r = rsqrtf(s * (1.f / D) + EPS); f32x4* o = (f32x4*)(out + (size_t)m * D) + lane;
#pragma unroll
        for (int j = 0; j < 4; ++j) { const f32x4 gv = ((const f32x4*)fg)[lane + 64 * j]; f32x4 v = o[64 * j]; v = v * r * gv; o[64 * j] = v; } }
}

struct Args { const float* in[15]; float* out; unsigned char* ws; };
__global__ void __launch_bounds__(NWAVES * 64, 2) fwd_kernel(Args args) {
    extern __shared__ __attribute__((aligned(16))) unsigned char lds_raw[];
    Frame F;
    F.lds = (LAS unsigned char*)lds_raw; F.MISC = (volatile LAS unsigned*)(F.lds + MISC_OFF);
    F.tid = threadIdx.x; F.lane = F.tid & 63; F.wave = __builtin_amdgcn_readfirstlane(F.tid >> 6);
    F.G = gridDim.x; { const int bx = blockIdx.x; F.vcu = (F.G % 8 == 0) ? (bx % 8) * (F.G / 8) + bx / 8 : bx; }
#pragma unroll
    for (int i = 0; i < 15; ++i) F.in[i] = args.in[i];
    F.out = args.out; F.ws = args.ws;
    unsigned char* ws = args.ws;
    for (int u = F.tid; u < (LDS_BYTES - LDSCTL_OFF) / 4; u += NWAVES * 64) ((LAS unsigned*)(F.lds + LDSCTL_OFF))[u] = 0u;
    __syncthreads();
    XcdBarrier bar = xcd_barrier_post((unsigned*)(ws + WS_CTL) + CW_BAR, F.MISC + 8);

#ifndef NO_P0
    p0_prep(F);
#endif
    xcd_barrier(bar);
    { pg8::Gemm g{(const bf16_t*)(ws + WS_XB), (const bf16_t*)(ws + WS_WIN), M, NINP, D}; pg8::StaticOrder S; S.init(M, NINP, F.G, (int)blockIdx.x);
      pg8::EpiInProj E{(const float*)(ws + WS_RINV), ws};
#ifndef NO_P1
      pg8::gemm_phase<pg8::EpiInProj, pg8::StaticOrder, true, true>(F.lds + RING_OFF, g, S, E);
#endif
    }
    xcd_barrier(bar);
#ifndef NO_P2A
    p2_conformer(F);
#endif
#ifndef NO_P2B
    p2_attn_naive(F);
#endif
    xcd_barrier(bar);
    { pg8::Gemm g{(const bf16_t*)(ws + WS_YA), (const bf16_t*)(ws + WS_WA), M, D, DC}; pg8::StaticOrder S; S.init(M, D, F.G, (int)blockIdx.x);
      pg8::EpiOutA E{(const bf16_t*)(ws + WS_GA), F.out};
#ifndef NO_P3A
      pg8::gemm_phase<pg8::EpiOutA, pg8::StaticOrder, true, true>(F.lds + RING_OFF, g, S, E);
#endif
    }
    { pg8::Gemm g{(const bf16_t*)(ws + WS_YB), (const bf16_t*)(ws + WS_WB), M, D, DC}; pg8::StaticOrder S; S.init(M, D, F.G, (int)blockIdx.x);
      pg8::EpiOutB E{(const bf16_t*)(ws + WS_GB), F.out, (bf16_t*)(ws + WS_MRG)};
#ifndef NO_P3B
      pg8::gemm_phase<pg8::EpiOutB, pg8::StaticOrder, true, true>(F.lds + RING_OFF, g, S, E);
#endif
    }
    xcd_barrier(bar);
    { pg8::Gemm g{(const bf16_t*)(ws + WS_MRG), (const bf16_t*)(ws + WS_WO), M, D, D}; pg8::StaticOrder S; S.init(M, D, F.G, (int)blockIdx.x);
      pg8::EpiWo E{F.in[0], F.out, (bf16_t*)(ws + WS_X1B), (float*)(ws + WS_SSP1)};
#ifndef NO_P4
      pg8::gemm_phase<pg8::EpiWo, pg8::StaticOrder, true, true>(F.lds + RING_OFF, g, S, E);
#endif
    }
    xcd_barrier(bar);
    { pg8::Gemm g{(const bf16_t*)(ws + WS_PB), (const bf16_t*)(ws + WS_WP), M, D, DPLE}; pg8::StaticOrder S; S.init(M, D, F.G, (int)blockIdx.x);
      pg8::EpiPP E{(bf16_t*)(ws + WS_PP)};
#ifndef NO_P5A
      pg8::gemm_phase<pg8::EpiPP, pg8::StaticOrder, true, true>(F.lds + RING_OFF, g, S, E);
#endif
    }
    __builtin_amdgcn_sched_barrier(0); asm volatile("" ::: "memory");
    { pg8::Gemm g{(const bf16_t*)(ws + WS_X1B), (const bf16_t*)(ws + WS_WG), M, D, D}; pg8::StaticOrder S; S.init(M, D, F.G, (int)blockIdx.x);
      pg8::EpiGate E{F.out, (const bf16_t*)(ws + WS_PP), (const float*)(ws + WS_SSP1), (float*)(ws + WS_SSP2)};
#ifndef NO_P5B
      pg8::gemm_phase<pg8::EpiGate, pg8::StaticOrder, true, true>(F.lds + RING_OFF, g, S, E);
#endif
    }
    xcd_barrier(bar);
#ifndef NO_P6
    p6_final(F);
#endif
}

extern "C" void kernel_launch(void* const* d_in, const int* in_sizes, int n_in, void* d_out, int out_size, void* d_ws, size_t ws_size, hipStream_t stream) {
    static int grid = 0;
    if (grid == 0) {
        if (n_in != 15 || out_size != M * D || ws_size < WS_END) { fprintf(stderr, "kernel_launch: unexpected sizes n_in %d out %d ws %zu\n", n_in, out_size, ws_size); grid = -1; return; }
        int dev = 0, cus = 0, per_cu = 0;
        if (hipGetDevice(&dev) != hipSuccess || hipDeviceGetAttribute(&cus, hipDeviceAttributeMultiprocessorCount, dev) != hipSuccess) { grid = -1; return; }
        if (hipFuncSetAttribute((const void*)fwd_kernel, hipFuncAttributeMaxDynamicSharedMemorySize, LDS_BYTES) != hipSuccess) { fprintf(stderr, "kernel_launch: hipFuncSetAttribute failed\n"); grid = -1; return; }
        if (hipOccupancyMaxActiveBlocksPerMultiprocessor(&per_cu, (const void*)fwd_kernel, NWAVES * 64, LDS_BYTES) != hipSuccess || per_cu < 1) { fprintf(stderr, "kernel_launch: occupancy query reports %d blocks per CU\n", per_cu); (void)hipGetLastError(); grid = -1; return; }
        grid = cus;
        if (M % grid != 0 || grid % 8 != 0) { fprintf(stderr, "kernel_launch: unsupported CU count %d\n", grid); grid = -1; return; }
    }
    if (grid < 0) return;
    (void)hipMemsetAsync((char*)d_ws + WS_CTL, 0, CTL_ZERO_BYTES, stream);
    Args a{};
    for (int i = 0; i < 15; ++i) a.in[i] = (const float*)d_in[i];
    a.out = (float*)d_out; a.ws = (unsigned char*)d_ws;
    hipLaunchKernelGGL(fwd_kernel, dim3(grid), dim3(NWAVES * 64), LDS_BYTES, stream, a);
}
```

```cpp
#include <hip/hip_runtime.h>
#include <cstdint>
#include <cstdio>

typedef unsigned short bf16_t;
typedef float f32x4 __attribute__((ext_vector_type(4)));
typedef unsigned u32x4 __attribute__((ext_vector_type(4)));
typedef unsigned u32x2 __attribute__((ext_vector_type(2)));
#define GAS __attribute__((address_space(1)))
#define LAS __attribute__((address_space(3)))
#define LDS_WAIT() asm volatile("s_waitcnt lgkmcnt(0)" ::: "memory")
#define VM_WAIT() asm volatile("s_waitcnt vmcnt(0)" ::: "memory")

constexpr int NB = 16, SEQ = 2048, D = 1024, M = NB * SEQ;
constexpr int DPLE = 256, DC = 512, CWID = 31, NH = 8, HD = 64, TOPK = 256;
constexpr int NIN = 5320, NINP = 5376;
constexpr float EPS = 1e-6f;

constexpr size_t MiB = 1u << 20;
constexpr size_t WS_CTL = 0;
constexpr size_t CTL_ZERO_BYTES = 64 * 1024;
constexpr int CW_BAR = 4096;
constexpr size_t WS_WIN = 2 * MiB;
constexpr size_t WS_WA = 13 * MiB;
constexpr size_t WS_WB = 14 * MiB;
constexpr size_t WS_WO = 15 * MiB;
constexpr size_t WS_WG = 17 * MiB;
constexpr size_t WS_WP = 19 * MiB;
constexpr size_t WS_RINV = 20 * MiB;
constexpr size_t WS_SSP1 = 22 * MiB;
constexpr size_t WS_SSP2 = 24 * MiB;
constexpr size_t WS_XB = 32 * MiB;
constexpr size_t WS_YA = 32 * MiB, WS_YB = 64 * MiB;
constexpr size_t WS_PB = 96 * MiB;
constexpr size_t WS_CIN = 112 * MiB;
constexpr size_t WS_MRG = 112 * MiB;
constexpr size_t WS_CZ = 176 * MiB;
constexpr size_t WS_Q = 208 * MiB;
constexpr size_t WS_X1B = 176 * MiB;
constexpr size_t WS_AZ = 240 * MiB;
constexpr size_t WS_IQ = 272 * MiB;
constexpr size_t WS_SM = 304 * MiB;
constexpr size_t WS_GA = 320 * MiB;
constexpr size_t WS_PP = 320 * MiB;
constexpr size_t WS_GB = 384 * MiB;
constexpr size_t WS_END = 448 * MiB;

__device__ __forceinline__ float bf2f(bf16_t h) { return __uint_as_float(((unsigned)h) << 16); }
__device__ __forceinline__ bf16_t f2bf(float f) { unsigned u = __float_as_uint(f); return (bf16_t)((u + 0x7fffu + ((u >> 16) & 1u)) >> 16); }
__device__ __forceinline__ unsigned pk2(float lo, float hi) { return (unsigned)f2bf(lo) | ((unsigned)f2bf(hi) << 16); }
__device__ __forceinline__ float bflo(unsigned w) { return __uint_as_float(w << 16); }
__device__ __forceinline__ float bfhi(unsigned w) { return __uint_as_float(w & 0xffff0000u); }
__device__ __forceinline__ float sigmoidf_(float x) { return 1.f / (1.f + __expf(-x)); }
__device__ __forceinline__ float siluf_(float x) { return x * sigmoidf_(x); }
__device__ __forceinline__ float wave_sum(float v) {
#pragma unroll
    for (int o = 1; o < 64; o <<= 1) v += __shfl_xor(v, o);
    return v;
}

__host__ __device__ __forceinline__ int inmap(int n) {
    if (n < 2048) return n;
    if (n < 2560) return 2176 + (n - 2048);
    if (n < 3072) return 2688 + (n - 2560);
    if (n < 3328) { const int j = n - 3072;
        if (j < 64) return 2048 + j; if (j < 128) return 2112 + (j - 64); if (j < 192) return 3200 + (j - 128); if (j < 200) return 3264 + (j - 192); return -1; }
    if (n < 4352) return 3272 + (n - 3328);
    return 4296 + (n - 4352);
}
namespace pg8 {
#define PG8_LAS __attribute__((address_space(3)))
typedef unsigned short bf16_t;
typedef short bf16x8 __attribute__((ext_vector_type(8)));
typedef float f32x4 __attribute__((ext_vector_type(4)));
typedef unsigned u32x4 __attribute__((ext_vector_type(4)));
constexpr int BM = 256, BK = 64, HALF = 128, HTB = HALF * BK * 2  , STAGE_BYTES = 8 * HTB, NXCD = 8, WGM = 8;

__host__ __device__ __forceinline__ int lds_byte(int r, int c) { const int st = (r >> 4) * 2 + (c >> 5), rr = r & 15, cc = c & 31, ob = rr * 64 + cc * 2; return st * 1024 + (ob ^ (((ob >> 9) & 1) << 5)); }
__host__ __device__ __forceinline__ void stage_rc(int b, int& R, int& C) { const int st = b / 1024, sb = b % 1024, swz = sb ^ (((sb >> 9) & 1) << 5); R = (st >> 1) * 16 + swz / 64; C = (st & 1) * 32 + (swz % 64) / 2; }
__host__ __device__ __forceinline__ int perm32(int rho) { const int n = rho >> 4, i = rho & 15; return 8 * (i >> 2) + 4 * n + (i & 3); }

struct Unit { int pm, pn; };
struct Gemm { const bf16_t* A; const bf16_t* Bt; int M, N, K; };

struct StaticOrder {
    int nM, nN, nwg, G, c;
    __host__ __device__ void init(int M, int N, int G_, int c_) { nM = M / BM; nN = N / BM; nwg = nM * nN; G = G_; c = c_; }
    __host__ __device__ bool next(int i, Unit& u) const {
        const long L = (long)i * G + c; if (L >= nwg) return false;
        int wgid = (int)L; { const int q = nwg / NXCD, r = nwg % NXCD, xcd = wgid % NXCD, off = wgid / NXCD; wgid = (xcd < r ? xcd * (q + 1) : r * (q + 1) + (xcd - r) * q) + off; }
        const int nig = WGM * nN, gid = wgid / nig, fm = gid * WGM, gsz = (nM - fm) < WGM ? (nM - fm) : WGM;
        u.pm = fm + ((wgid % nig) % gsz); u.pn = (wgid % nig) / gsz; return true;
    }
    __device__ __forceinline__ void a_ready(const Unit&) const {}
    __device__ __forceinline__ void done(const Unit&) const {}
};
__device__ __forceinline__ unsigned cvt_pk_bf16(float lo, float hi) { unsigned r; asm volatile("v_cvt_pk_bf16_f32 %0, %1, %2" : "=v"(r) : "v"(lo), "v"(hi)); return r; }
struct EpiInProj {
    static constexpr bool PERM = true, AFTER_DRAIN = false;
    const float* rinv; unsigned char* ws;
    __device__ __forceinline__ void operator()(const f32x4 (&acc)[2][2][4][2], const Unit& u, int wr, int wc, int fr, int fq) const {
        size_t off; int ld, colt; const int pn = u.pn;
        if (pn < 4) { off = WS_CIN; ld = 1024; colt = pn * 256; }
        else if (pn < 6) { off = WS_CZ; ld = 512; colt = (pn - 4) * 256; }
        else if (pn < 8) { off = WS_Q; ld = 512; colt = (pn - 6) * 256; }
        else if (pn < 10) { off = WS_AZ; ld = 512; colt = (pn - 8) * 256; }
        else if (pn < 12) { off = WS_IQ; ld = 512; colt = (pn - 10) * 256; }
        else if (pn < 13) { off = WS_SM; ld = 256; colt = 0; }
        else if (pn < 17) { off = WS_GA; ld = 1024; colt = (pn - 13) * 256; }
        else { off = WS_GB; ld = 1024; colt = (pn - 17) * 256; }
        bf16_t* base = (bf16_t*)(ws + off);
        const int row0 = u.pm * BM + wr * 64 + fr, col0 = colt + wc * 32 + 8 * fq;
#pragma unroll
        for (int ai = 0; ai < 2; ++ai)
#pragma unroll
            for (int m = 0; m < 4; ++m) { const int row = row0 + ai * HALF + m * 16; const float r = rinv[row]; bf16_t* rowp = base + (size_t)row * ld + col0;
#pragma unroll
                for (int bj = 0; bj < 2; ++bj) { const f32x4 v0 = acc[ai][bj][m][0] * r, v1 = acc[ai][bj][m][1] * r;
                    u32x4 w; w.x = cvt_pk_bf16(v0[0], v0[1]); w.y = cvt_pk_bf16(v0[2], v0[3]); w.z = cvt_pk_bf16(v1[0], v1[1]); w.w = cvt_pk_bf16(v1[2], v1[3]);
                    *(u32x4*)(rowp + bj * HALF) = w; } }
    }
};
__device__ __forceinline__ f32x4 sig4lo(unsigned a, unsigned b) { return (f32x4){sigmoidf_(bflo(a)), sigmoidf_(bfhi(a)), sigmoidf_(bflo(b)), sigmoidf_(bfhi(b))}; }
struct EpiOutA {
    static constexpr bool PERM = true, AFTER_DRAIN = false;
    const bf16_t* ga; float* part;
    __device__ __forceinline__ void operator()(const f32x4 (&acc)[2][2][4][2], const Unit& u, int wr, int wc, int fr, int fq) const {
        const int row0 = u.pm * BM + wr * 64 + fr, col0 = u.pn * BM + wc * 32 + 8 * fq;
#pragma unroll
        for (int ai = 0; ai < 2; ++ai)
#pragma unroll
            for (int m = 0; m < 4; ++m) { const size_t idx = (size_t)(row0 + ai * HALF + m * 16) * D + col0;
#pragma unroll
                for (int bj = 0; bj < 2; ++bj) { const u32x4 g = *(const u32x4*)(ga + idx + bj * HALF);
                    *(f32x4*)(part + idx + bj * HALF) = sig4lo(g.x, g.y) * acc[ai][bj][m][0]; *(f32x4*)(part + idx + bj * HALF + 4) = sig4lo(g.z, g.w) * acc[ai][bj][m][1]; } }
    }
};
struct EpiOutB {
    static constexpr bool PERM = true, AFTER_DRAIN = false;
    const bf16_t* gb; const float* part; bf16_t* mrg;
    __device__ __forceinline__ void operator()(const f32x4 (&acc)[2][2][4][2], const Unit& u, int wr, int wc, int fr, int fq) const {
        const int row0 = u.pm * BM + wr * 64 + fr, col0 = u.pn * BM + wc * 32 + 8 * fq;
#pragma unroll
        for (int ai = 0; ai < 2; ++ai)
#pragma unroll
            for (int m = 0; m < 4; ++m) { const size_t idx = (size_t)(row0 + ai * HALF + m * 16) * D + col0;
#pragma unroll
                for (int bj = 0; bj < 2; ++bj) { const u32x4 g = *(const u32x4*)(gb + idx + bj * HALF);
                    const f32x4 v0 = *(const f32x4*)(part + idx + bj * HALF) + sig4lo(g.x, g.y) * acc[ai][bj][m][0], v1 = *(const f32x4*)(part + idx + bj * HALF + 4) + sig4lo(g.z, g.w) * acc[ai][bj][m][1];
                    u32x4 w; w.x = cvt_pk_bf16(v0[0], v0[1]); w.y = cvt_pk_bf16(v0[2], v0[3]); w.z = cvt_pk_bf16(v1[0], v1[1]); w.w = cvt_pk_bf16(v1[2], v1[3]);
                    *(u32x4*)(mrg + idx + bj * HALF) = w; } }
    }
};
__device__ __forceinline__ float sq4(const f32x4 v) { return (v[0] * v[0] + v[1] * v[1]) + (v[2] * v[2] + v[3] * v[3]); }
struct EpiWo {
    static constexpr bool PERM = true, AFTER_DRAIN = false;
    const float* x; float* out; bf16_t* x1b; float* ssp;
    __device__ __forceinline__ void operator()(const f32x4 (&acc)[2][2][4][2], const Unit& u, int wr, int wc, int fr, int fq) const {
        const int row0 = u.pm * BM + wr * 64 + fr, col0 = u.pn * BM + wc * 32 + 8 * fq;
#pragma unroll
        for (int ai = 0; ai < 2; ++ai)
#pragma unroll
            for (int m = 0; m < 4; ++m) { const int row = row0 + ai * HALF + m * 16; const size_t idx = (size_t)row * D + col0; float s = 0.f;
#pragma unroll
                for (int bj = 0; bj < 2; ++bj) { const f32x4 v0 = *(const f32x4*)(x + idx + bj * HALF) + acc[ai][bj][m][0], v1 = *(const f32x4*)(x + idx + bj * HALF + 4) + acc[ai][bj][m][1];
                    *(f32x4*)(out + idx + bj * HALF) = v0; *(f32x4*)(out + idx + bj * HALF + 4) = v1; s += sq4(v0) + sq4(v1);
                    u32x4 w; w.x = cvt_pk_bf16(v0[0], v0[1]); w.y = cvt_pk_bf16(v0[2], v0[3]); w.z = cvt_pk_bf16(v1[0], v1[1]); w.w = cvt_pk_bf16(v1[2], v1[3]);
                    *(u32x4*)(x1b + idx + bj * HALF) = w; }
                s += __shfl_xor(s, 16); s += __shfl_xor(s, 32);
                if (fq == 0) ssp[(size_t)row * 16 + u.pn * 4 + wc] = s; }
    }
};
struct EpiPP {
    static constexpr bool PERM = true, AFTER_DRAIN = false;
    bf16_t* pp;
    __device__ __forceinline__ void operator()(const f32x4 (&acc)[2][2][4][2], const Unit& u, int wr, int wc, int fr, int fq) const {
        const int row0 = u.pm * BM + wr * 64 + fr, col0 = u.pn * BM + wc * 32 + 8 * fq;
#pragma unroll
        for (int ai = 0; ai < 2; ++ai)
#pragma unroll
            for (int m = 0; m < 4; ++m) { const size_t idx = (size_t)(row0 + ai * HALF + m * 16) * D + col0;
#pragma unroll
                for (int bj = 0; bj < 2; ++bj) { const f32x4 v0 = acc[ai][bj][m][0], v1 = acc[ai][bj][m][1];
                    u32x4 w; w.x = cvt_pk_bf16(v0[0], v0[1]); w.y = cvt_pk_bf16(v0[2], v0[3]); w.z = cvt_pk_bf16(v1[0], v1[1]); w.w = cvt_pk_bf16(v1[2], v1[3]);
                    *(u32x4*)(pp + idx + bj * HALF) = w; } }
    }
};
struct EpiGate {
    static constexpr bool PERM = true, AFTER_DRAIN = false;
    float* out; const bf16_t* pp; const float* ssp1; float* ssp2;
    __device__ __forceinline__ void operator()(const f32x4 (&acc)[2][2][4][2], const Unit& u, int wr, int wc, int fr, int fq) const {
        const int row0 = u.pm * BM + wr * 64 + fr, col0 = u.pn * BM + wc * 32 + 8 * fq;
#pragma unroll
        for (int ai = 0; ai < 2; ++ai)
#pragma unroll
            for (int m = 0; m < 4; ++m) { const int row = row0 + ai * HALF + m * 16; const size_t idx = (size_t)row * D + col0;
                const f32x4* sp = (const f32x4*)(ssp1 + (size_t)row * 16); const f32x4 t4 = (sp[0] + sp[1]) + (sp[2] + sp[3]);
                const float r1 = rsqrtf(((t4[0] + t4[1]) + (t4[2] + t4[3])) * (1.f / D) + EPS); float s = 0.f;
#pragma unroll
                for (int bj = 0; bj < 2; ++bj) { const u32x4 pw = *(const u32x4*)(pp + idx + bj * HALF); const f32x4 a0 = acc[ai][bj][m][0] * r1, a1 = acc[ai][bj][m][1] * r1;
                    const f32x4 g0 = (f32x4){sigmoidf_(a0[0]), sigmoidf_(a0[1]), sigmoidf_(a0[2]), sigmoidf_(a0[3])}, g1 = (f32x4){sigmoidf_(a1[0]), sigmoidf_(a1[1]), sigmoidf_(a1[2]), sigmoidf_(a1[3])};
                    const f32x4 p0 = (f32x4){bflo(pw.x), bfhi(pw.x), bflo(pw.y), bfhi(pw.y)}, p1 = (f32x4){bflo(pw.z), bfhi(pw.z), bflo(pw.w), bfhi(pw.w)};
                    const f32x4 v0 = *(const f32x4*)(out + idx + bj * HALF) + g0 * p0, v1 = *(const f32x4*)(out + idx + bj * HALF + 4) + g1 * p1;
                    *(f32x4*)(out + idx + bj * HALF) = v0; *(f32x4*)(out + idx + bj * HALF + 4) = v1; s += sq4(v0) + sq4(v1); }
                s += __shfl_xor(s, 16); s += __shfl_xor(s, 32);
                if (fq == 0) ssp2[(size_t)row * 16 + u.pn * 4 + wc] = s; }
    }
};
template <class Epi, class Sched, bool ALIGN_EPI = false, bool SP2 = false>
__device__ __forceinline__ void gemm_phase(PG8_LAS unsigned char* lds, const Gemm g, const Sched& S, const Epi& E) {
    int tid_ = threadIdx.x; asm volatile("" : "+v"(tid_));
    const int tid = tid_, wid = __builtin_amdgcn_readfirstlane(tid >> 6), lane = tid & 63, wr = wid >> 2, wc = wid & 3, fr = lane & 15, fq = lane >> 4;
    int K_ = g.K; asm volatile("" : "+s"(K_));
    const int K = K_, nt = K / BK;
    unsigned voffA[2], voffB[2];
#pragma unroll
    for (int i = 0; i < 2; ++i) { int R, C; stage_rc(tid * 16 + i * 8192, R, C); const int Rb = Epi::PERM ? ((R & ~31) + perm32(R & 31)) : R;
        voffA[i] = (unsigned)(R * K + C) * 2u; voffB[i] = (unsigned)(Rb * K + C) * 2u; }
    const size_t kstep = (size_t)(BK * 2);
    const size_t hstep = (size_t)HALF * K * 2;
    const size_t tstep = 2 * hstep;
    const unsigned ldsw = (unsigned)wid * 1024u;
    const int aoff = lds_byte(wr * 64 + fr, fq * 8), boff = lds_byte(wc * 32 + fr, fq * 8);
#define PG8_SA(b, h) (((b) * 2 + (h)) * HTB)
#define PG8_SB(b, h) ((4 + (b) * 2 + (h)) * HTB)
#define PG8_STAGE(bufoff, gbase, voff) do { _Pragma("unroll") for (int _i = 0; _i < 2; ++_i) \
        __builtin_amdgcn_global_load_lds((const unsigned*)((const char*)(gbase) + (voff)[_i]), (PG8_LAS unsigned*)(lds + (bufoff) + ldsw + _i * 8192), 16, 0, 0); } while (0)
#define PG8_LDA(dst, b, h) do { _Pragma("unroll") for (int m = 0; m < 4; ++m) _Pragma("unroll") for (int k = 0; k < 2; ++k) dst[m][k] = *(const PG8_LAS bf16x8*)(lds + PG8_SA(b, h) + aoff + m * 2048 + k * 1024); } while (0)
#define PG8_LDB(dst, b, h) do { _Pragma("unroll") for (int n = 0; n < 2; ++n) _Pragma("unroll") for (int k = 0; k < 2; ++k) dst[n][k] = *(const PG8_LAS bf16x8*)(lds + PG8_SB(b, h) + boff + n * 2048 + k * 1024); } while (0)
#define PG8_MMA(ai, bj, At, Bt) do { __builtin_amdgcn_s_setprio(1); _Pragma("unroll") for (int m = 0; m < 4; ++m) _Pragma("unroll") for (int n = 0; n < 2; ++n) _Pragma("unroll") for (int k = 0; k < 2; ++k) \
        acc[ai][bj][m][n] = __builtin_amdgcn_mfma_f32_16x16x32_bf16(Bt[n][k], At[m][k], acc[ai][bj][m][n], 0, 0, 0); __builtin_amdgcn_s_setprio(0); } while (0)
#define PG8_WAIT_V(n) asm volatile("s_waitcnt vmcnt(" #n ")" ::: "memory")
#define PG8_WAIT_L(n) asm volatile("s_waitcnt lgkmcnt(" #n ")" ::: "memory")
#define PG8_BAR __builtin_amdgcn_s_barrier()
#define PG8_SCHED __builtin_amdgcn_sched_barrier(0)
    Unit cur, nxt; int ui = 0;
    if (!S.next(0, cur)) return;
    f32x4 acc[2][2][4][2];
#pragma unroll
    for (int a = 0; a < 2; ++a)
#pragma unroll
        for (int b = 0; b < 2; ++b)
#pragma unroll
            for (int m = 0; m < 4; ++m)
#pragma unroll
                for (int n = 0; n < 2; ++n) acc[a][b][m][n] = (f32x4){0.f, 0.f, 0.f, 0.f};
    bf16x8 At[4][2], B0[2][2], B1[2][2];
    const char* cA = (const char*)g.A + (size_t)cur.pm * tstep; const char* cB = (const char*)g.Bt + (size_t)cur.pn * tstep;
    S.a_ready(cur);
    if constexpr (SP2) {
        PG8_STAGE(PG8_SB(0, 0), cB, voffB); PG8_STAGE(PG8_SB(0, 1), cB + hstep, voffB); PG8_STAGE(PG8_SA(0, 0), cA, voffA); PG8_STAGE(PG8_SA(0, 1), cA + hstep, voffA);
        if (wr == 1) PG8_BAR;
        PG8_WAIT_V(2); PG8_BAR;
        PG8_STAGE(PG8_SB(1, 0), cB + kstep, voffB); PG8_STAGE(PG8_SA(1, 0), cA + kstep, voffA); PG8_STAGE(PG8_SB(1, 1), cB + hstep + kstep, voffB);
        PG8_WAIT_V(6); PG8_BAR;
    } else {
        PG8_STAGE(PG8_SB(0, 0), cB, voffB); PG8_STAGE(PG8_SA(0, 0), cA, voffA); PG8_STAGE(PG8_SB(0, 1), cB + hstep, voffB); PG8_STAGE(PG8_SA(0, 1), cA + hstep, voffA);
        if (wr == 1) PG8_BAR;
        PG8_WAIT_V(4); PG8_BAR;
        PG8_STAGE(PG8_SB(1, 0), cB + kstep, voffB); PG8_STAGE(PG8_SA(1, 0), cA + kstep, voffA); PG8_STAGE(PG8_SB(1, 1), cB + hstep + kstep, voffB);
        PG8_WAIT_V(6); PG8_BAR;
    }
    for (;;) {
        const bool has_next = S.next(ui + 1, nxt);
        const char* nA = has_next ? (const char*)g.A + (size_t)nxt.pm * tstep : cA; const char* nB = has_next ? (const char*)g.Bt + (size_t)nxt.pn * tstep : cB;
        for (int t = 0; t < nt; t += 2) {
            const bool last = (t == nt - 2);
            const char* a1 = cA + (size_t)(t + 1) * kstep;
            const char* a2 = last ? nA : cA + (size_t)(t + 2) * kstep; const char* b2 = last ? nB : cB + (size_t)(t + 2) * kstep;
            const char* a3 = a2 + kstep; const char* b3 = b2 + kstep;
            if (last && has_next) S.a_ready(nxt);
            if constexpr (SP2) {
            PG8_LDB(B0, 0, 0); PG8_LDB(B1, 0, 1); PG8_SCHED; PG8_LDA(At, 0, 0); PG8_STAGE(PG8_SA(1, 1), a1 + hstep, voffA);
            PG8_WAIT_V(8); PG8_WAIT_L(0); PG8_BAR; PG8_MMA(0, 0, At, B0); PG8_MMA(0, 1, At, B1); PG8_BAR; PG8_SCHED;
            PG8_LDA(At, 0, 1); PG8_STAGE(PG8_SB(0, 0), b2, voffB); PG8_STAGE(PG8_SB(0, 1), b2 + hstep, voffB); PG8_STAGE(PG8_SA(0, 0), a2, voffA);
            PG8_WAIT_V(8); PG8_WAIT_L(0); PG8_BAR; PG8_MMA(1, 0, At, B0); PG8_MMA(1, 1, At, B1); PG8_BAR; PG8_SCHED;
            PG8_LDB(B0, 1, 0); PG8_LDB(B1, 1, 1); PG8_SCHED; PG8_LDA(At, 1, 0); PG8_STAGE(PG8_SA(0, 1), a2 + hstep, voffA);
            PG8_WAIT_V(8); PG8_WAIT_L(0); PG8_BAR; PG8_MMA(0, 0, At, B0); PG8_MMA(0, 1, At, B1); PG8_BAR; PG8_SCHED;
            PG8_LDA(At, 1, 1); PG8_STAGE(PG8_SB(1, 0), b3, voffB); PG8_STAGE(PG8_SB(1, 1), b3 + hstep, voffB); PG8_STAGE(PG8_SA(1, 0), a3, voffA);
            PG8_WAIT_V(8); PG8_WAIT_L(0); PG8_BAR; PG8_MMA(1, 0, At, B0); PG8_MMA(1, 1, At, B1); PG8_BAR; PG8_SCHED;
            } else {
            PG8_LDB(B0, 0, 0); PG8_SCHED; PG8_LDA(At, 0, 0); PG8_STAGE(PG8_SA(1, 1), a1 + hstep, voffA);
            PG8_WAIT_L(8); PG8_BAR; PG8_WAIT_L(0); PG8_MMA(0, 0, At, B0); PG8_BAR; PG8_SCHED;
            PG8_LDB(B1, 0, 1); PG8_STAGE(PG8_SB(0, 0), b2, voffB);
            PG8_BAR; PG8_WAIT_L(0); PG8_MMA(0, 1, At, B1); PG8_BAR;
            PG8_LDA(At, 0, 1); PG8_STAGE(PG8_SA(0, 0), a2, voffA);
            PG8_BAR; PG8_WAIT_L(0); PG8_MMA(1, 0, At, B0); PG8_BAR; PG8_SCHED;
            PG8_STAGE(PG8_SB(0, 1), b2 + hstep, voffB);
            PG8_WAIT_V(6); PG8_BAR; PG8_MMA(1, 1, At, B1); PG8_BAR;
            PG8_LDB(B0, 1, 0); PG8_SCHED; PG8_LDA(At, 1, 0); PG8_STAGE(PG8_SA(0, 1), a2 + hstep, voffA);
            PG8_WAIT_L(8); PG8_BAR; PG8_WAIT_L(0); PG8_MMA(0, 0, At, B0); PG8_BAR; PG8_SCHED;
            PG8_LDB(B1, 1, 1); PG8_STAGE(PG8_SB(1, 0), b3, voffB);
            PG8_BAR; PG8_WAIT_L(0); PG8_MMA(0, 1, At, B1); PG8_BAR;
            PG8_LDA(At, 1, 1); PG8_STAGE(PG8_SA(1, 0), a3, voffA);
            PG8_BAR; PG8_WAIT_L(0); PG8_MMA(1, 0, At, B0); PG8_BAR; PG8_SCHED;
            PG8_STAGE(PG8_SB(1, 1), b3 + hstep, voffB);
            PG8_WAIT_V(6); PG8_BAR; PG8_MMA(1, 1, At, B1); PG8_BAR;
            }
        }
        if constexpr (ALIGN_EPI) { if (wr == 0) PG8_BAR; }
        if constexpr (!Epi::AFTER_DRAIN) { E(acc, cur, wr, wc, fr, fq); S.done(cur); }
        if (!has_next) break;
#pragma unroll
        for (int a = 0; a < 2; ++a)
#pragma unroll
            for (int b = 0; b < 2; ++b)
#pragma unroll
                for (int m = 0; m < 4; ++m)
#pragma unroll
                    for (int n = 0; n < 2; ++n) acc[a][b][m][n] = (f32x4){0.f, 0.f, 0.f, 0.f};
        cur = nxt; cA = nA; cB = nB; ++ui;
        if constexpr (ALIGN_EPI) { if (wr == 1) PG8_BAR; }
    }
    PG8_WAIT_V(0);
    if constexpr (!ALIGN_EPI) { if (wr == 0) PG8_BAR; }
    PG8_BAR;
    if constexpr (Epi::AFTER_DRAIN) { E.fused(acc, cur, wr, wc, fr, fq, lds, wid, lane); S.done(cur); }
#undef PG8_SA
#undef PG8_SB
#undef PG8_STAGE
#undef PG8_LDA
#undef PG8_LDB
#undef PG8_MMA
#undef PG8_WAIT_V
#undef PG8_WAIT_L
#undef PG8_BAR
#undef PG8_SCHED
}
}
#define XB_TMO      128
#define XB_XCNT(j)  (256  + 64 * (j))
#define XB_XSUB(j)  (1280 + 64 * (j))
#define XB_XGEN(j)  (2304 + 64 * (j))
#define XB_TOP      3328
#define XB_TOPGEN   3392
#define XCD_BAR_WORDS 3456
#define XB_SPIN_CAP (1u << 18)

__device__ __forceinline__ unsigned xb_ld(unsigned* p)              { return __hip_atomic_load(p, __ATOMIC_RELAXED, __HIP_MEMORY_SCOPE_AGENT); }
__device__ __forceinline__ unsigned xb_add(unsigned* p, unsigned v) { return __hip_atomic_fetch_add(p, v, __ATOMIC_RELAXED, __HIP_MEMORY_SCOPE_AGENT); }
__device__ __forceinline__ unsigned xb_xcc_id() { return (unsigned)__builtin_amdgcn_s_getreg((3 << 11) | 20) & 0xFu; }
#define XB_SPIN(cond, bar) do { unsigned _sp = 0; while (cond) { __builtin_amdgcn_s_sleep(1); \
    if ((++_sp & 255u) == 0u) { if (xb_ld(&(bar)[XB_TMO])) break; if (_sp > XB_SPIN_CAP) { atomicAdd(&(bar)[XB_TMO], 1u); break; } } } } while (0)

struct XcdBarrier {
    unsigned* bar; unsigned x;
    volatile LAS unsigned* st;
};

__device__ __forceinline__ XcdBarrier xcd_barrier_post(unsigned* bar, volatile LAS unsigned* st) {
    XcdBarrier b; b.bar = bar; b.x = xb_xcc_id(); b.st = st;
    if (threadIdx.x == 0) (void)xb_add(&bar[XB_XCNT(b.x)], 1u);
    return b;
}
__device__ __forceinline__ void xcd_barrier_complete(unsigned* bar, unsigned x, unsigned& nloc, unsigned& nx) {
    const unsigned G = gridDim.x * gridDim.y * gridDim.z;
    unsigned sum, cnt, mine, sp = 0u;
    for (;;) {
        sum = 0u; cnt = 0u; mine = 0u;
#pragma unroll
        for (unsigned j = 0; j < 16; ++j) { const unsigned c = xb_ld(&bar[XB_XCNT(j)]); sum += c; cnt += (c > 0u) ? 1u : 0u; mine = (j == x) ? c : mine; }
        if (sum == G) break;
        __builtin_amdgcn_s_sleep(1);
        if ((++sp & 255u) == 0u) { if (xb_ld(&bar[XB_TMO])) break; if (sp > XB_SPIN_CAP) { atomicAdd(&bar[XB_TMO], 1u); break; } }
    }
    nloc = mine > 0u ? mine : 1u; nx = cnt > 0u ? cnt : 1u;
}

__device__ __forceinline__ void xcd_barrier(const XcdBarrier& b) {
    asm volatile("s_waitcnt vmcnt(0)" ::: "memory");
    __syncthreads();
    if (threadIdx.x == 0) {
        unsigned* bar = b.bar;
        __builtin_amdgcn_s_waitcnt(0);
        unsigned nloc = b.st[0], nx = b.st[1];
        if (nloc == 0u) { xcd_barrier_complete(bar, b.x, nloc, nx); b.st[0] = nloc; b.st[1] = nx; }
        const unsigned old = xb_add(&bar[XB_XSUB(b.x)], 1u);
        const unsigned gen = old / nloc;
        if (old + 1u == (gen + 1u) * nloc) {
            __builtin_amdgcn_fence(__ATOMIC_RELEASE, "agent");
            asm volatile("s_waitcnt vmcnt(0)" ::: "memory");
            const unsigned og = xb_add(&bar[XB_TOP], 1u);
            const unsigned tg = og / nx;
            if (og + 1u == (tg + 1u) * nx) xb_add(&bar[XB_TOPGEN], 1u);
            else XB_SPIN(xb_ld(&bar[XB_TOPGEN]) == tg, bar);
            __builtin_amdgcn_fence(__ATOMIC_ACQUIRE, "agent");
            xb_add(&bar[XB_XGEN(b.x)], 1u);
            asm volatile("s_waitcnt vmcnt(0)" ::: "memory");
        } else {
            XB_SPIN(xb_ld(&bar[XB_XGEN(b.x)]) == gen, bar);
            __builtin_amdgcn_fence(__ATOMIC_ACQUIRE, "agent");
            asm volatile("s_waitcnt vmcnt(0)" ::: "memory");
        }
    }
    __syncthreads();
}
constexpr int NWAVES = 8;
constexpr int RING_OFF = 0, RING_BYTES = 131072;
constexpr int LDSCTL_OFF = RING_BYTES, MISC_OFF = LDSCTL_OFF + 320;
constexpr int LDS_BYTES = 147456;

struct Frame {
    LAS unsigned char* lds; volatile LAS unsigned* MISC;
    int tid, lane, wave, G, vcu;
    const float* in[15]; float* out; unsigned char* ws;
};

__device__ __forceinline__ void prep_w_item(const float* W, const float* gain, int K, int Nsrc, bool map, bf16_t* Wt, LAS float* scr, int item, int nblk, int lane) {
    const int kb = item / nblk, nb = item % nblk, k0 = 64 * kb, n0 = 32 * nb;
    const int nn = n0 + (lane & 31); const int e = map ? inmap(nn) : nn;
#pragma unroll 8
    for (int i = 0; i < 32; ++i) { const int kk = 2 * i + (lane >> 5); float v = 0.f;
        if (e >= 0) v = W[(size_t)(k0 + kk) * Nsrc + e] * (gain ? gain[k0 + kk] : 1.f);
        scr[kk * 33 + (lane & 31)] = v; }
    LDS_WAIT(); asm volatile("" ::: "memory");
    const int c = lane & 7;
#pragma unroll
    for (int j = 0; j < 4; ++j) { const int n = (lane >> 3) + 8 * j; const LAS float* s = scr + (8 * c) * 33 + n;
        u32x4 o; o.x = pk2(s[0 * 33], s[1 * 33]); o.y = pk2(s[2 * 33], s[3 * 33]); o.z = pk2(s[4 * 33], s[5 * 33]); o.w = pk2(s[6 * 33], s[7 * 33]);
        *(u32x4*)(Wt + (size_t)(n0 + n) * K + k0 + 8 * c) = o; }
    LDS_WAIT(); asm volatile("" ::: "memory");
}
__device__ __forceinline__ void p0_prep(Frame& F) {
    LAS float* scr = (LAS float*)(F.lds + RING_OFF + F.wave * 16384);
    int tid_ = threadIdx.x; asm volatile("" : "+v"(tid_));
    const int lane = tid_ & 63, gw = F.vcu * NWAVES + __builtin_amdgcn_readfirstlane(tid_ >> 6), NGW = F.G * NWAVES;
    unsigned char* ws = F.ws;
    constexpr int I_IN = (D / 64) * (NINP / 32), I_A = (DC / 64) * (D / 32), I_O = (D / 64) * (D / 32), I_P = (DPLE / 64) * (D / 32);
    constexpr int NITEMS = I_IN + 2 * I_A + 2 * I_O + I_P;
    for (int it = gw; it < NITEMS; it += NGW) {
        int r = it;
        if (r < I_IN) { prep_w_item(F.in[3], F.in[2], D, NIN, true, (bf16_t*)(ws + WS_WIN), scr, r, NINP / 32, lane); continue; } r -= I_IN;
        if (r < I_A) { prep_w_item(F.in[8], nullptr, DC, D, false, (bf16_t*)(ws + WS_WA), scr, r, D / 32, lane); continue; } r -= I_A;
        if (r < I_A) { prep_w_item(F.in[9], nullptr, DC, D, false, (bf16_t*)(ws + WS_WB), scr, r, D / 32, lane); continue; } r -= I_A;
        if (r < I_O) { prep_w_item(F.in[10], nullptr, D, D, false, (bf16_t*)(ws + WS_WO), scr, r, D / 32, lane); continue; } r -= I_O;
        if (r < I_O) { prep_w_item(F.in[12], F.in[11], D, D, false, (bf16_t*)(ws + WS_WG), scr, r, D / 32, lane); continue; } r -= I_O;
        prep_w_item(F.in[13], nullptr, DPLE, D, false, (bf16_t*)(ws + WS_WP), scr, r, D / 32, lane);
    }
    const float* x = F.in[0]; const float* p = F.in[1]; bf16_t* xb = (bf16_t*)(ws + WS_XB); bf16_t* pb = (bf16_t*)(ws + WS_PB); float* rinv = (float*)(ws + WS_RINV);
    for (int m = gw; m < M; m += NGW) {
        const f32x4* xr = (const f32x4*)(x + (size_t)m * D) + lane; f32x4 v[4]; float s = 0.f;
#pragma unroll
        for (int j = 0; j < 4; ++j) { v[j] = xr[64 * j]; s += (v[j].x * v[j].x + v[j].y * v[j].y) + (v[j].z * v[j].z + v[j].w * v[j].w); }
        s = wave_sum(s);
        if (lane == 0) rinv[m] = rsqrtf(s * (1.f / D) + EPS);
        u32x2* o = (u32x2*)(xb + (size_t)m * D) + lane;
#pragma unroll
        for (int j = 0; j < 4; ++j) { u32x2 w; w.x = pk2(v[j].x, v[j].y); w.y = pk2(v[j].z, v[j].w); o[64 * j] = w; }
        const f32x4 pv = ((const f32x4*)(p + (size_t)m * DPLE))[lane];
        u32x2 w; w.x = pk2(pv.x, pv.y); w.y = pk2(pv.z, pv.w); ((u32x2*)(pb + (size_t)m * DPLE))[lane] = w;
    }
}

constexpr int CF_TOK = 128, CF_CH = 16;
__device__ __forceinline__ void p2_conformer(Frame& F) {
    LAS float* red = (LAS float*)(F.lds + RING_OFF);
    const bf16_t* cin = (const bf16_t*)(F.ws + WS_CIN); const bf16_t* cz = (const bf16_t*)(F.ws + WS_CZ); bf16_t* ya = (bf16_t*)(F.ws + WS_YA);
    const float* conv_w = F.in[4];
    int tid_ = threadIdx.x; asm volatile("" : "+v"(tid_));
    const int ch = tid_, lane = tid_ & 63, wv = __builtin_amdgcn_readfirstlane(tid_ >> 6);
    float w[CWID];
#pragma unroll
    for (int j = 0; j < CWID; ++j) w[j] = conv_w[j * DC + ch];
    const float cb = F.in[5][ch], g = F.in[6][ch], bb = F.in[7][ch];
    for (int item = F.vcu; item < M / CF_TOK; item += F.G) {
        const int b = item / (SEQ / CF_TOK), t0 = (item % (SEQ / CF_TOK)) * CF_TOK; const size_t rowb = (size_t)b * SEQ;
        float u[CF_CH + CWID - 1];
#pragma unroll
        for (int i = 0; i < CWID - 1; ++i) { const int t = t0 - (CWID - 1) + i; float v = 0.f;
            if (t >= 0) { const float a = bf2f(cin[(rowb + t) * 1024 + ch]), gt = bf2f(cin[(rowb + t) * 1024 + 512 + ch]); v = a * sigmoidf_(gt); }
            u[i] = v; }
        for (int tc = t0; tc < t0 + CF_TOK; tc += CF_CH) {
#pragma unroll
            for (int i = 0; i < CF_CH; ++i) { const size_t r = (rowb + tc + i) * 1024; const float a = bf2f(cin[r + ch]), gt = bf2f(cin[r + 512 + ch]); u[CWID - 1 + i] = a * sigmoidf_(gt); }
            float c[CF_CH];
#pragma unroll
            for (int i = 0; i < CF_CH; ++i) { float s = cb;
#pragma unroll
                for (int j = 0; j < CWID; ++j) s = fmaf(w[j], u[i + j], s);
                c[i] = s; }
#pragma unroll
            for (int i = 0; i < CF_CH; ++i) { const float s1 = wave_sum(c[i]), s2 = wave_sum(c[i] * c[i]); if (lane == 0) { red[wv * 32 + 2 * i] = s1; red[wv * 32 + 2 * i + 1] = s2; } }
            __syncthreads();
#pragma unroll
            for (int i = 0; i < CF_CH; ++i) { float s1 = 0.f, s2 = 0.f;
#pragma unroll
                for (int q = 0; q < 8; ++q) { s1 += red[q * 32 + 2 * i]; s2 += red[q * 32 + 2 * i + 1]; }
                const float mu = s1 * (1.f / DC), var = fmaxf(s2 * (1.f / DC) - mu * mu, 0.f), rs = rsqrtf(var + EPS);
                const float y = (c[i] - mu) * rs * g + bb; const float z = bf2f(cz[(rowb + tc + i) * DC + ch]);
                ya[(rowb + tc + i) * DC + ch] = f2bf(siluf_(y) * siluf_(z)); }
            __syncthreads();
#pragma unroll
            for (int i = 0; i < CWID - 1; ++i) u[i] = u[i + CF_CH];
        }
    }
}

typedef short bf16x8 __attribute__((ext_vector_type(8)));
typedef float f32x16 __attribute__((ext_vector_type(16)));
constexpr size_t WS_MASK = 448 * MiB;
__device__ __forceinline__ unsigned skey(float f) { const unsigned u = __float_as_uint(f + 0.f); return (u & 0x80000000u) ? ~u : (u | 0x80000000u); }
__device__ __forceinline__ int half_sum(int v) {
#pragma unroll
    for (int o = 1; o < 32; o <<= 1) v += __shfl_xor(v, o);
    return v;
}
__device__ __forceinline__ void attn_pass1(Frame& F, int b, int qb, LAS unsigned char* lds, unsigned* maskbuf) {
    int tid_ = threadIdx.x; asm volatile("" : "+v"(tid_));
    const int lane = tid_ & 63, w = __builtin_amdgcn_readfirstlane(tid_ >> 6), col = lane & 31, half = lane >> 5;
    const bf16_t* iq = (const bf16_t*)(F.ws + WS_IQ); const bf16_t* sm = (const bf16_t*)(F.ws + WS_SM);
    const size_t rowb = (size_t)b * SEQ; const int t0 = 32 * qb; const size_t m0w = rowb + t0 + 4 * w;
    bf16x8 aq[4];
    { const int r = col, half_r = (r >> 2) & 1, qsel = r >> 4, head = (r & 3) + 4 * ((r >> 3) & 1), ql = 2 * half_r + qsel;
#pragma unroll
      for (int ks = 0; ks < 4; ++ks) aq[ks] = *(const bf16x8*)(iq + (m0w + ql) * 512 + head * 64 + 16 * ks + 8 * half); }
    float wr[16];
    { const u32x4 va = *(const u32x4*)(sm + (m0w + 2 * half) * 256 + 192), vb = *(const u32x4*)(sm + (m0w + 2 * half + 1) * 256 + 192);
      const float wa[8] = {bflo(va.x), bfhi(va.x), bflo(va.y), bfhi(va.y), bflo(va.z), bfhi(va.z), bflo(va.w), bfhi(va.w)};
      const float wb[8] = {bflo(vb.x), bfhi(vb.x), bflo(vb.y), bfhi(vb.y), bflo(vb.z), bfhi(vb.z), bflo(vb.w), bfhi(vb.w)};
      const float sc = 0.125f * 0.35355339059327373f;
#pragma unroll
      for (int i = 0; i < 8; ++i) { wr[i] = wa[(i & 3) + 4 * (i >> 2)] * sc; wr[8 + i] = wb[(i & 3) + 4 * (i >> 2)] * sc; } }
    int offk[4];
#pragma unroll
    for (int ks = 0; ks < 4; ++ks) offk[ks] = col * 128 + ((((2 * ks + half) ^ ((col >> 1) & 7))) << 4);
    const int nch = qb / 8 + 1;
#define AT_STAGE(c, bufsel) do { _Pragma("unroll") for (int i_ = 0; i_ < 4; ++i_) { const int seg = 4 * w + i_, kl = 8 * seg + (lane >> 3), sp = (lane & 7) ^ ((kl >> 1) & 7); \
        __builtin_amdgcn_global_load_lds((const unsigned*)(sm + (rowb + 256 * (c) + kl) * 256 + 128 + 8 * sp), (LAS unsigned*)(lds + (bufsel) * 32768 + seg * 1024), 16, 0, 0); } } while (0)
    unsigned kA[64], kB[64];
    AT_STAGE(0, 0);
    asm volatile("s_waitcnt vmcnt(0)" ::: "memory"); __syncthreads();
#pragma unroll
    for (int c = 0; c < 8; ++c) {
        if (c < nch) {
            if (c + 1 < nch) AT_STAGE(c + 1, (c + 1) & 1);
#pragma unroll
            for (int jj = 0; jj < 8; ++jj) { const int j = 8 * c + jj;
                if (j <= qb) {
                    bf16x8 bk[4];
#pragma unroll
                    for (int ks = 0; ks < 4; ++ks) bk[ks] = *(const LAS bf16x8*)(lds + (c & 1) * 32768 + jj * 4096 + offk[ks]);
                    f32x16 acc = {0.f, 0.f, 0.f, 0.f, 0.f, 0.f, 0.f, 0.f, 0.f, 0.f, 0.f, 0.f, 0.f, 0.f, 0.f, 0.f};
#pragma unroll
                    for (int ks = 0; ks < 4; ++ks) acc = __builtin_amdgcn_mfma_f32_32x32x16_bf16(aq[ks], bk[ks], acc, 0, 0, 0);
                    float sA = 0.f, sB = 0.f;
#pragma unroll
                    for (int i = 0; i < 8; ++i) { sA = fmaf(wr[i], fmaxf(acc[i], 0.f), sA); sB = fmaf(wr[8 + i], fmaxf(acc[8 + i], 0.f), sB); }
                    bool vA = true, vB = true;
                    if (j == qb) { vA = col <= 4 * w + 2 * half; vB = col <= 4 * w + 2 * half + 1; }
                    kA[j] = vA ? skey(sA) : 0u; kB[j] = vB ? skey(sB) : 0u;
                } else { kA[j] = 0u; kB[j] = 0u; }
            }
            asm volatile("s_waitcnt vmcnt(0)" ::: "memory"); __syncthreads();
        } else {
#pragma unroll
            for (int jj = 0; jj < 8; ++jj) { kA[8 * c + jj] = 0u; kB[8 * c + jj] = 0u; }
        }
    }
#undef AT_STAGE
    const int nA = t0 + 4 * w + 2 * half + 1, nB = nA + 1;
    unsigned prefA = 0u, prefB = 0u, thrA = 1u, thrB = 1u; bool exA = nA <= TOPK, exB = nB <= TOPK;
    for (int bit = 31; bit >= 0; --bit) {
        if (__all(exA && exB)) break;
        const unsigned candA = prefA | (1u << bit), candB = prefB | (1u << bit);
        int cA = 0, cB = 0;
#pragma unroll
        for (int g = 0; g < 8; ++g) if (g < nch) {
#pragma unroll
            for (int jj = 0; jj < 8; ++jj) { cA += (kA[8 * g + jj] >= candA) ? 1 : 0; cB += (kB[8 * g + jj] >= candB) ? 1 : 0; } }
        cA = half_sum(cA); cB = half_sum(cB);
        if (!exA) { if (cA == TOPK) { thrA = candA; exA = true; } else if (cA > TOPK) prefA = candA; }
        if (!exB) { if (cB == TOPK) { thrB = candB; exB = true; } else if (cB > TOPK) prefB = candB; }
    }
    const unsigned tA = exA ? thrA : prefA + 1u, tB = exB ? thrB : prefB + 1u;
    unsigned mA[2] = {0u, 0u}, mB[2] = {0u, 0u};
#pragma unroll
    for (int j = 0; j < 64; ++j) { mA[j >> 5] |= (kA[j] >= tA) ? (1u << (j & 31)) : 0u; mB[j >> 5] |= (kB[j] >= tB) ? (1u << (j & 31)) : 0u; }
    if (!__all(exA && exB)) {
        const int needA = TOPK - half_sum(__popc(mA[0]) + __popc(mA[1])), needB = TOPK - half_sum(__popc(mB[0]) + __popc(mB[1]));
        int befA = 0, befB = 0; const unsigned below = (1u << col) - 1u;
#pragma unroll
        for (int j = 0; j < 64; ++j) {
            const bool eA = !exA && kA[j] == prefA, eB = !exB && kB[j] == prefB;
            const unsigned long long balA = __ballot(eA), balB = __ballot(eB);
            const unsigned hA = half ? (unsigned)(balA >> 32) : (unsigned)balA, hB = half ? (unsigned)(balB >> 32) : (unsigned)balB;
            if (eA && befA + __popc(hA & below) < needA) mA[j >> 5] |= 1u << (j & 31);
            if (eB && befB + __popc(hB & below) < needB) mB[j >> 5] |= 1u << (j & 31);
            befA += __popc(hA); befB += __popc(hB);
        }
    }
#pragma unroll
    for (int j = 0; j < 64; ++j) {
        const unsigned long long wa = __ballot((mA[j >> 5] >> (j & 31)) & 1u), wb = __ballot((mB[j >> 5] >> (j & 31)) & 1u);
        if (lane == 0) { maskbuf[(m0w + 0) * 64 + j] = (unsigned)wa; maskbuf[(m0w + 2) * 64 + j] = (unsigned)(wa >> 32); maskbuf[(m0w + 1) * 64 + j] = (unsigned)wb; maskbuf[(m0w + 3) * 64 + j] = (unsigned)(wb >> 32); }
    }
}

__device__ __forceinline__ void attn_naive_masked(Frame& F, int b, int qb, LAS unsigned char* ldsb, const unsigned* maskbuf) {
    const bf16_t* qbuf = (const bf16_t*)(F.ws + WS_Q); const bf16_t* sm = (const bf16_t*)(F.ws + WS_SM); const bf16_t* az = (const bf16_t*)(F.ws + WS_AZ); bf16_t* yb = (bf16_t*)(F.ws + WS_YB);
    int tid_ = threadIdx.x; asm volatile("" : "+v"(tid_));
    const int hb = tid_ >> 8, tid = tid_ & 255, lane = tid_ & 63, wv = (tid_ >> 6) & 3;
    LAS unsigned char* base = ldsb + hb * 16384;
    LAS float* qq = (LAS float*)base;
    LAS int* nselp = (LAS int*)(base + 2048);
    LAS int* sel = (LAS int*)(base + 2048 + 64);
    LAS float* pr = (LAS float*)(base + 4096);
    const size_t rowb = (size_t)b * SEQ;
    for (int itq = 0; itq < 32; itq += 2) {
        const int t = 32 * qb + itq + hb, n = t + 1; const size_t m = rowb + t;
        __syncthreads();
        for (int i = tid; i < 512; i += 256) qq[i] = bf2f(qbuf[m * 512 + i]);
        if (tid == 0) nselp[0] = 0;
        __syncthreads();
        for (int s = tid; s < n; s += 256) { if ((maskbuf[m * 64 + (s >> 5)] >> (s & 31)) & 1u) { const int pos = atomicAdd((int*)&nselp[0], 1); if (pos < TOPK) sel[pos] = s; } }
        __syncthreads();
        const int nsel = nselp[0] < TOPK ? nselp[0] : TOPK;
        { const int j = tid; float lg[8];
          if (j < nsel) { const int s = sel[j]; const bf16_t* kr = sm + (rowb + s) * 256; float dd[8];
#pragma unroll
              for (int h = 0; h < 8; ++h) dd[h] = 0.f;
#pragma unroll 1
              for (int c2 = 0; c2 < 8; ++c2) { const u32x4 v = ((const u32x4*)kr)[c2]; const float kf[8] = {bflo(v.x), bfhi(v.x), bflo(v.y), bfhi(v.y), bflo(v.z), bfhi(v.z), bflo(v.w), bfhi(v.w)};
#pragma unroll
                  for (int h = 0; h < 8; ++h)
#pragma unroll
                      for (int e = 0; e < 8; ++e) dd[h] = fmaf(qq[h * 64 + c2 * 8 + e], kf[e], dd[h]); }
#pragma unroll
              for (int h = 0; h < 8; ++h) lg[h] = dd[h] * 0.125f - exp2f(-(float)(h + 1)) * (float)(t - s); }
          else {
#pragma unroll
              for (int h = 0; h < 8; ++h) lg[h] = -INFINITY; }
#pragma unroll
          for (int h = 0; h < 8; ++h) pr[h * 256 + j] = lg[h]; }
        __syncthreads();
#pragma unroll
        for (int hh = 0; hh < 2; ++hh) { const int h = 2 * wv + hh; float v[4]; float mx = -INFINITY;
#pragma unroll
            for (int i = 0; i < 4; ++i) { v[i] = pr[h * 256 + lane + 64 * i]; mx = fmaxf(mx, v[i]); }
#pragma unroll
            for (int o = 1; o < 64; o <<= 1) mx = fmaxf(mx, __shfl_xor(mx, o));
            float s = 0.f;
#pragma unroll
            for (int i = 0; i < 4; ++i) { v[i] = __expf(v[i] - mx); s += v[i]; }
            s = wave_sum(s); const float inv = 1.f / s;
#pragma unroll
            for (int i = 0; i < 4; ++i) pr[h * 256 + lane + 64 * i] = v[i] * inv; }
        __syncthreads();
        { const int h = tid >> 5, d = 2 * (tid & 31); float o0 = 0.f, o1 = 0.f;
          for (int j = 0; j < nsel; ++j) { const unsigned vv = *(const unsigned*)(sm + (rowb + sel[j]) * 256 + 64 + d); const float pj = pr[h * 256 + j];
              o0 = fmaf(pj, bflo(vv), o0); o1 = fmaf(pj, bfhi(vv), o1); }
          const unsigned zz = *(const unsigned*)(az + m * 512 + h * 64 + d);
          *(unsigned*)(yb + m * 512 + h * 64 + d) = pk2(o0 * siluf_(bflo(zz)), o1 * siluf_(bfhi(zz))); }
    }
    __syncthreads();
}
__device__ __forceinline__ void p2_attn(Frame& F) {
    unsigned* maskbuf = (unsigned*)(F.ws + WS_MASK);
    const int b = F.vcu >> 4, r = F.vcu & 15;
    for (int i = 0; i < 4; ++i) { const int qb = (i == 0) ? r : (i == 1) ? 31 - r : (i == 2) ? 32 + r : 63 - r;
        attn_pass1(F, b, qb, F.lds + RING_OFF, maskbuf);
        asm volatile("s_waitcnt vmcnt(0)" ::: "memory"); __syncthreads();
        attn_naive_masked(F, b, qb, F.lds + RING_OFF + 65536, maskbuf);
    }
}

__device__ __forceinline__ void p6_final(Frame& F) {
    float* out = F.out; const float* ssp2 = (const float*)(F.ws + WS_SSP2); const float* fg = F.in[14];
    int tid_ = threadIdx.x; asm volatile("" : "+v"(tid_));
    const int lane = tid_ & 63, gw = F.vcu * NWAVES + __builtin_amdgcn_readfirstlane(tid_ >> 6), NGW = F.G * NWAVES;
    for (int m = gw; m < M; m += NGW) { float s = (lane < 16) ? ssp2[(size_t)m * 16 + lane] : 0.f; s = wave_sum(s);
        const float r = rsqrtf(s * (1.f / D) + EPS); f32x4* o = (f32x4*)(out + (size_t)m * D) + lane;
#pragma unroll
        for (int j = 0; j < 4; ++j) { const f32x4 gv = ((const f32x4*)fg)[lane + 64 * j]; f32x4 v = o[64 * j]; v = v * r * gv; o[64 * j] = v; } }
}

struct Args { const float* in[15]; float* out; unsigned char* ws; };
__global__ void __launch_bounds__(NWAVES * 64, 2) fwd_kernel(Args args) {
    extern __shared__ __attribute__((aligned(16))) unsigned char lds_raw[];
    Frame F;
    F.lds = (LAS unsigned char*)lds_raw; F.MISC = (volatile LAS unsigned*)(F.lds + MISC_OFF);
    F.tid = threadIdx.x; F.lane = F.tid & 63; F.wave = __builtin_amdgcn_readfirstlane(F.tid >> 6);
    F.G = gridDim.x; { const int bx = blockIdx.x; F.vcu = (F.G % 8 == 0) ? (bx % 8) * (F.G / 8) + bx / 8 : bx; }
#pragma unroll
    for (int i = 0; i < 15; ++i) F.in[i] = args.in[i];
    F.out = args.out; F.ws = args.ws;
    unsigned char* ws = args.ws;
    for (int u = F.tid; u < (LDS_BYTES - LDSCTL_OFF) / 4; u += NWAVES * 64) ((LAS unsigned*)(F.lds + LDSCTL_OFF))[u] = 0u;
    __syncthreads();
    XcdBarrier bar = xcd_barrier_post((unsigned*)(ws + WS_CTL) + CW_BAR, F.MISC + 8);

#ifndef NO_P0
    p0_prep(F);
#endif
    xcd_barrier(bar);
    { pg8::Gemm g{(const bf16_t*)(ws + WS_XB), (const bf16_t*)(ws + WS_WIN), M, NINP, D}; pg8::StaticOrder S; S.init(M, NINP, F.G, (int)blockIdx.x);
      pg8::EpiInProj E{(const float*)(ws + WS_RINV), ws};
#ifndef NO_P1
      pg8::gemm_phase<pg8::EpiInProj, pg8::StaticOrder, true, true>(F.lds + RING_OFF, g, S, E);
#endif
    }
    xcd_barrier(bar);
#ifndef NO_P2A
    p2_conformer(F);
#endif
#ifndef NO_P2B
    p2_attn(F);
#endif
    xcd_barrier(bar);
    { pg8::Gemm g{(const bf16_t*)(ws + WS_YA), (const bf16_t*)(ws + WS_WA), M, D, DC}; pg8::StaticOrder S; S.init(M, D, F.G, (int)blockIdx.x);
      pg8::EpiOutA E{(const bf16_t*)(ws + WS_GA), F.out};
#ifndef NO_P3A
      pg8::gemm_phase<pg8::EpiOutA, pg8::StaticOrder, true, true>(F.lds + RING_OFF, g, S, E);
#endif
    }
    { pg8::Gemm g{(const bf16_t*)(ws + WS_YB), (const bf16_t*)(ws + WS_WB), M, D, DC}; pg8::StaticOrder S; S.init(M, D, F.G, (int)blockIdx.x);
      pg8::EpiOutB E{(const bf16_t*)(ws + WS_GB), F.out, (bf16_t*)(ws + WS_MRG)};
#ifndef NO_P3B
      pg8::gemm_phase<pg8::EpiOutB, pg8::StaticOrder, true, true>(F.lds + RING_OFF, g, S, E);
#endif
    }
    xcd_barrier(bar);
    { pg8::Gemm g{(const bf16_t*)(ws + WS_MRG), (const bf16_t*)(ws + WS_WO), M, D, D}; pg8::StaticOrder S; S.init(M, D, F.G, (int)blockIdx.x);
      pg8::EpiWo E{F.in[0], F.out, (bf16_t*)(ws + WS_X1B), (float*)(ws + WS_SSP1)};
#ifndef NO_P4
      pg8::gemm_phase<pg8::EpiWo, pg8::StaticOrder, true, true>(F.lds + RING_OFF, g, S, E);
#endif
    }
    xcd_barrier(bar);
    { pg8::Gemm g{(const bf16_t*)(ws + WS_PB), (const bf16_t*)(ws + WS_WP), M, D, DPLE}; pg8::StaticOrder S; S.init(M, D, F.G, (int)blockIdx.x);
      pg8::EpiPP E{(bf16_t*)(ws + WS_PP)};
#ifndef NO_P5A
      pg8::gemm_phase<pg8::EpiPP, pg8::StaticOrder, true, true>(F.lds + RING_OFF, g, S, E);
#endif
    }
    __builtin_amdgcn_sched_barrier(0); asm volatile("" ::: "memory");
    { pg8::Gemm g{(const bf16_t*)(ws + WS_X1B), (const bf16_t*)(ws + WS_WG), M, D, D}; pg8::StaticOrder S; S.init(M, D, F.G, (int)blockIdx.x);
      pg8::EpiGate E{F.out, (const bf16_t*)(ws + WS_PP), (const float*)(ws + WS_SSP1), (float*)(ws + WS_SSP2)};
#ifndef NO_P5B
      pg8::gemm_phase<pg8::EpiGate, pg8::StaticOrder, true, true>(F.lds + RING_OFF, g, S, E);
#endif
    }
    xcd_barrier(bar);
#ifndef NO_P6
    p6_final(F);
#endif
}

extern "C" void kernel_launch(void* const* d_in, const int* in_sizes, int n_in, void* d_out, int out_size, void* d_ws, size_t ws_size, hipStream_t stream) {
    static int grid = 0;
    if (grid == 0) {
        if (n_in != 15 || out_size != M * D || ws_size < 456 * MiB) { fprintf(stderr, "kernel_launch: unexpected sizes n_in %d out %d ws %zu\n", n_in, out_size, ws_size); grid = -1; return; }
        int dev = 0, cus = 0, per_cu = 0;
        if (hipGetDevice(&dev) != hipSuccess || hipDeviceGetAttribute(&cus, hipDeviceAttributeMultiprocessorCount, dev) != hipSuccess) { grid = -1; return; }
        if (hipFuncSetAttribute((const void*)fwd_kernel, hipFuncAttributeMaxDynamicSharedMemorySize, LDS_BYTES) != hipSuccess) { fprintf(stderr, "kernel_launch: hipFuncSetAttribute failed\n"); grid = -1; return; }
        if (hipOccupancyMaxActiveBlocksPerMultiprocessor(&per_cu, (const void*)fwd_kernel, NWAVES * 64, LDS_BYTES) != hipSuccess || per_cu < 1) { fprintf(stderr, "kernel_launch: occupancy query reports %d blocks per CU\n", per_cu); (void)hipGetLastError(); grid = -1; return; }
        grid = cus;
        if (M % grid != 0 || grid % 8 != 0) { fprintf(stderr, "kernel_launch: unsupported CU count %d\n", grid); grid = -1; return; }
    }
    if (grid < 0) return;
    (void)hipMemsetAsync((char*)d_ws + WS_CTL, 0, CTL_ZERO_BYTES, stream);
    Args a{};
    for (int i = 0; i < 15; ++i) a.in[i] = (const float*)d_in[i];
    a.out = (float*)d_out; a.ws = (unsigned char*)d_ws;
    hipLaunchKernelGGL(fwd_kernel, dim3(grid), dim3(NWAVES * 64), LDS_BYTES, stream, a);
}
```

```cpp
#include <hip/hip_runtime.h>
#include <cstdint>
#include <cstdio>

typedef unsigned short bf16_t;
typedef float f32x4 __attribute__((ext_vector_type(4)));
typedef unsigned u32x4 __attribute__((ext_vector_type(4)));
typedef unsigned u32x2 __attribute__((ext_vector_type(2)));
#define GAS __attribute__((address_space(1)))
#define LAS __attribute__((address_space(3)))
#define LDS_WAIT() asm volatile("s_waitcnt lgkmcnt(0)" ::: "memory")
#define VM_WAIT() asm volatile("s_waitcnt vmcnt(0)" ::: "memory")

constexpr int NB = 16, SEQ = 2048, D = 1024, M = NB * SEQ;
constexpr int DPLE = 256, DC = 512, CWID = 31, NH = 8, HD = 64, TOPK = 256;
constexpr int NIN = 5320, NINP = 5376;
constexpr float EPS = 1e-6f;

constexpr size_t MiB = 1u << 20;
constexpr size_t WS_CTL = 0;
constexpr size_t CTL_ZERO_BYTES = 64 * 1024;
constexpr int CW_BAR = 4096;
constexpr size_t WS_WIN = 2 * MiB;
constexpr size_t WS_WA = 13 * MiB;
constexpr size_t WS_WB = 14 * MiB;
constexpr size_t WS_WO = 15 * MiB;
constexpr size_t WS_WG = 17 * MiB;
constexpr size_t WS_WP = 19 * MiB;
constexpr size_t WS_RINV = 20 * MiB;
constexpr size_t WS_SSP1 = 22 * MiB;
constexpr size_t WS_SSP2 = 24 * MiB;
constexpr size_t WS_VT = 26 * MiB;
constexpr size_t WS_XB = 32 * MiB;
constexpr size_t WS_YA = 32 * MiB, WS_YB = 64 * MiB;
constexpr size_t WS_PB = 96 * MiB;
constexpr size_t WS_CIN = 112 * MiB;
constexpr size_t WS_MRG = 112 * MiB;
constexpr size_t WS_CZ = 176 * MiB;
constexpr size_t WS_Q = 208 * MiB;
constexpr size_t WS_X1B = 176 * MiB;
constexpr size_t WS_AZ = 240 * MiB;
constexpr size_t WS_IQ = 272 * MiB;
constexpr size_t WS_SM = 304 * MiB;
constexpr size_t WS_GA = 320 * MiB;
constexpr size_t WS_PP = 320 * MiB;
constexpr size_t WS_GB = 384 * MiB;
constexpr size_t WS_END = 448 * MiB;

__device__ __forceinline__ float bf2f(bf16_t h) { return __uint_as_float(((unsigned)h) << 16); }
__device__ __forceinline__ bf16_t f2bf(float f) { unsigned u = __float_as_uint(f); return (bf16_t)((u + 0x7fffu + ((u >> 16) & 1u)) >> 16); }
__device__ __forceinline__ unsigned pk2(float lo, float hi) { return (unsigned)f2bf(lo) | ((unsigned)f2bf(hi) << 16); }
__device__ __forceinline__ float bflo(unsigned w) { return __uint_as_float(w << 16); }
__device__ __forceinline__ float bfhi(unsigned w) { return __uint_as_float(w & 0xffff0000u); }
__device__ __forceinline__ float sigmoidf_(float x) { return 1.f / (1.f + __expf(-x)); }
__device__ __forceinline__ float siluf_(float x) { return x * sigmoidf_(x); }
__device__ __forceinline__ float wave_sum(float v) {
#pragma unroll
    for (int o = 1; o < 64; o <<= 1) v += __shfl_xor(v, o);
    return v;
}

__host__ __device__ __forceinline__ int inmap(int n) {
    if (n < 2048) return n;
    if (n < 2560) return 2176 + (n - 2048);
    if (n < 3072) return 2688 + (n - 2560);
    if (n < 3328) { const int j = n - 3072;
        if (j < 64) return 2048 + j; if (j < 128) return 2112 + (j - 64); if (j < 192) return 3200 + (j - 128); if (j < 200) return 3264 + (j - 192); return -1; }
    if (n < 4352) return 3272 + (n - 3328);
    return 4296 + (n - 4352);
}
namespace pg8 {
#define PG8_LAS __attribute__((address_space(3)))
typedef unsigned short bf16_t;
typedef short bf16x8 __attribute__((ext_vector_type(8)));
typedef float f32x4 __attribute__((ext_vector_type(4)));
typedef unsigned u32x4 __attribute__((ext_vector_type(4)));
constexpr int BM = 256, BK = 64, HALF = 128, HTB = HALF * BK * 2  , STAGE_BYTES = 8 * HTB, NXCD = 8, WGM = 8;

__host__ __device__ __forceinline__ int lds_byte(int r, int c) { const int st = (r >> 4) * 2 + (c >> 5), rr = r & 15, cc = c & 31, ob = rr * 64 + cc * 2; return st * 1024 + (ob ^ (((ob >> 9) & 1) << 5)); }
__host__ __device__ __forceinline__ void stage_rc(int b, int& R, int& C) { const int st = b / 1024, sb = b % 1024, swz = sb ^ (((sb >> 9) & 1) << 5); R = (st >> 1) * 16 + swz / 64; C = (st & 1) * 32 + (swz % 64) / 2; }
__host__ __device__ __forceinline__ int perm32(int rho) { const int n = rho >> 4, i = rho & 15; return 8 * (i >> 2) + 4 * n + (i & 3); }

struct Unit { int pm, pn; };
struct Gemm { const bf16_t* A; const bf16_t* Bt; int M, N, K; };

struct StaticOrder {
    int nM, nN, nwg, G, c;
    __host__ __device__ void init(int M, int N, int G_, int c_) { nM = M / BM; nN = N / BM; nwg = nM * nN; G = G_; c = c_; }
    __host__ __device__ bool next(int i, Unit& u) const {
        const long L = (long)i * G + c; if (L >= nwg) return false;
        int wgid = (int)L; { const int q = nwg / NXCD, r = nwg % NXCD, xcd = wgid % NXCD, off = wgid / NXCD; wgid = (xcd < r ? xcd * (q + 1) : r * (q + 1) + (xcd - r) * q) + off; }
        const int nig = WGM * nN, gid = wgid / nig, fm = gid * WGM, gsz = (nM - fm) < WGM ? (nM - fm) : WGM;
        u.pm = fm + ((wgid % nig) % gsz); u.pn = (wgid % nig) / gsz; return true;
    }
    __device__ __forceinline__ void a_ready(const Unit&) const {}
    __device__ __forceinline__ void done(const Unit&) const {}
};
__device__ __forceinline__ unsigned cvt_pk_bf16(float lo, float hi) { unsigned r; asm volatile("v_cvt_pk_bf16_f32 %0, %1, %2" : "=v"(r) : "v"(lo), "v"(hi)); return r; }
struct EpiInProj {
    static constexpr bool PERM = true, AFTER_DRAIN = false;
    const float* rinv; unsigned char* ws;
    __device__ __forceinline__ void operator()(const f32x4 (&acc)[2][2][4][2], const Unit& u, int wr, int wc, int fr, int fq) const {
        size_t off; int ld, colt; const int pn = u.pn;
        if (pn < 4) { off = WS_CIN; ld = 1024; colt = pn * 256; }
        else if (pn < 6) { off = WS_CZ; ld = 512; colt = (pn - 4) * 256; }
        else if (pn < 8) { off = WS_Q; ld = 512; colt = (pn - 6) * 256; }
        else if (pn < 10) { off = WS_AZ; ld = 512; colt = (pn - 8) * 256; }
        else if (pn < 12) { off = WS_IQ; ld = 512; colt = (pn - 10) * 256; }
        else if (pn < 13) { off = WS_SM; ld = 256; colt = 0; }
        else if (pn < 17) { off = WS_GA; ld = 1024; colt = (pn - 13) * 256; }
        else { off = WS_GB; ld = 1024; colt = (pn - 17) * 256; }
        bf16_t* base = (bf16_t*)(ws + off);
        const float qs = (pn == 6 || pn == 7) ? 0.125f * 1.4426950408889634f : 1.f;
        const int row0 = u.pm * BM + wr * 64 + fr, col0 = colt + wc * 32 + 8 * fq;
#pragma unroll
        for (int ai = 0; ai < 2; ++ai)
#pragma unroll
            for (int m = 0; m < 4; ++m) { const int row = row0 + ai * HALF + m * 16; const float r = rinv[row] * qs; bf16_t* rowp = base + (size_t)row * ld + col0;
#pragma unroll
                for (int bj = 0; bj < 2; ++bj) { const f32x4 v0 = acc[ai][bj][m][0] * r, v1 = acc[ai][bj][m][1] * r;
                    u32x4 w; w.x = cvt_pk_bf16(v0[0], v0[1]); w.y = cvt_pk_bf16(v0[2], v0[3]); w.z = cvt_pk_bf16(v1[0], v1[1]); w.w = cvt_pk_bf16(v1[2], v1[3]);
                    *(u32x4*)(rowp + bj * HALF) = w; } }
        if (pn == 12 && wc >= 2) {
            bf16_t* vt = (bf16_t*)(ws + WS_VT); const int d0 = (wc - 2) * 32 + 8 * fq;
#pragma unroll
            for (int ai = 0; ai < 2; ++ai)
#pragma unroll
                for (int m = 0; m < 4; ++m) { const int row = row0 + ai * HALF + m * 16; const float r = rinv[row]; const int bb = row >> 11, sq = row & 2047, k5 = sq & 31;
                    const int pos = (sq & ~31) + ((k5 & 0x13) | ((k5 & 4) << 1) | ((k5 & 8) >> 1)); bf16_t* vp = vt + ((size_t)bb * 64 + d0) * 2048 + pos;
                    const f32x4 v0 = acc[ai][0][m][0] * r, v1 = acc[ai][0][m][1] * r;
#pragma unroll
                    for (int e = 0; e < 4; ++e) { vp[(size_t)e * 2048] = f2bf(v0[e]); vp[(size_t)(4 + e) * 2048] = f2bf(v1[e]); } }
        }
    }
};
__device__ __forceinline__ f32x4 sig4lo(unsigned a, unsigned b) { return (f32x4){sigmoidf_(bflo(a)), sigmoidf_(bfhi(a)), sigmoidf_(bflo(b)), sigmoidf_(bfhi(b))}; }
struct EpiOutA {
    static constexpr bool PERM = true, AFTER_DRAIN = false;
    const bf16_t* ga; float* part;
    __device__ __forceinline__ void operator()(const f32x4 (&acc)[2][2][4][2], const Unit& u, int wr, int wc, int fr, int fq) const {
        const int row0 = u.pm * BM + wr * 64 + fr, col0 = u.pn * BM + wc * 32 + 8 * fq;
#pragma unroll
        for (int ai = 0; ai < 2; ++ai)
#pragma unroll
            for (int m = 0; m < 4; ++m) { const size_t idx = (size_t)(row0 + ai * HALF + m * 16) * D + col0;
#pragma unroll
                for (int bj = 0; bj < 2; ++bj) { const u32x4 g = *(const u32x4*)(ga + idx + bj * HALF);
                    *(f32x4*)(part + idx + bj * HALF) = sig4lo(g.x, g.y) * acc[ai][bj][m][0]; *(f32x4*)(part + idx + bj * HALF + 4) = sig4lo(g.z, g.w) * acc[ai][bj][m][1]; } }
    }
};
struct EpiOutB {
    static constexpr bool PERM = true, AFTER_DRAIN = false;
    const bf16_t* gb; const float* part; bf16_t* mrg;
    __device__ __forceinline__ void operator()(const f32x4 (&acc)[2][2][4][2], const Unit& u, int wr, int wc, int fr, int fq) const {
        const int row0 = u.pm * BM + wr * 64 + fr, col0 = u.pn * BM + wc * 32 + 8 * fq;
#pragma unroll
        for (int ai = 0; ai < 2; ++ai)
#pragma unroll
            for (int m = 0; m < 4; ++m) { const size_t idx = (size_t)(row0 + ai * HALF + m * 16) * D + col0;
#pragma unroll
                for (int bj = 0; bj < 2; ++bj) { const u32x4 g = *(const u32x4*)(gb + idx + bj * HALF);
                    const f32x4 v0 = *(const f32x4*)(part + idx + bj * HALF) + sig4lo(g.x, g.y) * acc[ai][bj][m][0], v1 = *(const f32x4*)(part + idx + bj * HALF + 4) + sig4lo(g.z, g.w) * acc[ai][bj][m][1];
                    u32x4 w; w.x = cvt_pk_bf16(v0[0], v0[1]); w.y = cvt_pk_bf16(v0[2], v0[3]); w.z = cvt_pk_bf16(v1[0], v1[1]); w.w = cvt_pk_bf16(v1[2], v1[3]);
                    *(u32x4*)(mrg + idx + bj * HALF) = w; } }
    }
};
__device__ __forceinline__ float sq4(const f32x4 v) { return (v[0] * v[0] + v[1] * v[1]) + (v[2] * v[2] + v[3] * v[3]); }
struct EpiWo {
    static constexpr bool PERM = true, AFTER_DRAIN = false;
    const float* x; float* out; bf16_t* x1b; float* ssp;
    __device__ __forceinline__ void operator()(const f32x4 (&acc)[2][2][4][2], const Unit& u, int wr, int wc, int fr, int fq) const {
        const int row0 = u.pm * BM + wr * 64 + fr, col0 = u.pn * BM + wc * 32 + 8 * fq;
#pragma unroll
        for (int ai = 0; ai < 2; ++ai)
#pragma unroll
            for (int m = 0; m < 4; ++m) { const int row = row0 + ai * HALF + m * 16; const size_t idx = (size_t)row * D + col0; float s = 0.f;
#pragma unroll
                for (int bj = 0; bj < 2; ++bj) { const f32x4 v0 = *(const f32x4*)(x + idx + bj * HALF) + acc[ai][bj][m][0], v1 = *(const f32x4*)(x + idx + bj * HALF + 4) + acc[ai][bj][m][1];
                    *(f32x4*)(out + idx + bj * HALF) = v0; *(f32x4*)(out + idx + bj * HALF + 4) = v1; s += sq4(v0) + sq4(v1);
                    u32x4 w; w.x = cvt_pk_bf16(v0[0], v0[1]); w.y = cvt_pk_bf16(v0[2], v0[3]); w.z = cvt_pk_bf16(v1[0], v1[1]); w.w = cvt_pk_bf16(v1[2], v1[3]);
                    *(u32x4*)(x1b + idx + bj * HALF) = w; }
                s += __shfl_xor(s, 16); s += __shfl_xor(s, 32);
                if (fq == 0) ssp[(size_t)row * 16 + u.pn * 4 + wc] = s; }
    }
};
struct EpiPP {
    static constexpr bool PERM = true, AFTER_DRAIN = false;
    bf16_t* pp;
    __device__ __forceinline__ void operator()(const f32x4 (&acc)[2][2][4][2], const Unit& u, int wr, int wc, int fr, int fq) const {
        const int row0 = u.pm * BM + wr * 64 + fr, col0 = u.pn * BM + wc * 32 + 8 * fq;
#pragma unroll
        for (int ai = 0; ai < 2; ++ai)
#pragma unroll
            for (int m = 0; m < 4; ++m) { const size_t idx = (size_t)(row0 + ai * HALF + m * 16) * D + col0;
#pragma unroll
                for (int bj = 0; bj < 2; ++bj) { const f32x4 v0 = acc[ai][bj][m][0], v1 = acc[ai][bj][m][1];
                    u32x4 w; w.x = cvt_pk_bf16(v0[0], v0[1]); w.y = cvt_pk_bf16(v0[2], v0[3]); w.z = cvt_pk_bf16(v1[0], v1[1]); w.w = cvt_pk_bf16(v1[2], v1[3]);
                    *(u32x4*)(pp + idx + bj * HALF) = w; } }
    }
};
struct EpiGate {
    static constexpr bool PERM = true, AFTER_DRAIN = false;
    float* out; const bf16_t* pp; const float* ssp1; float* ssp2;
    __device__ __forceinline__ void operator()(const f32x4 (&acc)[2][2][4][2], const Unit& u, int wr, int wc, int fr, int fq) const {
        const int row0 = u.pm * BM + wr * 64 + fr, col0 = u.pn * BM + wc * 32 + 8 * fq;
#pragma unroll
        for (int ai = 0; ai < 2; ++ai)
#pragma unroll
            for (int m = 0; m < 4; ++m) { const int row = row0 + ai * HALF + m * 16; const size_t idx = (size_t)row * D + col0;
                const f32x4* sp = (const f32x4*)(ssp1 + (size_t)row * 16); const f32x4 t4 = (sp[0] + sp[1]) + (sp[2] + sp[3]);
                const float r1 = rsqrtf(((t4[0] + t4[1]) + (t4[2] + t4[3])) * (1.f / D) + EPS); float s = 0.f;
#pragma unroll
                for (int bj = 0; bj < 2; ++bj) { const u32x4 pw = *(const u32x4*)(pp + idx + bj * HALF); const f32x4 a0 = acc[ai][bj][m][0] * r1, a1 = acc[ai][bj][m][1] * r1;
                    const f32x4 g0 = (f32x4){sigmoidf_(a0[0]), sigmoidf_(a0[1]), sigmoidf_(a0[2]), sigmoidf_(a0[3])}, g1 = (f32x4){sigmoidf_(a1[0]), sigmoidf_(a1[1]), sigmoidf_(a1[2]), sigmoidf_(a1[3])};
                    const f32x4 p0 = (f32x4){bflo(pw.x), bfhi(pw.x), bflo(pw.y), bfhi(pw.y)}, p1 = (f32x4){bflo(pw.z), bfhi(pw.z), bflo(pw.w), bfhi(pw.w)};
                    const f32x4 v0 = *(const f32x4*)(out + idx + bj * HALF) + g0 * p0, v1 = *(const f32x4*)(out + idx + bj * HALF + 4) + g1 * p1;
                    *(f32x4*)(out + idx + bj * HALF) = v0; *(f32x4*)(out + idx + bj * HALF + 4) = v1; s += sq4(v0) + sq4(v1); }
                s += __shfl_xor(s, 16); s += __shfl_xor(s, 32);
                if (fq == 0) ssp2[(size_t)row * 16 + u.pn * 4 + wc] = s; }
    }
};
template <class Epi, class Sched, bool ALIGN_EPI = false, bool SP2 = false>
__device__ __forceinline__ void gemm_phase(PG8_LAS unsigned char* lds, const Gemm g, const Sched& S, const Epi& E) {
    int tid_ = threadIdx.x; asm volatile("" : "+v"(tid_));
    const int tid = tid_, wid = __builtin_amdgcn_readfirstlane(tid >> 6), lane = tid & 63, wr = wid >> 2, wc = wid & 3, fr = lane & 15, fq = lane >> 4;
    int K_ = g.K; asm volatile("" : "+s"(K_));
    const int K = K_, nt = K / BK;
    unsigned voffA[2], voffB[2];
#pragma unroll
    for (int i = 0; i < 2; ++i) { int R, C; stage_rc(tid * 16 + i * 8192, R, C); const int Rb = Epi::PERM ? ((R & ~31) + perm32(R & 31)) : R;
        voffA[i] = (unsigned)(R * K + C) * 2u; voffB[i] = (unsigned)(Rb * K + C) * 2u; }
    const size_t kstep = (size_t)(BK * 2);
    const size_t hstep = (size_t)HALF * K * 2;
    const size_t tstep = 2 * hstep;
    const unsigned ldsw = (unsigned)wid * 1024u;
    const int aoff = lds_byte(wr * 64 + fr, fq * 8), boff = lds_byte(wc * 32 + fr, fq * 8);
#define PG8_SA(b, h) (((b) * 2 + (h)) * HTB)
#define PG8_SB(b, h) ((4 + (b) * 2 + (h)) * HTB)
#define PG8_STAGE(bufoff, gbase, voff) do { _Pragma("unroll") for (int _i = 0; _i < 2; ++_i) \
        __builtin_amdgcn_global_load_lds((const unsigned*)((const char*)(gbase) + (voff)[_i]), (PG8_LAS unsigned*)(lds + (bufoff) + ldsw + _i * 8192), 16, 0, 0); } while (0)
#define PG8_LDA(dst, b, h) do { _Pragma("unroll") for (int m = 0; m < 4; ++m) _Pragma("unroll") for (int k = 0; k < 2; ++k) dst[m][k] = *(const PG8_LAS bf16x8*)(lds + PG8_SA(b, h) + aoff + m * 2048 + k * 1024); } while (0)
#define PG8_LDB(dst, b, h) do { _Pragma("unroll") for (int n = 0; n < 2; ++n) _Pragma("unroll") for (int k = 0; k < 2; ++k) dst[n][k] = *(const PG8_LAS bf16x8*)(lds + PG8_SB(b, h) + boff + n * 2048 + k * 1024); } while (0)
#define PG8_MMA(ai, bj, At, Bt) do { __builtin_amdgcn_s_setprio(1); _Pragma("unroll") for (int m = 0; m < 4; ++m) _Pragma("unroll") for (int n = 0; n < 2; ++n) _Pragma("unroll") for (int k = 0; k < 2; ++k) \
        acc[ai][bj][m][n] = __builtin_amdgcn_mfma_f32_16x16x32_bf16(Bt[n][k], At[m][k], acc[ai][bj][m][n], 0, 0, 0); __builtin_amdgcn_s_setprio(0); } while (0)
#define PG8_WAIT_V(n) asm volatile("s_waitcnt vmcnt(" #n ")" ::: "memory")
#define PG8_WAIT_L(n) asm volatile("s_waitcnt lgkmcnt(" #n ")" ::: "memory")
#define PG8_BAR __builtin_amdgcn_s_barrier()
#define PG8_SCHED __builtin_amdgcn_sched_barrier(0)
    Unit cur, nxt; int ui = 0;
    if (!S.next(0, cur)) return;
    f32x4 acc[2][2][4][2];
#pragma unroll
    for (int a = 0; a < 2; ++a)
#pragma unroll
        for (int b = 0; b < 2; ++b)
#pragma unroll
            for (int m = 0; m < 4; ++m)
#pragma unroll
                for (int n = 0; n < 2; ++n) acc[a][b][m][n] = (f32x4){0.f, 0.f, 0.f, 0.f};
    bf16x8 At[4][2], B0[2][2], B1[2][2];
    const char* cA = (const char*)g.A + (size_t)cur.pm * tstep; const char* cB = (const char*)g.Bt + (size_t)cur.pn * tstep;
    S.a_ready(cur);
    if constexpr (SP2) {
        PG8_STAGE(PG8_SB(0, 0), cB, voffB); PG8_STAGE(PG8_SB(0, 1), cB + hstep, voffB); PG8_STAGE(PG8_SA(0, 0), cA, voffA); PG8_STAGE(PG8_SA(0, 1), cA + hstep, voffA);
        if (wr == 1) PG8_BAR;
        PG8_WAIT_V(2); PG8_BAR;
        PG8_STAGE(PG8_SB(1, 0), cB + kstep, voffB); PG8_STAGE(PG8_SA(1, 0), cA + kstep, voffA); PG8_STAGE(PG8_SB(1, 1), cB + hstep + kstep, voffB);
        PG8_WAIT_V(6); PG8_BAR;
    } else {
        PG8_STAGE(PG8_SB(0, 0), cB, voffB); PG8_STAGE(PG8_SA(0, 0), cA, voffA); PG8_STAGE(PG8_SB(0, 1), cB + hstep, voffB); PG8_STAGE(PG8_SA(0, 1), cA + hstep, voffA);
        if (wr == 1) PG8_BAR;
        PG8_WAIT_V(4); PG8_BAR;
        PG8_STAGE(PG8_SB(1, 0), cB + kstep, voffB); PG8_STAGE(PG8_SA(1, 0), cA + kstep, voffA); PG8_STAGE(PG8_SB(1, 1), cB + hstep + kstep, voffB);
        PG8_WAIT_V(6); PG8_BAR;
    }
    for (;;) {
        const bool has_next = S.next(ui + 1, nxt);
        const char* nA = has_next ? (const char*)g.A + (size_t)nxt.pm * tstep : cA; const char* nB = has_next ? (const char*)g.Bt + (size_t)nxt.pn * tstep : cB;
        for (int t = 0; t < nt; t += 2) {
            const bool last = (t == nt - 2);
            const char* a1 = cA + (size_t)(t + 1) * kstep;
            const char* a2 = last ? nA : cA + (size_t)(t + 2) * kstep; const char* b2 = last ? nB : cB + (size_t)(t + 2) * kstep;
            const char* a3 = a2 + kstep; const char* b3 = b2 + kstep;
            if (last && has_next) S.a_ready(nxt);
            if constexpr (SP2) {
            PG8_LDB(B0, 0, 0); PG8_LDB(B1, 0, 1); PG8_SCHED; PG8_LDA(At, 0, 0); PG8_STAGE(PG8_SA(1, 1), a1 + hstep, voffA);
            PG8_WAIT_V(8); PG8_WAIT_L(0); PG8_BAR; PG8_MMA(0, 0, At, B0); PG8_MMA(0, 1, At, B1); PG8_BAR; PG8_SCHED;
            PG8_LDA(At, 0, 1); PG8_STAGE(PG8_SB(0, 0), b2, voffB); PG8_STAGE(PG8_SB(0, 1), b2 + hstep, voffB); PG8_STAGE(PG8_SA(0, 0), a2, voffA);
            PG8_WAIT_V(8); PG8_WAIT_L(0); PG8_BAR; PG8_MMA(1, 0, At, B0); PG8_MMA(1, 1, At, B1); PG8_BAR; PG8_SCHED;
            PG8_LDB(B0, 1, 0); PG8_LDB(B1, 1, 1); PG8_SCHED; PG8_LDA(At, 1, 0); PG8_STAGE(PG8_SA(0, 1), a2 + hstep, voffA);
            PG8_WAIT_V(8); PG8_WAIT_L(0); PG8_BAR; PG8_MMA(0, 0, At, B0); PG8_MMA(0, 1, At, B1); PG8_BAR; PG8_SCHED;
            PG8_LDA(At, 1, 1); PG8_STAGE(PG8_SB(1, 0), b3, voffB); PG8_STAGE(PG8_SB(1, 1), b3 + hstep, voffB); PG8_STAGE(PG8_SA(1, 0), a3, voffA);
            PG8_WAIT_V(8); PG8_WAIT_L(0); PG8_BAR; PG8_MMA(1, 0, At, B0); PG8_MMA(1, 1, At, B1); PG8_BAR; PG8_SCHED;
            } else {
            PG8_LDB(B0, 0, 0); PG8_SCHED; PG8_LDA(At, 0, 0); PG8_STAGE(PG8_SA(1, 1), a1 + hstep, voffA);
            PG8_WAIT_L(8); PG8_BAR; PG8_WAIT_L(0); PG8_MMA(0, 0, At, B0); PG8_BAR; PG8_SCHED;
            PG8_LDB(B1, 0, 1); PG8_STAGE(PG8_SB(0, 0), b2, voffB);
            PG8_BAR; PG8_WAIT_L(0); PG8_MMA(0, 1, At, B1); PG8_BAR;
            PG8_LDA(At, 0, 1); PG8_STAGE(PG8_SA(0, 0), a2, voffA);
            PG8_BAR; PG8_WAIT_L(0); PG8_MMA(1, 0, At, B0); PG8_BAR; PG8_SCHED;
            PG8_STAGE(PG8_SB(0, 1), b2 + hstep, voffB);
            PG8_WAIT_V(6); PG8_BAR; PG8_MMA(1, 1, At, B1); PG8_BAR;
            PG8_LDB(B0, 1, 0); PG8_SCHED; PG8_LDA(At, 1, 0); PG8_STAGE(PG8_SA(0, 1), a2 + hstep, voffA);
            PG8_WAIT_L(8); PG8_BAR; PG8_WAIT_L(0); PG8_MMA(0, 0, At, B0); PG8_BAR; PG8_SCHED;
            PG8_LDB(B1, 1, 1); PG8_STAGE(PG8_SB(1, 0), b3, voffB);
            PG8_BAR; PG8_WAIT_L(0); PG8_MMA(0, 1, At, B1); PG8_BAR;
            PG8_LDA(At, 1, 1); PG8_STAGE(PG8_SA(1, 0), a3, voffA);
            PG8_BAR; PG8_WAIT_L(0); PG8_MMA(1, 0, At, B0); PG8_BAR; PG8_SCHED;
            PG8_STAGE(PG8_SB(1, 1), b3 + hstep, voffB);
            PG8_WAIT_V(6); PG8_BAR; PG8_MMA(1, 1, At, B1); PG8_BAR;
            }
        }
        if constexpr (ALIGN_EPI) { if (wr == 0) PG8_BAR; }
        if constexpr (!Epi::AFTER_DRAIN) { E(acc, cur, wr, wc, fr, fq); S.done(cur); }
        if (!has_next) break;
#pragma unroll
        for (int a = 0; a < 2; ++a)
#pragma unroll
            for (int b = 0; b < 2; ++b)
#pragma unroll
                for (int m = 0; m < 4; ++m)
#pragma unroll
                    for (int n = 0; n < 2; ++n) acc[a][b][m][n] = (f32x4){0.f, 0.f, 0.f, 0.f};
        cur = nxt; cA = nA; cB = nB; ++ui;
        if constexpr (ALIGN_EPI) { if (wr == 1) PG8_BAR; }
    }
    PG8_WAIT_V(0);
    if constexpr (!ALIGN_EPI) { if (wr == 0) PG8_BAR; }
    PG8_BAR;
    if constexpr (Epi::AFTER_DRAIN) { E.fused(acc, cur, wr, wc, fr, fq, lds, wid, lane); S.done(cur); }
#undef PG8_SA
#undef PG8_SB
#undef PG8_STAGE
#undef PG8_LDA
#undef PG8_LDB
#undef PG8_MMA
#undef PG8_WAIT_V
#undef PG8_WAIT_L
#undef PG8_BAR
#undef PG8_SCHED
}
}
#define XB_TMO      128
#define XB_XCNT(j)  (256  + 64 * (j))
#define XB_XSUB(j)  (1280 + 64 * (j))
#define XB_XGEN(j)  (2304 + 64 * (j))
#define XB_TOP      3328
#define XB_TOPGEN   3392
#define XCD_BAR_WORDS 3456
#define XB_SPIN_CAP (1u << 18)

__device__ __forceinline__ unsigned xb_ld(unsigned* p)              { return __hip_atomic_load(p, __ATOMIC_RELAXED, __HIP_MEMORY_SCOPE_AGENT); }
__device__ __forceinline__ unsigned xb_add(unsigned* p, unsigned v) { return __hip_atomic_fetch_add(p, v, __ATOMIC_RELAXED, __HIP_MEMORY_SCOPE_AGENT); }
__device__ __forceinline__ unsigned xb_xcc_id() { return (unsigned)__builtin_amdgcn_s_getreg((3 << 11) | 20) & 0xFu; }
#define XB_SPIN(cond, bar) do { unsigned _sp = 0; while (cond) { __builtin_amdgcn_s_sleep(1); \
    if ((++_sp & 255u) == 0u) { if (xb_ld(&(bar)[XB_TMO])) break; if (_sp > XB_SPIN_CAP) { atomicAdd(&(bar)[XB_TMO], 1u); break; } } } } while (0)

struct XcdBarrier {
    unsigned* bar; unsigned x;
    volatile LAS unsigned* st;
};

__device__ __forceinline__ XcdBarrier xcd_barrier_post(unsigned* bar, volatile LAS unsigned* st) {
    XcdBarrier b; b.bar = bar; b.x = xb_xcc_id(); b.st = st;
    if (threadIdx.x == 0) (void)xb_add(&bar[XB_XCNT(b.x)], 1u);
    return b;
}
__device__ __forceinline__ void xcd_barrier_complete(unsigned* bar, unsigned x, unsigned& nloc, unsigned& nx) {
    const unsigned G = gridDim.x * gridDim.y * gridDim.z;
    unsigned sum, cnt, mine, sp = 0u;
    for (;;) {
        sum = 0u; cnt = 0u; mine = 0u;
#pragma unroll
        for (unsigned j = 0; j < 16; ++j) { const unsigned c = xb_ld(&bar[XB_XCNT(j)]); sum += c; cnt += (c > 0u) ? 1u : 0u; mine = (j == x) ? c : mine; }
        if (sum == G) break;
        __builtin_amdgcn_s_sleep(1);
        if ((++sp & 255u) == 0u) { if (xb_ld(&bar[XB_TMO])) break; if (sp > XB_SPIN_CAP) { atomicAdd(&bar[XB_TMO], 1u); break; } }
    }
    nloc = mine > 0u ? mine : 1u; nx = cnt > 0u ? cnt : 1u;
}

__device__ __forceinline__ void xcd_barrier(const XcdBarrier& b) {
    asm volatile("s_waitcnt vmcnt(0)" ::: "memory");
    __syncthreads();
    if (threadIdx.x == 0) {
        unsigned* bar = b.bar;
        __builtin_amdgcn_s_waitcnt(0);
        unsigned nloc = b.st[0], nx = b.st[1];
        if (nloc == 0u) { xcd_barrier_complete(bar, b.x, nloc, nx); b.st[0] = nloc; b.st[1] = nx; }
        const unsigned old = xb_add(&bar[XB_XSUB(b.x)], 1u);
        const unsigned gen = old / nloc;
        if (old + 1u == (gen + 1u) * nloc) {
            __builtin_amdgcn_fence(__ATOMIC_RELEASE, "agent");
            asm volatile("s_waitcnt vmcnt(0)" ::: "memory");
            const unsigned og = xb_add(&bar[XB_TOP], 1u);
            const unsigned tg = og / nx;
            if (og + 1u == (tg + 1u) * nx) xb_add(&bar[XB_TOPGEN], 1u);
            else XB_SPIN(xb_ld(&bar[XB_TOPGEN]) == tg, bar);
            __builtin_amdgcn_fence(__ATOMIC_ACQUIRE, "agent");
            xb_add(&bar[XB_XGEN(b.x)], 1u);
            asm volatile("s_waitcnt vmcnt(0)" ::: "memory");
        } else {
            XB_SPIN(xb_ld(&bar[XB_XGEN(b.x)]) == gen, bar);
            __builtin_amdgcn_fence(__ATOMIC_ACQUIRE, "agent");
            asm volatile("s_waitcnt vmcnt(0)" ::: "memory");
        }
    }
    __syncthreads();
}
constexpr int NWAVES = 8;
constexpr int RING_OFF = 0, RING_BYTES = 131072;
constexpr int LDSCTL_OFF = RING_BYTES, MISC_OFF = LDSCTL_OFF + 320;
constexpr int LDS_BYTES = 147456;

struct Frame {
    LAS unsigned char* lds; volatile LAS unsigned* MISC;
    int tid, lane, wave, G, vcu;
    const float* in[15]; float* out; unsigned char* ws;
};

__device__ __forceinline__ void prep_w_item(const float* W, const float* gain, int K, int Nsrc, bool map, bf16_t* Wt, LAS float* scr, int item, int nblk, int lane) {
    const int kb = item / nblk, nb = item % nblk, k0 = 64 * kb, n0 = 32 * nb;
    const int nn = n0 + (lane & 31); const int e = map ? inmap(nn) : nn;
#pragma unroll 8
    for (int i = 0; i < 32; ++i) { const int kk = 2 * i + (lane >> 5); float v = 0.f;
        if (e >= 0) v = W[(size_t)(k0 + kk) * Nsrc + e] * (gain ? gain[k0 + kk] : 1.f);
        scr[kk * 33 + (lane & 31)] = v; }
    LDS_WAIT(); asm volatile("" ::: "memory");
    const int c = lane & 7;
#pragma unroll
    for (int j = 0; j < 4; ++j) { const int n = (lane >> 3) + 8 * j; const LAS float* s = scr + (8 * c) * 33 + n;
        u32x4 o; o.x = pk2(s[0 * 33], s[1 * 33]); o.y = pk2(s[2 * 33], s[3 * 33]); o.z = pk2(s[4 * 33], s[5 * 33]); o.w = pk2(s[6 * 33], s[7 * 33]);
        *(u32x4*)(Wt + (size_t)(n0 + n) * K + k0 + 8 * c) = o; }
    LDS_WAIT(); asm volatile("" ::: "memory");
}
__device__ __forceinline__ void p0_prep(Frame& F) {
    LAS float* scr = (LAS float*)(F.lds + RING_OFF + F.wave * 16384);
    int tid_ = threadIdx.x; asm volatile("" : "+v"(tid_));
    const int lane = tid_ & 63, gw = F.vcu * NWAVES + __builtin_amdgcn_readfirstlane(tid_ >> 6), NGW = F.G * NWAVES;
    unsigned char* ws = F.ws;
    constexpr int I_IN = (D / 64) * (NINP / 32), I_A = (DC / 64) * (D / 32), I_O = (D / 64) * (D / 32), I_P = (DPLE / 64) * (D / 32);
    constexpr int NITEMS = I_IN + 2 * I_A + 2 * I_O + I_P;
    for (int it = gw; it < NITEMS; it += NGW) {
        int r = it;
        if (r < I_IN) { prep_w_item(F.in[3], F.in[2], D, NIN, true, (bf16_t*)(ws + WS_WIN), scr, r, NINP / 32, lane); continue; } r -= I_IN;
        if (r < I_A) { prep_w_item(F.in[8], nullptr, DC, D, false, (bf16_t*)(ws + WS_WA), scr, r, D / 32, lane); continue; } r -= I_A;
        if (r < I_A) { prep_w_item(F.in[9], nullptr, DC, D, false, (bf16_t*)(ws + WS_WB), scr, r, D / 32, lane); continue; } r -= I_A;
        if (r < I_O) { prep_w_item(F.in[10], nullptr, D, D, false, (bf16_t*)(ws + WS_WO), scr, r, D / 32, lane); continue; } r -= I_O;
        if (r < I_O) { prep_w_item(F.in[12], F.in[11], D, D, false, (bf16_t*)(ws + WS_WG), scr, r, D / 32, lane); continue; } r -= I_O;
        prep_w_item(F.in[13], nullptr, DPLE, D, false, (bf16_t*)(ws + WS_WP), scr, r, D / 32, lane);
    }
    const float* x = F.in[0]; const float* p = F.in[1]; bf16_t* xb = (bf16_t*)(ws + WS_XB); bf16_t* pb = (bf16_t*)(ws + WS_PB); float* rinv = (float*)(ws + WS_RINV);
    for (int m = gw; m < M; m += NGW) {
        const f32x4* xr = (const f32x4*)(x + (size_t)m * D) + lane; f32x4 v[4]; float s = 0.f;
#pragma unroll
        for (int j = 0; j < 4; ++j) { v[j] = xr[64 * j]; s += (v[j].x * v[j].x + v[j].y * v[j].y) + (v[j].z * v[j].z + v[j].w * v[j].w); }
        s = wave_sum(s);
        if (lane == 0) rinv[m] = rsqrtf(s * (1.f / D) + EPS);
        u32x2* o = (u32x2*)(xb + (size_t)m * D) + lane;
#pragma unroll
        for (int j = 0; j < 4; ++j) { u32x2 w; w.x = pk2(v[j].x, v[j].y); w.y = pk2(v[j].z, v[j].w); o[64 * j] = w; }
        const f32x4 pv = ((const f32x4*)(p + (size_t)m * DPLE))[lane];
        u32x2 w; w.x = pk2(pv.x, pv.y); w.y = pk2(pv.z, pv.w); ((u32x2*)(pb + (size_t)m * DPLE))[lane] = w;
    }
}

constexpr int CF_TOK = 128, CF_CH = 16;
__device__ __forceinline__ void p2_conformer(Frame& F) {
    LAS float* red = (LAS float*)(F.lds + RING_OFF);
    const bf16_t* cin = (const bf16_t*)(F.ws + WS_CIN); const bf16_t* cz = (const bf16_t*)(F.ws + WS_CZ); bf16_t* ya = (bf16_t*)(F.ws + WS_YA);
    const float* conv_w = F.in[4];
    int tid_ = threadIdx.x; asm volatile("" : "+v"(tid_));
    const int ch = tid_, lane = tid_ & 63, wv = __builtin_amdgcn_readfirstlane(tid_ >> 6);
    float w[CWID];
#pragma unroll
    for (int j = 0; j < CWID; ++j) w[j] = conv_w[j * DC + ch];
    const float cb = F.in[5][ch], g = F.in[6][ch], bb = F.in[7][ch];
    for (int item = F.vcu; item < M / CF_TOK; item += F.G) {
        const int b = item / (SEQ / CF_TOK), t0 = (item % (SEQ / CF_TOK)) * CF_TOK; const size_t rowb = (size_t)b * SEQ;
        float u[CF_CH + CWID - 1];
#pragma unroll
        for (int i = 0; i < CWID - 1; ++i) { const int t = t0 - (CWID - 1) + i; float v = 0.f;
            if (t >= 0) { const float a = bf2f(cin[(rowb + t) * 1024 + ch]), gt = bf2f(cin[(rowb + t) * 1024 + 512 + ch]); v = a * sigmoidf_(gt); }
            u[i] = v; }
        for (int tc = t0; tc < t0 + CF_TOK; tc += CF_CH) {
#pragma unroll
            for (int i = 0; i < CF_CH; ++i) { const size_t r = (rowb + tc + i) * 1024; const float a = bf2f(cin[r + ch]), gt = bf2f(cin[r + 512 + ch]); u[CWID - 1 + i] = a * sigmoidf_(gt); }
            float c[CF_CH];
#pragma unroll
            for (int i = 0; i < CF_CH; ++i) { float s = cb;
#pragma unroll
                for (int j = 0; j < CWID; ++j) s = fmaf(w[j], u[i + j], s);
                c[i] = s; }
#pragma unroll
            for (int i = 0; i < CF_CH; ++i) { const float s1 = wave_sum(c[i]), s2 = wave_sum(c[i] * c[i]); if (lane == 0) { red[wv * 32 + 2 * i] = s1; red[wv * 32 + 2 * i + 1] = s2; } }
            __syncthreads();
#pragma unroll
            for (int i = 0; i < CF_CH; ++i) { float s1 = 0.f, s2 = 0.f;
#pragma unroll
                for (int q = 0; q < 8; ++q) { s1 += red[q * 32 + 2 * i]; s2 += red[q * 32 + 2 * i + 1]; }
                const float mu = s1 * (1.f / DC), var = fmaxf(s2 * (1.f / DC) - mu * mu, 0.f), rs = rsqrtf(var + EPS);
                const float y = (c[i] - mu) * rs * g + bb; const float z = bf2f(cz[(rowb + tc + i) * DC + ch]);
                ya[(rowb + tc + i) * DC + ch] = f2bf(siluf_(y) * siluf_(z)); }
            __syncthreads();
#pragma unroll
            for (int i = 0; i < CWID - 1; ++i) u[i] = u[i + CF_CH];
        }
    }
}

typedef short bf16x8 __attribute__((ext_vector_type(8)));
typedef float f32x16 __attribute__((ext_vector_type(16)));
__device__ __forceinline__ unsigned skey(float f) { const unsigned u = __float_as_uint(f + 0.f); return (u & 0x80000000u) ? ~u : (u | 0x80000000u); }
__device__ __forceinline__ int half_sum(int v) {
#pragma unroll
    for (int o = 1; o < 32; o <<= 1) v += __shfl_xor(v, o);
    return v;
}
__device__ __forceinline__ void attn_unit(Frame& F, int b, int qb, LAS unsigned char* lds) {
    int tid_ = threadIdx.x; asm volatile("" : "+v"(tid_));
    const int lane = tid_ & 63, w = __builtin_amdgcn_readfirstlane(tid_ >> 6), col = lane & 31, half = lane >> 5;
    const bf16_t* iq = (const bf16_t*)(F.ws + WS_IQ); const bf16_t* sm = (const bf16_t*)(F.ws + WS_SM);
    const size_t rowb = (size_t)b * SEQ; const int t0 = 32 * qb; const size_t m0w = rowb + t0 + 4 * w;
    bf16x8 aq[4];
    { const int r = col, half_r = (r >> 2) & 1, qsel = r >> 4, head = (r & 3) + 4 * ((r >> 3) & 1), ql = 2 * half_r + qsel;
#pragma unroll
      for (int ks = 0; ks < 4; ++ks) aq[ks] = *(const bf16x8*)(iq + (m0w + ql) * 512 + head * 64 + 16 * ks + 8 * half); }
    float wr[16];
    { const u32x4 va = *(const u32x4*)(sm + (m0w + 2 * half) * 256 + 192), vb = *(const u32x4*)(sm + (m0w + 2 * half + 1) * 256 + 192);
      const float wa[8] = {bflo(va.x), bfhi(va.x), bflo(va.y), bfhi(va.y), bflo(va.z), bfhi(va.z), bflo(va.w), bfhi(va.w)};
      const float wb[8] = {bflo(vb.x), bfhi(vb.x), bflo(vb.y), bfhi(vb.y), bflo(vb.z), bfhi(vb.z), bflo(vb.w), bfhi(vb.w)};
      const float sc = 0.125f * 0.35355339059327373f;
#pragma unroll
      for (int i = 0; i < 8; ++i) { wr[i] = wa[(i & 3) + 4 * (i >> 2)] * sc; wr[8 + i] = wb[(i & 3) + 4 * (i >> 2)] * sc; } }
    int offk[4];
#pragma unroll
    for (int ks = 0; ks < 4; ++ks) offk[ks] = col * 128 + ((((2 * ks + half) ^ ((col >> 1) & 7))) << 4);
    const int nch = qb / 8 + 1;
#define AT_STAGE(c, bufsel) do { _Pragma("unroll") for (int i_ = 0; i_ < 4; ++i_) { const int seg = 4 * w + i_, kl = 8 * seg + (lane >> 3), sp = (lane & 7) ^ ((kl >> 1) & 7); \
        __builtin_amdgcn_global_load_lds((const unsigned*)(sm + (rowb + 256 * (c) + kl) * 256 + 128 + 8 * sp), (LAS unsigned*)(lds + (bufsel) * 32768 + seg * 1024), 16, 0, 0); } } while (0)
    unsigned kA[64], kB[64];
    AT_STAGE(0, 0);
    asm volatile("s_waitcnt vmcnt(0)" ::: "memory"); __syncthreads();
#pragma unroll
    for (int c = 0; c < 8; ++c) {
        if (c < nch) {
            if (c + 1 < nch) AT_STAGE(c + 1, (c + 1) & 1);
#pragma unroll
            for (int jj = 0; jj < 8; ++jj) { const int j = 8 * c + jj;
                if (j <= qb) {
                    bf16x8 bk[4];
#pragma unroll
                    for (int ks = 0; ks < 4; ++ks) bk[ks] = *(const LAS bf16x8*)(lds + (c & 1) * 32768 + jj * 4096 + offk[ks]);
                    f32x16 acc = {0.f, 0.f, 0.f, 0.f, 0.f, 0.f, 0.f, 0.f, 0.f, 0.f, 0.f, 0.f, 0.f, 0.f, 0.f, 0.f};
#pragma unroll
                    for (int ks = 0; ks < 4; ++ks) acc = __builtin_amdgcn_mfma_f32_32x32x16_bf16(aq[ks], bk[ks], acc, 0, 0, 0);
                    float sA = 0.f, sB = 0.f;
#pragma unroll
                    for (int i = 0; i < 8; ++i) { sA = fmaf(wr[i], fmaxf(acc[i], 0.f), sA); sB = fmaf(wr[8 + i], fmaxf(acc[8 + i], 0.f), sB); }
                    bool vA = true, vB = true;
                    if (j == qb) { vA = col <= 4 * w + 2 * half; vB = col <= 4 * w + 2 * half + 1; }
                    kA[j] = vA ? skey(sA) : 0u; kB[j] = vB ? skey(sB) : 0u;
                } else { kA[j] = 0u; kB[j] = 0u; }
            }
            asm volatile("s_waitcnt vmcnt(0)" ::: "memory"); __syncthreads();
        } else {
#pragma unroll
            for (int jj = 0; jj < 8; ++jj) { kA[8 * c + jj] = 0u; kB[8 * c + jj] = 0u; }
        }
    }
#undef AT_STAGE
    const int nA = t0 + 4 * w + 2 * half + 1, nB = nA + 1;
    unsigned prefA = 0u, prefB = 0u, thrA = 1u, thrB = 1u; bool exA = nA <= TOPK, exB = nB <= TOPK;
    for (int bit = 31; bit >= 0; --bit) {
        if (__all(exA && exB)) break;
        const unsigned candA = prefA | (1u << bit), candB = prefB | (1u << bit);
        int cA = 0, cB = 0;
#pragma unroll
        for (int g = 0; g < 8; ++g) if (g < nch) {
#pragma unroll
            for (int jj = 0; jj < 8; ++jj) { cA += (kA[8 * g + jj] >= candA) ? 1 : 0; cB += (kB[8 * g + jj] >= candB) ? 1 : 0; } }
        cA = half_sum(cA); cB = half_sum(cB);
        if (!exA) { if (cA == TOPK) { thrA = candA; exA = true; } else if (cA > TOPK) prefA = candA; }
        if (!exB) { if (cB == TOPK) { thrB = candB; exB = true; } else if (cB > TOPK) prefB = candB; }
    }
    const unsigned tA = exA ? thrA : prefA + 1u, tB = exB ? thrB : prefB + 1u;
    unsigned mA[2] = {0u, 0u}, mB[2] = {0u, 0u};
#pragma unroll
    for (int j = 0; j < 64; ++j) { mA[j >> 5] |= (kA[j] >= tA) ? (1u << (j & 31)) : 0u; mB[j >> 5] |= (kB[j] >= tB) ? (1u << (j & 31)) : 0u; }
    if (!__all(exA && exB)) {
        const int needA = TOPK - half_sum(__popc(mA[0]) + __popc(mA[1])), needB = TOPK - half_sum(__popc(mB[0]) + __popc(mB[1]));
        int befA = 0, befB = 0; const unsigned below = (1u << col) - 1u;
#pragma unroll
        for (int j = 0; j < 64; ++j) {
            const bool eA = !exA && kA[j] == prefA, eB = !exB && kB[j] == prefB;
            const unsigned long long balA = __ballot(eA), balB = __ballot(eB);
            const unsigned hA = half ? (unsigned)(balA >> 32) : (unsigned)balA, hB = half ? (unsigned)(balB >> 32) : (unsigned)balB;
            if (eA && befA + __popc(hA & below) < needA) mA[j >> 5] |= 1u << (j & 31);
            if (eB && befB + __popc(hB & below) < needB) mB[j >> 5] |= 1u << (j & 31);
            befA += __popc(hA); befB += __popc(hB);
        }
    }
    const bf16_t* qbuf = (const bf16_t*)(F.ws + WS_Q); const bf16_t* vt = (const bf16_t*)(F.ws + WS_VT); const bf16_t* az = (const bf16_t*)(F.ws + WS_AZ); bf16_t* yb = (bf16_t*)(F.ws + WS_YB);
    typedef unsigned long long u64;
    u64 mq[4];
    { const unsigned oa0 = __shfl_xor(mA[0], 32), oa1 = __shfl_xor(mA[1], 32), ob0 = __shfl_xor(mB[0], 32), ob1 = __shfl_xor(mB[1], 32);
      const u64 ownA = ((u64)mA[1] << 32) | mA[0], ownB = ((u64)mB[1] << 32) | mB[0], othA = ((u64)oa1 << 32) | oa0, othB = ((u64)ob1 << 32) | ob0;
      mq[0] = half ? othA : ownA; mq[1] = half ? othB : ownB; mq[2] = half ? ownA : othA; mq[3] = half ? ownB : othB; }
    const int qlc = col >> 3, hd = col & 7;
    bf16x8 bq[4];
#pragma unroll
    for (int ks = 0; ks < 4; ++ks) bq[ks] = *(const bf16x8*)(qbuf + (m0w + qlc) * 512 + hd * 64 + 16 * ks + 8 * half);
    const float cslope = exp2f(-(float)(hd + 1)) * 1.4426950408889634f;
    const unsigned c_hi = f2bf(cslope), c_lo = f2bf(cslope - bf2f((bf16_t)c_hi));
    float mref = cslope * (float)(t0 + 4 * w + qlc);
    u32x4 bau;
#define AT_MPIECES(mval) do { const float v_ = -(mval); const unsigned uh_ = __float_as_uint(v_) & 0xffff0000u; const float r_ = v_ - __uint_as_float(uh_); \
        const unsigned um_ = __float_as_uint(r_) & 0xffff0000u; const float r2_ = r_ - __uint_as_float(um_); bau.z = half ? ((uh_ >> 16) | um_) : 0u; bau.w = half ? (unsigned)f2bf(r2_) : 0u; } while (0)
    if (half) { bau.x = (unsigned)f2bf(16.f * bf2f((bf16_t)c_hi)) | ((unsigned)f2bf(16.f * bf2f((bf16_t)c_lo)) << 16); bau.y = c_hi | (c_lo << 16); }
    else { bau.x = (qlc == 0 ? 0x3f80u : 0u) | (qlc == 1 ? 0x3f800000u : 0u); bau.y = (qlc == 2 ? 0x3f80u : 0u) | (qlc == 3 ? 0x3f800000u : 0u); }
    AT_MPIECES(mref);
    const unsigned slo_b = __float_as_uint((float)(col & 15)) >> 16, slo2 = slo_b | (slo_b << 16);
    int offv[2][2];
#pragma unroll
    for (int dt = 0; dt < 2; ++dt)
#pragma unroll
        for (int s2 = 0; s2 < 2; ++s2) offv[dt][s2] = (32 * dt + col) * 64 + ((((2 * s2 + half) ^ ((col >> 2) & 3))) << 4);
    f32x16 oacc[2];
#pragma unroll
    for (int dt = 0; dt < 2; ++dt)
#pragma unroll
        for (int i = 0; i < 16; ++i) oacc[dt][i] = 0.f;
    float lsum = 0.f; bool anch = false;
    const f32x16 zero16 = {0.f, 0.f, 0.f, 0.f, 0.f, 0.f, 0.f, 0.f, 0.f, 0.f, 0.f, 0.f, 0.f, 0.f, 0.f, 0.f};
#define AT_STAGE2(c, bufsel) do { _Pragma("unroll") for (int i_ = 0; i_ < 4; ++i_) { const int seg = 4 * w + i_, kl = 8 * seg + (lane >> 3), sp = (lane & 7) ^ ((kl >> 1) & 7); \
        __builtin_amdgcn_global_load_lds((const unsigned*)(sm + (rowb + 256 * (c) + kl) * 256 + 8 * sp), (LAS unsigned*)(lds + (bufsel) * 32768 + seg * 1024), 16, 0, 0); \
        const int dd_ = 16 * (seg & 3) + (lane >> 2), vp_ = (lane & 3) ^ ((dd_ >> 2) & 3); \
        __builtin_amdgcn_global_load_lds((const unsigned*)(vt + ((size_t)b * 64 + dd_) * SEQ + 256 * (c) + 32 * (seg >> 2) + 8 * vp_), (LAS unsigned*)(lds + 65536 + (bufsel) * 32768 + seg * 1024), 16, 0, 0); } } while (0)
    __syncthreads();
    AT_STAGE2(nch - 1, (nch - 1) & 1);
    asm volatile("s_waitcnt vmcnt(0)" ::: "memory"); __syncthreads();
    for (int c = nch - 1; c >= 0; --c) {
        if (c > 0) AT_STAGE2(c - 1, (c - 1) & 1);
        const LAS unsigned char* kimg = lds + (c & 1) * 32768; const LAS unsigned char* vimg = lds + 65536 + (c & 1) * 32768;
        for (int jj = 7; jj >= 0; --jj) { const int j = 8 * c + jj;
            if (j > qb) continue;
            bf16x8 ak[4];
#pragma unroll
            for (int ks = 0; ks < 4; ++ks) ak[ks] = *(const LAS bf16x8*)(kimg + jj * 4096 + offk[ks]);
            u32x4 aau;
            { const unsigned p0 = (unsigned)(~(mq[0] >> j) & 1ull) * 0xc700u, p1 = (unsigned)(~(mq[1] >> j) & 1ull) * 0xc700u, p2 = (unsigned)(~(mq[2] >> j) & 1ull) * 0xc700u, p3 = (unsigned)(~(mq[3] >> j) & 1ull) * 0xc700u;
              const unsigned shi_b = __float_as_uint((float)(2 * j + (col >> 4))) >> 16;
              aau.x = half ? (shi_b | (shi_b << 16)) : (p0 | (p1 << 16)); aau.y = half ? slo2 : (p2 | (p3 << 16)); aau.z = half ? 0x3f803f80u : 0u; aau.w = half ? 0x00003f80u : 0u; }
            f32x16 x = __builtin_amdgcn_mfma_f32_32x32x16_bf16(ak[0], bq[0], zero16, 0, 0, 0);
#pragma unroll
            for (int ks = 1; ks < 4; ++ks) x = __builtin_amdgcn_mfma_f32_32x32x16_bf16(ak[ks], bq[ks], x, 0, 0, 0);
            x = __builtin_amdgcn_mfma_f32_32x32x16_bf16(__builtin_bit_cast(bf16x8, aau), __builtin_bit_cast(bf16x8, bau), x, 0, 0, 0);
            float lmax = fmaxf(fmaxf(x[0], x[1]), fmaxf(x[2], x[3]));
#pragma unroll
            for (int i = 4; i < 16; i += 4) lmax = fmaxf(lmax, fmaxf(fmaxf(x[i], x[i + 1]), fmaxf(x[i + 2], x[i + 3])));
            lmax = fmaxf(lmax, __shfl_xor(lmax, 32));
            const bool need = anch ? (lmax > 8.f) : (lmax > -30000.f);
            if (__any(need)) {
                const float dl = need ? lmax : 0.f, f = (need && anch) ? exp2f(-dl) : 1.f;
                mref += dl; lsum *= f; anch = anch || need;
#pragma unroll
                for (int i = 0; i < 16; ++i) { x[i] -= dl; oacc[0][i] *= f; oacc[1][i] *= f; }
                AT_MPIECES(mref);
            }
            unsigned pw[8];
#pragma unroll
            for (int i = 0; i < 16; i += 2) { const float e0 = exp2f(x[i]), e1 = exp2f(x[i + 1]); lsum += e0 + e1; pw[i >> 1] = pk2(e0, e1); }
            const u32x4 pf0 = {pw[0], pw[1], pw[2], pw[3]}, pf1 = {pw[4], pw[5], pw[6], pw[7]};
#pragma unroll
            for (int dt = 0; dt < 2; ++dt) {
                const bf16x8 av0 = *(const LAS bf16x8*)(vimg + jj * 4096 + offv[dt][0]), av1 = *(const LAS bf16x8*)(vimg + jj * 4096 + offv[dt][1]);
                oacc[dt] = __builtin_amdgcn_mfma_f32_32x32x16_bf16(av0, __builtin_bit_cast(bf16x8, pf0), oacc[dt], 0, 0, 0);
                oacc[dt] = __builtin_amdgcn_mfma_f32_32x32x16_bf16(av1, __builtin_bit_cast(bf16x8, pf1), oacc[dt], 0, 0, 0); }
        }
        asm volatile("s_waitcnt vmcnt(0)" ::: "memory"); __syncthreads();
    }
#undef AT_STAGE2
#undef AT_MPIECES
    { const float inv = 1.f / (lsum + __shfl_xor(lsum, 32)); const size_t mrow = (m0w + qlc) * 512 + hd * 64;
#pragma unroll
      for (int dt = 0; dt < 2; ++dt)
#pragma unroll
          for (int g4 = 0; g4 < 4; ++g4) { const int d0 = 32 * dt + 8 * g4 + 4 * half; const u32x2 zz = *(const u32x2*)(az + mrow + d0);
              const float y0 = oacc[dt][4 * g4 + 0] * inv * siluf_(bflo(zz.x)), y1 = oacc[dt][4 * g4 + 1] * inv * siluf_(bfhi(zz.x)), y2 = oacc[dt][4 * g4 + 2] * inv * siluf_(bflo(zz.y)), y3 = oacc[dt][4 * g4 + 3] * inv * siluf_(bfhi(zz.y));
              u32x2 o; o.x = pk2(y0, y1); o.y = pk2(y2, y3); *(u32x2*)(yb + mrow + d0) = o; } }
}
__device__ __forceinline__ void p2_attn(Frame& F) {
    const int b = F.vcu >> 4, r = F.vcu & 15;
    for (int i = 0; i < 4; ++i) { const int qb = (i == 0) ? r : (i == 1) ? 31 - r : (i == 2) ? 32 + r : 63 - r;
        attn_unit(F, b, qb, F.lds + RING_OFF);
    }
}

__device__ __forceinline__ void p6_final(Frame& F) {
    float* out = F.out; const float* ssp2 = (const float*)(F.ws + WS_SSP2); const float* fg = F.in[14];
    int tid_ = threadIdx.x; asm volatile("" : "+v"(tid_));
    const int lane = tid_ & 63, gw = F.vcu * NWAVES + __builtin_amdgcn_readfirstlane(tid_ >> 6), NGW = F.G * NWAVES;
    for (int m = gw; m < M; m += NGW) { float s = (lane < 16) ? ssp2[(size_t)m * 16 + lane] : 0.f; s = wave_sum(s);
        const float r = rsqrtf(s * (1.f / D) + EPS); f32x4* o = (f32x4*)(out + (size_t)m * D) + lane;
#pragma unroll
        for (int j = 0; j < 4; ++j) { const f32x4 gv = ((const f32x4*)fg)[lane + 64 * j]; f32x4 v = o[64 * j]; v = v * r * gv; o[64 * j] = v; } }
}

struct Args { const float* in[15]; float* out; unsigned char* ws; };
__global__ void __launch_bounds__(NWAVES * 64, 2) fwd_kernel(Args args) {
    extern __shared__ __attribute__((aligned(16))) unsigned char lds_raw[];
    Frame F;
    F.lds = (LAS unsigned char*)lds_raw; F.MISC = (volatile LAS unsigned*)(F.lds + MISC_OFF);
    F.tid = threadIdx.x; F.lane = F.tid & 63; F.wave = __builtin_amdgcn_readfirstlane(F.tid >> 6);
    F.G = gridDim.x; { const int bx = blockIdx.x; F.vcu = (F.G % 8 == 0) ? (bx % 8) * (F.G / 8) + bx / 8 : bx; }
#pragma unroll
    for (int i = 0; i < 15; ++i) F.in[i] = args.in[i];
    F.out = args.out; F.ws = args.ws;
    unsigned char* ws = args.ws;
    for (int u = F.tid; u < (LDS_BYTES - LDSCTL_OFF) / 4; u += NWAVES * 64) ((LAS unsigned*)(F.lds + LDSCTL_OFF))[u] = 0u;
    __syncthreads();
    XcdBarrier bar = xcd_barrier_post((unsigned*)(ws + WS_CTL) + CW_BAR, F.MISC + 8);

#ifndef NO_P0
    p0_prep(F);
#endif
    xcd_barrier(bar);
    { pg8::Gemm g{(const bf16_t*)(ws + WS_XB), (const bf16_t*)(ws + WS_WIN), M, NINP, D}; pg8::StaticOrder S; S.init(M, NINP, F.G, (int)blockIdx.x);
      pg8::EpiInProj E{(const float*)(ws + WS_RINV), ws};
#ifndef NO_P1
      pg8::gemm_phase<pg8::EpiInProj, pg8::StaticOrder, true, true>(F.lds + RING_OFF, g, S, E);
#endif
    }
    xcd_barrier(bar);
#ifndef NO_P2A
    p2_conformer(F);
#endif
#ifndef NO_P2B
    p2_attn(F);
#endif
    xcd_barrier(bar);
    { pg8::Gemm g{(const bf16_t*)(ws + WS_YA), (const bf16_t*)(ws + WS_WA), M, D, DC}; pg8::StaticOrder S; S.init(M, D, F.G, (int)blockIdx.x);
      pg8::EpiOutA E{(const bf16_t*)(ws + WS_GA), F.out};
#ifndef NO_P3A
      pg8::gemm_phase<pg8::EpiOutA, pg8::StaticOrder, true, true>(F.lds + RING_OFF, g, S, E);
#endif
    }
    { pg8::Gemm g{(const bf16_t*)(ws + WS_YB), (const bf16_t*)(ws + WS_WB), M, D, DC}; pg8::StaticOrder S; S.init(M, D, F.G, (int)blockIdx.x);
      pg8::EpiOutB E{(const bf16_t*)(ws + WS_GB), F.out, (bf16_t*)(ws + WS_MRG)};
#ifndef NO_P3B
      pg8::gemm_phase<pg8::EpiOutB, pg8::StaticOrder, true, true>(F.lds + RING_OFF, g, S, E);
#endif
    }
    xcd_barrier(bar);
    { pg8::Gemm g{(const bf16_t*)(ws + WS_MRG), (const bf16_t*)(ws + WS_WO), M, D, D}; pg8::StaticOrder S; S.init(M, D, F.G, (int)blockIdx.x);
      pg8::EpiWo E{F.in[0], F.out, (bf16_t*)(ws + WS_X1B), (float*)(ws + WS_SSP1)};
#ifndef NO_P4
      pg8::gemm_phase<pg8::EpiWo, pg8::StaticOrder, true, true>(F.lds + RING_OFF, g, S, E);
#endif
    }
    xcd_barrier(bar);
    { pg8::Gemm g{(const bf16_t*)(ws + WS_PB), (const bf16_t*)(ws + WS_WP), M, D, DPLE}; pg8::StaticOrder S; S.init(M, D, F.G, (int)blockIdx.x);
      pg8::EpiPP E{(bf16_t*)(ws + WS_PP)};
#ifndef NO_P5A
      pg8::gemm_phase<pg8::EpiPP, pg8::StaticOrder, true, true>(F.lds + RING_OFF, g, S, E);
#endif
    }
    __builtin_amdgcn_sched_barrier(0); asm volatile("" ::: "memory");
    { pg8::Gemm g{(const bf16_t*)(ws + WS_X1B), (const bf16_t*)(ws + WS_WG), M, D, D}; pg8::StaticOrder S; S.init(M, D, F.G, (int)blockIdx.x);
      pg8::EpiGate E{F.out, (const bf16_t*)(ws + WS_PP), (const float*)(ws + WS_SSP1), (float*)(ws + WS_SSP2)};
#ifndef NO_P5B
      pg8::gemm_phase<pg8::EpiGate, pg8::StaticOrder, true, true>(F.lds + RING_OFF, g, S, E);
#endif
    }
    xcd_barrier(bar);
#ifndef NO_P6
    p6_final(F);
#endif
}

extern "C" void kernel_launch(void* const* d_in, const int* in_sizes, int n_in, void* d_out, int out_size, void* d_ws, size_t ws_size, hipStream_t stream) {
    static int grid = 0;
    if (grid == 0) {
        if (n_in != 15 || out_size != M * D || ws_size < WS_END) { fprintf(stderr, "kernel_launch: unexpected sizes n_in %d out %d ws %zu\n", n_in, out_size, ws_size); grid = -1; return; }
        int dev = 0, cus = 0, per_cu = 0;
        if (hipGetDevice(&dev) != hipSuccess || hipDeviceGetAttribute(&cus, hipDeviceAttributeMultiprocessorCount, dev) != hipSuccess) { grid = -1; return; }
        if (hipFuncSetAttribute((const void*)fwd_kernel, hipFuncAttributeMaxDynamicSharedMemorySize, LDS_BYTES) != hipSuccess) { fprintf(stderr, "kernel_launch: hipFuncSetAttribute failed\n"); grid = -1; return; }
        if (hipOccupancyMaxActiveBlocksPerMultiprocessor(&per_cu, (const void*)fwd_kernel, NWAVES * 64, LDS_BYTES) != hipSuccess || per_cu < 1) { fprintf(stderr, "kernel_launch: occupancy query reports %d blocks per CU\n", per_cu); (void)hipGetLastError(); grid = -1; return; }
        grid = cus;
        if (M % grid != 0 || grid % 8 != 0) { fprintf(stderr, "kernel_launch: unsupported CU count %d\n", grid); grid = -1; return; }
    }
    if (grid < 0) return;
    (void)hipMemsetAsync((char*)d_ws + WS_CTL, 0, CTL_ZERO_BYTES, stream);
    Args a{};
    for (int i = 0; i < 15; ++i) a.in[i] = (const float*)d_in[i];
    a.out = (float*)d_out; a.ws = (unsigned char*)d_ws;
    hipLaunchKernelGGL(fwd_kernel, dim3(grid), dim3(NWAVES * 64), LDS_BYTES, stream, a);
}
```

```cpp
#include <hip/hip_runtime.h>
#include <cstdint>
#include <cstdio>

typedef unsigned short bf16_t;
typedef float f32x4 __attribute__((ext_vector_type(4)));
typedef unsigned u32x4 __attribute__((ext_vector_type(4)));
typedef unsigned u32x2 __attribute__((ext_vector_type(2)));
#define GAS __attribute__((address_space(1)))
#define LAS __attribute__((address_space(3)))
#define LDS_WAIT() asm volatile("s_waitcnt lgkmcnt(0)" ::: "memory")
#define VM_WAIT() asm volatile("s_waitcnt vmcnt(0)" ::: "memory")

constexpr int NB = 16, SEQ = 2048, D = 1024, M = NB * SEQ;
constexpr int DPLE = 256, DC = 512, CWID = 31, NH = 8, HD = 64, TOPK = 256;
constexpr int NIN = 5320, NINP = 5376;
constexpr float EPS = 1e-6f;

constexpr size_t MiB = 1u << 20;
constexpr size_t WS_CTL = 0;
constexpr size_t CTL_ZERO_BYTES = 64 * 1024;
constexpr int CW_BAR = 4096;
constexpr size_t WS_WIN = 2 * MiB;
constexpr size_t WS_WA = 13 * MiB;
constexpr size_t WS_WB = 14 * MiB;
constexpr size_t WS_WO = 15 * MiB;
constexpr size_t WS_WG = 17 * MiB;
constexpr size_t WS_WP = 19 * MiB;
constexpr size_t WS_RINV = 20 * MiB;
constexpr size_t WS_SSP1 = 22 * MiB;
constexpr size_t WS_SSP2 = 24 * MiB;
constexpr size_t WS_VT = 26 * MiB;
constexpr size_t WS_XB = 32 * MiB;
constexpr size_t WS_YA = 32 * MiB, WS_YB = 64 * MiB;
constexpr size_t WS_PB = 96 * MiB;
constexpr size_t WS_CIN = 112 * MiB;
constexpr size_t WS_MRG = 112 * MiB;
constexpr size_t WS_CZ = 176 * MiB;
constexpr size_t WS_Q = 208 * MiB;
constexpr size_t WS_X1B = 176 * MiB;
constexpr size_t WS_AZ = 240 * MiB;
constexpr size_t WS_IQ = 272 * MiB;
constexpr size_t WS_SM = 304 * MiB;
constexpr size_t WS_GA = 320 * MiB;
constexpr size_t WS_PP = 320 * MiB;
constexpr size_t WS_GB = 384 * MiB;
constexpr size_t WS_END = 448 * MiB;

__device__ __forceinline__ float bf2f(bf16_t h) { return __uint_as_float(((unsigned)h) << 16); }
typedef float f32x2_t __attribute__((ext_vector_type(2))); typedef __bf16 bf16x2_t __attribute__((ext_vector_type(2)));
__device__ __forceinline__ unsigned pk2(float lo, float hi) { const f32x2_t v = {lo, hi}; const bf16x2_t b = __builtin_convertvector(v, bf16x2_t); return __builtin_bit_cast(unsigned, b); }
__device__ __forceinline__ bf16_t f2bf(float f) { return (bf16_t)(pk2(f, 0.f) & 0xffffu); }
__device__ __forceinline__ float bflo(unsigned w) { return __uint_as_float(w << 16); }
__device__ __forceinline__ float bfhi(unsigned w) { return __uint_as_float(w & 0xffff0000u); }
__device__ __forceinline__ float sigmoidf_(float x) { return __builtin_amdgcn_rcpf(1.f + __builtin_amdgcn_exp2f(-1.4426950408889634f * x)); }
__device__ __forceinline__ float siluf_(float x) { return x * sigmoidf_(x); }
__device__ __forceinline__ float wave_sum(float v) {
#pragma unroll
    for (int o = 1; o < 64; o <<= 1) v += __shfl_xor(v, o);
    return v;
}

__host__ __device__ __forceinline__ int inmap(int n) {
    if (n < 2048) return n;
    if (n < 2560) return 2176 + (n - 2048);
    if (n < 3072) return 2688 + (n - 2560);
    if (n < 3328) { const int j = n - 3072;
        if (j < 64) return 2048 + j; if (j < 128) return 2112 + (j - 64); if (j < 192) return 3200 + (j - 128); if (j < 200) return 3264 + (j - 192); return -1; }
    if (n < 4352) return 3272 + (n - 3328);
    return 4296 + (n - 4352);
}
namespace pg8 {
#define PG8_LAS __attribute__((address_space(3)))
typedef unsigned short bf16_t;
typedef short bf16x8 __attribute__((ext_vector_type(8)));
typedef float f32x4 __attribute__((ext_vector_type(4)));
typedef unsigned u32x4 __attribute__((ext_vector_type(4)));
constexpr int BM = 256, BK = 64, HALF = 128, HTB = HALF * BK * 2  , STAGE_BYTES = 8 * HTB, NXCD = 8, WGM = 8;

__host__ __device__ __forceinline__ int lds_byte(int r, int c) { const int st = (r >> 4) * 2 + (c >> 5), rr = r & 15, cc = c & 31, ob = rr * 64 + cc * 2; return st * 1024 + (ob ^ (((ob >> 9) & 1) << 5)); }
__host__ __device__ __forceinline__ void stage_rc(int b, int& R, int& C) { const int st = b / 1024, sb = b % 1024, swz = sb ^ (((sb >> 9) & 1) << 5); R = (st >> 1) * 16 + swz / 64; C = (st & 1) * 32 + (swz % 64) / 2; }
__host__ __device__ __forceinline__ int perm32(int rho) { const int n = rho >> 4, i = rho & 15; return 8 * (i >> 2) + 4 * n + (i & 3); }

struct Unit { int pm, pn; };
struct Gemm { const bf16_t* A; const bf16_t* Bt; int M, N, K; };

struct StaticOrder {
    int nM, nN, nwg, G, c;
    __host__ __device__ void init(int M, int N, int G_, int c_) { nM = M / BM; nN = N / BM; nwg = nM * nN; G = G_; c = c_; }
    __host__ __device__ bool next(int i, Unit& u) const {
        const long L = (long)i * G + c; if (L >= nwg) return false;
        int wgid = (int)L; { const int q = nwg / NXCD, r = nwg % NXCD, xcd = wgid % NXCD, off = wgid / NXCD; wgid = (xcd < r ? xcd * (q + 1) : r * (q + 1) + (xcd - r) * q) + off; }
        const int nig = WGM * nN, gid = wgid / nig, fm = gid * WGM, gsz = (nM - fm) < WGM ? (nM - fm) : WGM;
        u.pm = fm + ((wgid % nig) % gsz); u.pn = (wgid % nig) / gsz; return true;
    }
    __device__ __forceinline__ void a_ready(const Unit&) const {}
    __device__ __forceinline__ void done(const Unit&) const {}
};
__device__ __forceinline__ unsigned cvt_pk_bf16(float lo, float hi) { unsigned r; asm volatile("v_cvt_pk_bf16_f32 %0, %1, %2" : "=v"(r) : "v"(lo), "v"(hi)); return r; }
struct EpiInProj {
    static constexpr bool PERM = true, AFTER_DRAIN = false;
    const float* rinv; unsigned char* ws;
    __device__ __forceinline__ void operator()(const f32x4 (&acc)[2][2][4][2], const Unit& u, int wr, int wc, int fr, int fq) const {
        size_t off; int ld, colt; const int pn = u.pn;
        if (pn < 4) { off = WS_CIN; ld = 1024; colt = pn * 256; }
        else if (pn < 6) { off = WS_CZ; ld = 512; colt = (pn - 4) * 256; }
        else if (pn < 8) { off = WS_Q; ld = 512; colt = (pn - 6) * 256; }
        else if (pn < 10) { off = WS_AZ; ld = 512; colt = (pn - 8) * 256; }
        else if (pn < 12) { off = WS_IQ; ld = 512; colt = (pn - 10) * 256; }
        else if (pn < 13) { off = WS_SM; ld = 256; colt = 0; }
        else if (pn < 17) { off = WS_GA; ld = 1024; colt = (pn - 13) * 256; }
        else { off = WS_GB; ld = 1024; colt = (pn - 17) * 256; }
        bf16_t* base = (bf16_t*)(ws + off);
        const float qs = (pn == 6 || pn == 7) ? 0.125f * 1.4426950408889634f : 1.f;
        const int row0 = u.pm * BM + wr * 64 + fr, col0 = colt + wc * 32 + 8 * fq;
#pragma unroll
        for (int ai = 0; ai < 2; ++ai)
#pragma unroll
            for (int m = 0; m < 4; ++m) { const int row = row0 + ai * HALF + m * 16; const float r = rinv[row] * qs; bf16_t* rowp = base + (size_t)row * ld + col0;
#pragma unroll
                for (int bj = 0; bj < 2; ++bj) { const f32x4 v0 = acc[ai][bj][m][0] * r, v1 = acc[ai][bj][m][1] * r;
                    u32x4 w; w.x = cvt_pk_bf16(v0[0], v0[1]); w.y = cvt_pk_bf16(v0[2], v0[3]); w.z = cvt_pk_bf16(v1[0], v1[1]); w.w = cvt_pk_bf16(v1[2], v1[3]);
                    *(u32x4*)(rowp + bj * HALF) = w; } }
        if (pn == 12 && wc >= 2) {
            bf16_t* vt = (bf16_t*)(ws + WS_VT); const int d0 = (wc - 2) * 32 + 8 * fq;
#pragma unroll
            for (int ai = 0; ai < 2; ++ai)
#pragma unroll
                for (int m = 0; m < 4; ++m) { const int row = row0 + ai * HALF + m * 16; const float r = rinv[row]; const int bb = row >> 11, sq = row & 2047, k5 = sq & 31;
                    const int pos = (sq & ~31) + ((k5 & 0x13) | ((k5 & 4) << 1) | ((k5 & 8) >> 1)); bf16_t* vp = vt + ((size_t)bb * 64 + d0) * 2048 + pos;
                    const f32x4 v0 = acc[ai][0][m][0] * r, v1 = acc[ai][0][m][1] * r;
#pragma unroll
                    for (int e = 0; e < 4; ++e) { vp[(size_t)e * 2048] = f2bf(v0[e]); vp[(size_t)(4 + e) * 2048] = f2bf(v1[e]); } }
        }
    }
};
__device__ __forceinline__ f32x4 sig4lo(unsigned a, unsigned b) { return (f32x4){sigmoidf_(bflo(a)), sigmoidf_(bfhi(a)), sigmoidf_(bflo(b)), sigmoidf_(bfhi(b))}; }
struct EpiOutA {
    static constexpr bool PERM = true, AFTER_DRAIN = false;
    const bf16_t* ga; float* part;
    __device__ __forceinline__ void operator()(const f32x4 (&acc)[2][2][4][2], const Unit& u, int wr, int wc, int fr, int fq) const {
        const int row0 = u.pm * BM + wr * 64 + fr, col0 = u.pn * BM + wc * 32 + 8 * fq;
#pragma unroll
        for (int ai = 0; ai < 2; ++ai)
#pragma unroll
            for (int m = 0; m < 4; ++m) { const size_t idx = (size_t)(row0 + ai * HALF + m * 16) * D + col0;
#pragma unroll
                for (int bj = 0; bj < 2; ++bj) { const u32x4 g = *(const u32x4*)(ga + idx + bj * HALF);
                    *(f32x4*)(part + idx + bj * HALF) = sig4lo(g.x, g.y) * acc[ai][bj][m][0]; *(f32x4*)(part + idx + bj * HALF + 4) = sig4lo(g.z, g.w) * acc[ai][bj][m][1]; } }
    }
};
struct EpiOutB {
    static constexpr bool PERM = true, AFTER_DRAIN = false;
    const bf16_t* gb; const float* part; bf16_t* mrg;
    __device__ __forceinline__ void operator()(const f32x4 (&acc)[2][2][4][2], const Unit& u, int wr, int wc, int fr, int fq) const {
        const int row0 = u.pm * BM + wr * 64 + fr, col0 = u.pn * BM + wc * 32 + 8 * fq;
#pragma unroll
        for (int ai = 0; ai < 2; ++ai)
#pragma unroll
            for (int m = 0; m < 4; ++m) { const size_t idx = (size_t)(row0 + ai * HALF + m * 16) * D + col0;
#pragma unroll
                for (int bj = 0; bj < 2; ++bj) { const u32x4 g = *(const u32x4*)(gb + idx + bj * HALF);
                    const f32x4 v0 = *(const f32x4*)(part + idx + bj * HALF) + sig4lo(g.x, g.y) * acc[ai][bj][m][0], v1 = *(const f32x4*)(part + idx + bj * HALF + 4) + sig4lo(g.z, g.w) * acc[ai][bj][m][1];
                    u32x4 w; w.x = cvt_pk_bf16(v0[0], v0[1]); w.y = cvt_pk_bf16(v0[2], v0[3]); w.z = cvt_pk_bf16(v1[0], v1[1]); w.w = cvt_pk_bf16(v1[2], v1[3]);
                    *(u32x4*)(mrg + idx + bj * HALF) = w; } }
    }
};
__device__ __forceinline__ float sq4(const f32x4 v) { return (v[0] * v[0] + v[1] * v[1]) + (v[2] * v[2] + v[3] * v[3]); }
struct EpiWo {
    static constexpr bool PERM = true, AFTER_DRAIN = false;
    const float* x; float* out; bf16_t* x1b; float* ssp;
    __device__ __forceinline__ void operator()(const f32x4 (&acc)[2][2][4][2], const Unit& u, int wr, int wc, int fr, int fq) const {
        const int row0 = u.pm * BM + wr * 64 + fr, col0 = u.pn * BM + wc * 32 + 8 * fq;
#pragma unroll
        for (int ai = 0; ai < 2; ++ai)
#pragma unroll
            for (int m = 0; m < 4; ++m) { const int row = row0 + ai * HALF + m * 16; const size_t idx = (size_t)row * D + col0; float s = 0.f;
#pragma unroll
                for (int bj = 0; bj < 2; ++bj) { const f32x4 v0 = *(const f32x4*)(x + idx + bj * HALF) + acc[ai][bj][m][0], v1 = *(const f32x4*)(x + idx + bj * HALF + 4) + acc[ai][bj][m][1];
                    *(f32x4*)(out + idx + bj * HALF) = v0; *(f32x4*)(out + idx + bj * HALF + 4) = v1; s += sq4(v0) + sq4(v1);
                    u32x4 w; w.x = cvt_pk_bf16(v0[0], v0[1]); w.y = cvt_pk_bf16(v0[2], v0[3]); w.z = cvt_pk_bf16(v1[0], v1[1]); w.w = cvt_pk_bf16(v1[2], v1[3]);
                    *(u32x4*)(x1b + idx + bj * HALF) = w; }
                s += __shfl_xor(s, 16); s += __shfl_xor(s, 32);
                if (fq == 0) ssp[(size_t)row * 16 + u.pn * 4 + wc] = s; }
    }
};
struct EpiPP {
    static constexpr bool PERM = true, AFTER_DRAIN = false;
    bf16_t* pp;
    __device__ __forceinline__ void operator()(const f32x4 (&acc)[2][2][4][2], const Unit& u, int wr, int wc, int fr, int fq) const {
        const int row0 = u.pm * BM + wr * 64 + fr, col0 = u.pn * BM + wc * 32 + 8 * fq;
#pragma unroll
        for (int ai = 0; ai < 2; ++ai)
#pragma unroll
            for (int m = 0; m < 4; ++m) { const size_t idx = (size_t)(row0 + ai * HALF + m * 16) * D + col0;
#pragma unroll
                for (int bj = 0; bj < 2; ++bj) { const f32x4 v0 = acc[ai][bj][m][0], v1 = acc[ai][bj][m][1];
                    u32x4 w; w.x = cvt_pk_bf16(v0[0], v0[1]); w.y = cvt_pk_bf16(v0[2], v0[3]); w.z = cvt_pk_bf16(v1[0], v1[1]); w.w = cvt_pk_bf16(v1[2], v1[3]);
                    *(u32x4*)(pp + idx + bj * HALF) = w; } }
    }
};
struct EpiGate {
    static constexpr bool PERM = true, AFTER_DRAIN = false;
    float* out; const bf16_t* pp; const float* ssp1; float* ssp2;
    __device__ __forceinline__ void operator()(const f32x4 (&acc)[2][2][4][2], const Unit& u, int wr, int wc, int fr, int fq) const {
        const int row0 = u.pm * BM + wr * 64 + fr, col0 = u.pn * BM + wc * 32 + 8 * fq;
#pragma unroll
        for (int ai = 0; ai < 2; ++ai)
#pragma unroll
            for (int m = 0; m < 4; ++m) { const int row = row0 + ai * HALF + m * 16; const size_t idx = (size_t)row * D + col0;
                const f32x4* sp = (const f32x4*)(ssp1 + (size_t)row * 16); const f32x4 t4 = (sp[0] + sp[1]) + (sp[2] + sp[3]);
                const float r1 = rsqrtf(((t4[0] + t4[1]) + (t4[2] + t4[3])) * (1.f / D) + EPS); float s = 0.f;
#pragma unroll
                for (int bj = 0; bj < 2; ++bj) { const u32x4 pw = *(const u32x4*)(pp + idx + bj * HALF); const f32x4 a0 = acc[ai][bj][m][0] * r1, a1 = acc[ai][bj][m][1] * r1;
                    const f32x4 g0 = (f32x4){sigmoidf_(a0[0]), sigmoidf_(a0[1]), sigmoidf_(a0[2]), sigmoidf_(a0[3])}, g1 = (f32x4){sigmoidf_(a1[0]), sigmoidf_(a1[1]), sigmoidf_(a1[2]), sigmoidf_(a1[3])};
                    const f32x4 p0 = (f32x4){bflo(pw.x), bfhi(pw.x), bflo(pw.y), bfhi(pw.y)}, p1 = (f32x4){bflo(pw.z), bfhi(pw.z), bflo(pw.w), bfhi(pw.w)};
                    const f32x4 v0 = *(const f32x4*)(out + idx + bj * HALF) + g0 * p0, v1 = *(const f32x4*)(out + idx + bj * HALF + 4) + g1 * p1;
                    *(f32x4*)(out + idx + bj * HALF) = v0; *(f32x4*)(out + idx + bj * HALF + 4) = v1; s += sq4(v0) + sq4(v1); }
                s += __shfl_xor(s, 16); s += __shfl_xor(s, 32);
                if (fq == 0) ssp2[(size_t)row * 16 + u.pn * 4 + wc] = s; }
    }
};
template <class Epi, class Sched, bool ALIGN_EPI = false, bool SP2 = false>
__device__ __forceinline__ void gemm_phase(PG8_LAS unsigned char* lds, const Gemm g, const Sched& S, const Epi& E) {
    int tid_ = threadIdx.x; asm volatile("" : "+v"(tid_));
    const int tid = tid_, wid = __builtin_amdgcn_readfirstlane(tid >> 6), lane = tid & 63, wr = wid >> 2, wc = wid & 3, fr = lane & 15, fq = lane >> 4;
    int K_ = g.K; asm volatile("" : "+s"(K_));
    const int K = K_, nt = K / BK;
    unsigned voffA[2], voffB[2];
#pragma unroll
    for (int i = 0; i < 2; ++i) { int R, C; stage_rc(tid * 16 + i * 8192, R, C); const int Rb = Epi::PERM ? ((R & ~31) + perm32(R & 31)) : R;
        voffA[i] = (unsigned)(R * K + C) * 2u; voffB[i] = (unsigned)(Rb * K + C) * 2u; }
    const size_t kstep = (size_t)(BK * 2);
    const size_t hstep = (size_t)HALF * K * 2;
    const size_t tstep = 2 * hstep;
    const unsigned ldsw = (unsigned)wid * 1024u;
    const int aoff = lds_byte(wr * 64 + fr, fq * 8), boff = lds_byte(wc * 32 + fr, fq * 8);
#define PG8_SA(b, h) (((b) * 2 + (h)) * HTB)
#define PG8_SB(b, h) ((4 + (b) * 2 + (h)) * HTB)
#define PG8_STAGE(bufoff, gbase, voff) do { _Pragma("unroll") for (int _i = 0; _i < 2; ++_i) \
        __builtin_amdgcn_global_load_lds((const unsigned*)((const char*)(gbase) + (voff)[_i]), (PG8_LAS unsigned*)(lds + (bufoff) + ldsw + _i * 8192), 16, 0, 0); } while (0)
#define PG8_LDA(dst, b, h) do { _Pragma("unroll") for (int m = 0; m < 4; ++m) _Pragma("unroll") for (int k = 0; k < 2; ++k) dst[m][k] = *(const PG8_LAS bf16x8*)(lds + PG8_SA(b, h) + aoff + m * 2048 + k * 1024); } while (0)
#define PG8_LDB(dst, b, h) do { _Pragma("unroll") for (int n = 0; n < 2; ++n) _Pragma("unroll") for (int k = 0; k < 2; ++k) dst[n][k] = *(const PG8_LAS bf16x8*)(lds + PG8_SB(b, h) + boff + n * 2048 + k * 1024); } while (0)
#define PG8_MMA(ai, bj, At, Bt) do { __builtin_amdgcn_s_setprio(1); _Pragma("unroll") for (int m = 0; m < 4; ++m) _Pragma("unroll") for (int n = 0; n < 2; ++n) _Pragma("unroll") for (int k = 0; k < 2; ++k) \
        acc[ai][bj][m][n] = __builtin_amdgcn_mfma_f32_16x16x32_bf16(Bt[n][k], At[m][k], acc[ai][bj][m][n], 0, 0, 0); __builtin_amdgcn_s_setprio(0); } while (0)
#define PG8_WAIT_V(n) asm volatile("s_waitcnt vmcnt(" #n ")" ::: "memory")
#define PG8_WAIT_L(n) asm volatile("s_waitcnt lgkmcnt(" #n ")" ::: "memory")
#define PG8_BAR __builtin_amdgcn_s_barrier()
#define PG8_SCHED __builtin_amdgcn_sched_barrier(0)
    Unit cur, nxt; int ui = 0;
    if (!S.next(0, cur)) return;
    f32x4 acc[2][2][4][2];
#pragma unroll
    for (int a = 0; a < 2; ++a)
#pragma unroll
        for (int b = 0; b < 2; ++b)
#pragma unroll
            for (int m = 0; m < 4; ++m)
#pragma unroll
                for (int n = 0; n < 2; ++n) acc[a][b][m][n] = (f32x4){0.f, 0.f, 0.f, 0.f};
    bf16x8 At[4][2], B0[2][2], B1[2][2];
    const char* cA = (const char*)g.A + (size_t)cur.pm * tstep; const char* cB = (const char*)g.Bt + (size_t)cur.pn * tstep;
    S.a_ready(cur);
    if constexpr (SP2) {
        PG8_STAGE(PG8_SB(0, 0), cB, voffB); PG8_STAGE(PG8_SB(0, 1), cB + hstep, voffB); PG8_STAGE(PG8_SA(0, 0), cA, voffA); PG8_STAGE(PG8_SA(0, 1), cA + hstep, voffA);
        if (wr == 1) PG8_BAR;
        PG8_WAIT_V(2); PG8_BAR;
        PG8_STAGE(PG8_SB(1, 0), cB + kstep, voffB); PG8_STAGE(PG8_SA(1, 0), cA + kstep, voffA); PG8_STAGE(PG8_SB(1, 1), cB + hstep + kstep, voffB);
        PG8_WAIT_V(6); PG8_BAR;
    } else {
        PG8_STAGE(PG8_SB(0, 0), cB, voffB); PG8_STAGE(PG8_SA(0, 0), cA, voffA); PG8_STAGE(PG8_SB(0, 1), cB + hstep, voffB); PG8_STAGE(PG8_SA(0, 1), cA + hstep, voffA);
        if (wr == 1) PG8_BAR;
        PG8_WAIT_V(4); PG8_BAR;
        PG8_STAGE(PG8_SB(1, 0), cB + kstep, voffB); PG8_STAGE(PG8_SA(1, 0), cA + kstep, voffA); PG8_STAGE(PG8_SB(1, 1), cB + hstep + kstep, voffB);
        PG8_WAIT_V(6); PG8_BAR;
    }
    for (;;) {
        const bool has_next = S.next(ui + 1, nxt);
        const char* nA = has_next ? (const char*)g.A + (size_t)nxt.pm * tstep : cA; const char* nB = has_next ? (const char*)g.Bt + (size_t)nxt.pn * tstep : cB;
        for (int t = 0; t < nt; t += 2) {
            const bool last = (t == nt - 2);
            const char* a1 = cA + (size_t)(t + 1) * kstep;
            const char* a2 = last ? nA : cA + (size_t)(t + 2) * kstep; const char* b2 = last ? nB : cB + (size_t)(t + 2) * kstep;
            const char* a3 = a2 + kstep; const char* b3 = b2 + kstep;
            if (last && has_next) S.a_ready(nxt);
            if constexpr (SP2) {
            PG8_LDB(B0, 0, 0); PG8_LDB(B1, 0, 1); PG8_SCHED; PG8_LDA(At, 0, 0); PG8_STAGE(PG8_SA(1, 1), a1 + hstep, voffA);
            PG8_WAIT_V(8); PG8_WAIT_L(0); PG8_BAR; PG8_MMA(0, 0, At, B0); PG8_MMA(0, 1, At, B1); PG8_BAR; PG8_SCHED;
            PG8_LDA(At, 0, 1); PG8_STAGE(PG8_SB(0, 0), b2, voffB); PG8_STAGE(PG8_SB(0, 1), b2 + hstep, voffB); PG8_STAGE(PG8_SA(0, 0), a2, voffA);
            PG8_WAIT_V(8); PG8_WAIT_L(0); PG8_BAR; PG8_MMA(1, 0, At, B0); PG8_MMA(1, 1, At, B1); PG8_BAR; PG8_SCHED;
            PG8_LDB(B0, 1, 0); PG8_LDB(B1, 1, 1); PG8_SCHED; PG8_LDA(At, 1, 0); PG8_STAGE(PG8_SA(0, 1), a2 + hstep, voffA);
            PG8_WAIT_V(8); PG8_WAIT_L(0); PG8_BAR; PG8_MMA(0, 0, At, B0); PG8_MMA(0, 1, At, B1); PG8_BAR; PG8_SCHED;
            PG8_LDA(At, 1, 1); PG8_STAGE(PG8_SB(1, 0), b3, voffB); PG8_STAGE(PG8_SB(1, 1), b3 + hstep, voffB); PG8_STAGE(PG8_SA(1, 0), a3, voffA);
            PG8_WAIT_V(8); PG8_WAIT_L(0); PG8_BAR; PG8_MMA(1, 0, At, B0); PG8_MMA(1, 1, At, B1); PG8_BAR; PG8_SCHED;
            } else {
            PG8_LDB(B0, 0, 0); PG8_SCHED; PG8_LDA(At, 0, 0); PG8_STAGE(PG8_SA(1, 1), a1 + hstep, voffA);
            PG8_WAIT_L(8); PG8_BAR; PG8_WAIT_L(0); PG8_MMA(0, 0, At, B0); PG8_BAR; PG8_SCHED;
            PG8_LDB(B1, 0, 1); PG8_STAGE(PG8_SB(0, 0), b2, voffB);
            PG8_BAR; PG8_WAIT_L(0); PG8_MMA(0, 1, At, B1); PG8_BAR;
            PG8_LDA(At, 0, 1); PG8_STAGE(PG8_SA(0, 0), a2, voffA);
            PG8_BAR; PG8_WAIT_L(0); PG8_MMA(1, 0, At, B0); PG8_BAR; PG8_SCHED;
            PG8_STAGE(PG8_SB(0, 1), b2 + hstep, voffB);
            PG8_WAIT_V(6); PG8_BAR; PG8_MMA(1, 1, At, B1); PG8_BAR;
            PG8_LDB(B0, 1, 0); PG8_SCHED; PG8_LDA(At, 1, 0); PG8_STAGE(PG8_SA(0, 1), a2 + hstep, voffA);
            PG8_WAIT_L(8); PG8_BAR; PG8_WAIT_L(0); PG8_MMA(0, 0, At, B0); PG8_BAR; PG8_SCHED;
            PG8_LDB(B1, 1, 1); PG8_STAGE(PG8_SB(1, 0), b3, voffB);
            PG8_BAR; PG8_WAIT_L(0); PG8_MMA(0, 1, At, B1); PG8_BAR;
            PG8_LDA(At, 1, 1); PG8_STAGE(PG8_SA(1, 0), a3, voffA);
            PG8_BAR; PG8_WAIT_L(0); PG8_MMA(1, 0, At, B0); PG8_BAR; PG8_SCHED;
            PG8_STAGE(PG8_SB(1, 1), b3 + hstep, voffB);
            PG8_WAIT_V(6); PG8_BAR; PG8_MMA(1, 1, At, B1); PG8_BAR;
            }
        }
        if constexpr (ALIGN_EPI) { if (wr == 0) PG8_BAR; }
        if constexpr (!Epi::AFTER_DRAIN) { E(acc, cur, wr, wc, fr, fq); S.done(cur); }
        if (!has_next) break;
#pragma unroll
        for (int a = 0; a < 2; ++a)
#pragma unroll
            for (int b = 0; b < 2; ++b)
#pragma unroll
                for (int m = 0; m < 4; ++m)
#pragma unroll
                    for (int n = 0; n < 2; ++n) acc[a][b][m][n] = (f32x4){0.f, 0.f, 0.f, 0.f};
        cur = nxt; cA = nA; cB = nB; ++ui;
        if constexpr (ALIGN_EPI) { if (wr == 1) PG8_BAR; }
    }
    PG8_WAIT_V(0);
    if constexpr (!ALIGN_EPI) { if (wr == 0) PG8_BAR; }
    PG8_BAR;
    if constexpr (Epi::AFTER_DRAIN) { E.fused(acc, cur, wr, wc, fr, fq, lds, wid, lane); S.done(cur); }
#undef PG8_SA
#undef PG8_SB
#undef PG8_STAGE
#undef PG8_LDA
#undef PG8_LDB
#undef PG8_MMA
#undef PG8_WAIT_V
#undef PG8_WAIT_L
#undef PG8_BAR
#undef PG8_SCHED
}
}
#define XB_TMO      128
#define XB_XCNT(j)  (256  + 64 * (j))
#define XB_XSUB(j)  (1280 + 64 * (j))
#define XB_XGEN(j)  (2304 + 64 * (j))
#define XB_TOP      3328
#define XB_TOPGEN   3392
#define XCD_BAR_WORDS 3456
#define XB_SPIN_CAP (1u << 18)

__device__ __forceinline__ unsigned xb_ld(unsigned* p)              { return __hip_atomic_load(p, __ATOMIC_RELAXED, __HIP_MEMORY_SCOPE_AGENT); }
__device__ __forceinline__ unsigned xb_add(unsigned* p, unsigned v) { return __hip_atomic_fetch_add(p, v, __ATOMIC_RELAXED, __HIP_MEMORY_SCOPE_AGENT); }
__device__ __forceinline__ unsigned xb_xcc_id() { return (unsigned)__builtin_amdgcn_s_getreg((3 << 11) | 20) & 0xFu; }
#define XB_SPIN(cond, bar) do { unsigned _sp = 0; while (cond) { __builtin_amdgcn_s_sleep(1); \
    if ((++_sp & 255u) == 0u) { if (xb_ld(&(bar)[XB_TMO])) break; if (_sp > XB_SPIN_CAP) { atomicAdd(&(bar)[XB_TMO], 1u); break; } } } } while (0)

struct XcdBarrier {
    unsigned* bar; unsigned x;
    volatile LAS unsigned* st;
};

__device__ __forceinline__ XcdBarrier xcd_barrier_post(unsigned* bar, volatile LAS unsigned* st) {
    XcdBarrier b; b.bar = bar; b.x = xb_xcc_id(); b.st = st;
    if (threadIdx.x == 0) (void)xb_add(&bar[XB_XCNT(b.x)], 1u);
    return b;
}
__device__ __forceinline__ void xcd_barrier_complete(unsigned* bar, unsigned x, unsigned& nloc, unsigned& nx) {
    const unsigned G = gridDim.x * gridDim.y * gridDim.z;
    unsigned sum, cnt, mine, sp = 0u;
    for (;;) {
        sum = 0u; cnt = 0u; mine = 0u;
#pragma unroll
        for (unsigned j = 0; j < 16; ++j) { const unsigned c = xb_ld(&bar[XB_XCNT(j)]); sum += c; cnt += (c > 0u) ? 1u : 0u; mine = (j == x) ? c : mine; }
        if (sum == G) break;
        __builtin_amdgcn_s_sleep(1);
        if ((++sp & 255u) == 0u) { if (xb_ld(&bar[XB_TMO])) break; if (sp > XB_SPIN_CAP) { atomicAdd(&bar[XB_TMO], 1u); break; } }
    }
    nloc = mine > 0u ? mine : 1u; nx = cnt > 0u ? cnt : 1u;
}

__device__ __forceinline__ void xcd_barrier(const XcdBarrier& b) {
    asm volatile("s_waitcnt vmcnt(0)" ::: "memory");
    __syncthreads();
    if (threadIdx.x == 0) {
        unsigned* bar = b.bar;
        __builtin_amdgcn_s_waitcnt(0);
        unsigned nloc = b.st[0], nx = b.st[1];
        if (nloc == 0u) { xcd_barrier_complete(bar, b.x, nloc, nx); b.st[0] = nloc; b.st[1] = nx; }
        const unsigned old = xb_add(&bar[XB_XSUB(b.x)], 1u);
        const unsigned gen = old / nloc;
        if (old + 1u == (gen + 1u) * nloc) {
            __builtin_amdgcn_fence(__ATOMIC_RELEASE, "agent");
            asm volatile("s_waitcnt vmcnt(0)" ::: "memory");
            const unsigned og = xb_add(&bar[XB_TOP], 1u);
            const unsigned tg = og / nx;
            if (og + 1u == (tg + 1u) * nx) xb_add(&bar[XB_TOPGEN], 1u);
            else XB_SPIN(xb_ld(&bar[XB_TOPGEN]) == tg, bar);
            __builtin_amdgcn_fence(__ATOMIC_ACQUIRE, "agent");
            xb_add(&bar[XB_XGEN(b.x)], 1u);
            asm volatile("s_waitcnt vmcnt(0)" ::: "memory");
        } else {
            XB_SPIN(xb_ld(&bar[XB_XGEN(b.x)]) == gen, bar);
            __builtin_amdgcn_fence(__ATOMIC_ACQUIRE, "agent");
            asm volatile("s_waitcnt vmcnt(0)" ::: "memory");
        }
    }
    __syncthreads();
}
constexpr int NWAVES = 8;
constexpr int RING_OFF = 0, RING_BYTES = 131072;
constexpr int LDSCTL_OFF = RING_BYTES, MISC_OFF = LDSCTL_OFF + 320;
constexpr int LDS_BYTES = 147456;

struct Frame {
    LAS unsigned char* lds; volatile LAS unsigned* MISC;
    int tid, lane, wave, G, vcu;
    const float* in[15]; float* out; unsigned char* ws;
};

__device__ __forceinline__ void prep_w_item(const float* W, const float* gain, int K, int Nsrc, bool map, bf16_t* Wt, LAS float* scr, int item, int nblk, int lane) {
    const int kb = item / nblk, nb = item % nblk, k0 = 64 * kb, n0 = 32 * nb;
    const int nn = n0 + (lane & 31); const int e = map ? inmap(nn) : nn;
#pragma unroll 8
    for (int i = 0; i < 32; ++i) { const int kk = 2 * i + (lane >> 5); float v = 0.f;
        if (e >= 0) v = W[(size_t)(k0 + kk) * Nsrc + e] * (gain ? gain[k0 + kk] : 1.f);
        scr[kk * 33 + (lane & 31)] = v; }
    LDS_WAIT(); asm volatile("" ::: "memory");
    const int c = lane & 7;
#pragma unroll
    for (int j = 0; j < 4; ++j) { const int n = (lane >> 3) + 8 * j; const LAS float* s = scr + (8 * c) * 33 + n;
        u32x4 o; o.x = pk2(s[0 * 33], s[1 * 33]); o.y = pk2(s[2 * 33], s[3 * 33]); o.z = pk2(s[4 * 33], s[5 * 33]); o.w = pk2(s[6 * 33], s[7 * 33]);
        *(u32x4*)(Wt + (size_t)(n0 + n) * K + k0 + 8 * c) = o; }
    LDS_WAIT(); asm volatile("" ::: "memory");
}
__device__ __forceinline__ void p0_prep(Frame& F) {
    LAS float* scr = (LAS float*)(F.lds + RING_OFF + F.wave * 16384);
    int tid_ = threadIdx.x; asm volatile("" : "+v"(tid_));
    const int lane = tid_ & 63, gw = F.vcu * NWAVES + __builtin_amdgcn_readfirstlane(tid_ >> 6), NGW = F.G * NWAVES;
    unsigned char* ws = F.ws;
    constexpr int I_IN = (D / 64) * (NINP / 32), I_A = (DC / 64) * (D / 32), I_O = (D / 64) * (D / 32), I_P = (DPLE / 64) * (D / 32);
    constexpr int NITEMS = I_IN + 2 * I_A + 2 * I_O + I_P;
    for (int it = gw; it < NITEMS; it += NGW) {
        int r = it;
        if (r < I_IN) { prep_w_item(F.in[3], F.in[2], D, NIN, true, (bf16_t*)(ws + WS_WIN), scr, r, NINP / 32, lane); continue; } r -= I_IN;
        if (r < I_A) { prep_w_item(F.in[8], nullptr, DC, D, false, (bf16_t*)(ws + WS_WA), scr, r, D / 32, lane); continue; } r -= I_A;
        if (r < I_A) { prep_w_item(F.in[9], nullptr, DC, D, false, (bf16_t*)(ws + WS_WB), scr, r, D / 32, lane); continue; } r -= I_A;
        if (r < I_O) { prep_w_item(F.in[10], nullptr, D, D, false, (bf16_t*)(ws + WS_WO), scr, r, D / 32, lane); continue; } r -= I_O;
        if (r < I_O) { prep_w_item(F.in[12], F.in[11], D, D, false, (bf16_t*)(ws + WS_WG), scr, r, D / 32, lane); continue; } r -= I_O;
        prep_w_item(F.in[13], nullptr, DPLE, D, false, (bf16_t*)(ws + WS_WP), scr, r, D / 32, lane);
    }
    const float* x = F.in[0]; const float* p = F.in[1]; bf16_t* xb = (bf16_t*)(ws + WS_XB); bf16_t* pb = (bf16_t*)(ws + WS_PB); float* rinv = (float*)(ws + WS_RINV);
    for (int m = gw; m < M; m += NGW) {
        const f32x4* xr = (const f32x4*)(x + (size_t)m * D) + lane; f32x4 v[4]; float s = 0.f;
#pragma unroll
        for (int j = 0; j < 4; ++j) { v[j] = xr[64 * j]; s += (v[j].x * v[j].x + v[j].y * v[j].y) + (v[j].z * v[j].z + v[j].w * v[j].w); }
        s = wave_sum(s);
        if (lane == 0) rinv[m] = rsqrtf(s * (1.f / D) + EPS);
        u32x2* o = (u32x2*)(xb + (size_t)m * D) + lane;
#pragma unroll
        for (int j = 0; j < 4; ++j) { u32x2 w; w.x = pk2(v[j].x, v[j].y); w.y = pk2(v[j].z, v[j].w); o[64 * j] = w; }
        const f32x4 pv = ((const f32x4*)(p + (size_t)m * DPLE))[lane];
        u32x2 w; w.x = pk2(pv.x, pv.y); w.y = pk2(pv.z, pv.w); ((u32x2*)(pb + (size_t)m * DPLE))[lane] = w;
    }
}

constexpr int CF_TOK = 128, CF_CH = 16;
__device__ __forceinline__ void p2_conformer(Frame& F) {
    LAS float* red = (LAS float*)(F.lds + RING_OFF);
    const bf16_t* cin = (const bf16_t*)(F.ws + WS_CIN); const bf16_t* cz = (const bf16_t*)(F.ws + WS_CZ); bf16_t* ya = (bf16_t*)(F.ws + WS_YA);
    const float* conv_w = F.in[4];
    int tid_ = threadIdx.x; asm volatile("" : "+v"(tid_));
    const int ch = tid_, lane = tid_ & 63, wv = __builtin_amdgcn_readfirstlane(tid_ >> 6);
    float w[CWID];
#pragma unroll
    for (int j = 0; j < CWID; ++j) w[j] = conv_w[j * DC + ch];
    const float cb = F.in[5][ch], g = F.in[6][ch], bb = F.in[7][ch];
    for (int item = F.vcu; item < M / CF_TOK; item += F.G) {
        const int b = item / (SEQ / CF_TOK), t0 = (item % (SEQ / CF_TOK)) * CF_TOK; const size_t rowb = (size_t)b * SEQ;
        float u[CF_CH + CWID - 1];
#pragma unroll
        for (int i = 0; i < CWID - 1; ++i) { const int t = t0 - (CWID - 1) + i; float v = 0.f;
            if (t >= 0) { const float a = bf2f(cin[(rowb + t) * 1024 + ch]), gt = bf2f(cin[(rowb + t) * 1024 + 512 + ch]); v = a * sigmoidf_(gt); }
            u[i] = v; }
        for (int tc = t0; tc < t0 + CF_TOK; tc += CF_CH) {
#pragma unroll
            for (int i = 0; i < CF_CH; ++i) { const size_t r = (rowb + tc + i) * 1024; const float a = bf2f(cin[r + ch]), gt = bf2f(cin[r + 512 + ch]); u[CWID - 1 + i] = a * sigmoidf_(gt); }
            float c[CF_CH];
#pragma unroll
            for (int i = 0; i < CF_CH; ++i) { float s = cb;
#pragma unroll
                for (int j = 0; j < CWID; ++j) s = fmaf(w[j], u[i + j], s);
                c[i] = s; }
#pragma unroll
            for (int i = 0; i < CF_CH; ++i) { const float s1 = wave_sum(c[i]), s2 = wave_sum(c[i] * c[i]); if (lane == 0) { red[wv * 32 + 2 * i] = s1; red[wv * 32 + 2 * i + 1] = s2; } }
            __syncthreads();
#pragma unroll
            for (int i = 0; i < CF_CH; ++i) { float s1 = 0.f, s2 = 0.f;
#pragma unroll
                for (int q = 0; q < 8; ++q) { s1 += red[q * 32 + 2 * i]; s2 += red[q * 32 + 2 * i + 1]; }
                const float mu = s1 * (1.f / DC), var = fmaxf(s2 * (1.f / DC) - mu * mu, 0.f), rs = rsqrtf(var + EPS);
                const float y = (c[i] - mu) * rs * g + bb; const float z = bf2f(cz[(rowb + tc + i) * DC + ch]);
                ya[(rowb + tc + i) * DC + ch] = f2bf(siluf_(y) * siluf_(z)); }
            __syncthreads();
#pragma unroll
            for (int i = 0; i < CWID - 1; ++i) u[i] = u[i + CF_CH];
        }
    }
}

#ifndef REP_PASS1
#define REP_PASS1 1
#endif
#ifndef REP_SEL
#define REP_SEL 1
#endif
#ifndef REP_PASS2
#define REP_PASS2 1
#endif
__device__ __forceinline__ float max3f_(float a, float b, float c) { float r; asm("v_max3_f32 %0, %1, %2, %3" : "=v"(r) : "v"(a), "v"(b), "v"(c)); return r; }
__device__ __forceinline__ float relu_(float a) { float r; asm("v_max_f32_e32 %0, 0, %1" : "=v"(r) : "v"(a)); return r; }
typedef short bf16x8 __attribute__((ext_vector_type(8)));
typedef float f32x16 __attribute__((ext_vector_type(16)));
__device__ __forceinline__ unsigned skey(float f) { const unsigned u = __float_as_uint(f + 0.f); return (u & 0x80000000u) ? ~u : (u | 0x80000000u); }
__device__ __forceinline__ int half_sum(int v) {
#pragma unroll
    for (int o = 1; o < 32; o <<= 1) v += __shfl_xor(v, o);
    return v;
}
__device__ __forceinline__ void attn_unit(Frame& F, int b, int qb, LAS unsigned char* lds) {
    int tid_ = threadIdx.x; asm volatile("" : "+v"(tid_));
    const int lane = tid_ & 63, w = __builtin_amdgcn_readfirstlane(tid_ >> 6), col = lane & 31, half = lane >> 5;
    const bf16_t* iq = (const bf16_t*)(F.ws + WS_IQ); const bf16_t* sm = (const bf16_t*)(F.ws + WS_SM);
    const size_t rowb = (size_t)b * SEQ; const int t0 = 32 * qb; const size_t m0w = rowb + t0 + 4 * w;
    bf16x8 aq[4];
    { const int r = col, half_r = (r >> 2) & 1, qsel = r >> 4, head = (r & 3) + 4 * ((r >> 3) & 1), ql = 2 * half_r + qsel;
#pragma unroll
      for (int ks = 0; ks < 4; ++ks) aq[ks] = *(const bf16x8*)(iq + (m0w + ql) * 512 + head * 64 + 16 * ks + 8 * half); }
    float wr[16];
    { const u32x4 va = *(const u32x4*)(sm + (m0w + 2 * half) * 256 + 192), vb = *(const u32x4*)(sm + (m0w + 2 * half + 1) * 256 + 192);
      const float wa[8] = {bflo(va.x), bfhi(va.x), bflo(va.y), bfhi(va.y), bflo(va.z), bfhi(va.z), bflo(va.w), bfhi(va.w)};
      const float wb[8] = {bflo(vb.x), bfhi(vb.x), bflo(vb.y), bfhi(vb.y), bflo(vb.z), bfhi(vb.z), bflo(vb.w), bfhi(vb.w)};
      const float sc = 0.125f * 0.35355339059327373f;
#pragma unroll
      for (int i = 0; i < 8; ++i) { wr[i] = wa[(i & 3) + 4 * (i >> 2)] * sc; wr[8 + i] = wb[(i & 3) + 4 * (i >> 2)] * sc; } }
    int offk[4];
#pragma unroll
    for (int ks = 0; ks < 4; ++ks) offk[ks] = col * 128 + ((((2 * ks + half) ^ ((col >> 1) & 7))) << 4);
    const int nch = qb / 8 + 1;
#define AT_STAGE(c, bufsel) do { _Pragma("unroll") for (int i_ = 0; i_ < 4; ++i_) { const int seg = 4 * w + i_, kl = 8 * seg + (lane >> 3), sp = (lane & 7) ^ ((kl >> 1) & 7); \
        __builtin_amdgcn_global_load_lds((const unsigned*)(sm + (rowb + 256 * (c) + kl) * 256 + 128 + 8 * sp), (LAS unsigned*)(lds + (bufsel) * 32768 + seg * 1024), 16, 0, 0); } } while (0)
    unsigned kA[64], kB[64];
    for (int rep1_ = 0; rep1_ < REP_PASS1; ++rep1_) {
    AT_STAGE(0, 0);
    asm volatile("s_waitcnt vmcnt(0)" ::: "memory"); __syncthreads();
#pragma unroll
    for (int c = 0; c < 8; ++c) {
        if (c < nch) {
            if (c + 1 < nch) AT_STAGE(c + 1, (c + 1) & 1);
#pragma unroll
            for (int jj = 0; jj < 8; ++jj) { const int j = 8 * c + jj;
                if (j <= qb) {
                    bf16x8 bk[4];
#pragma unroll
                    for (int ks = 0; ks < 4; ++ks) bk[ks] = *(const LAS bf16x8*)(lds + (c & 1) * 32768 + jj * 4096 + offk[ks]);
                    f32x16 acc = {0.f, 0.f, 0.f, 0.f, 0.f, 0.f, 0.f, 0.f, 0.f, 0.f, 0.f, 0.f, 0.f, 0.f, 0.f, 0.f};
#pragma unroll
                    for (int ks = 0; ks < 4; ++ks) acc = __builtin_amdgcn_mfma_f32_32x32x16_bf16(aq[ks], bk[ks], acc, 0, 0, 0);
                    asm volatile("s_nop 11" : "+v"(acc));
                    float sA = 0.f, sB = 0.f;
#pragma unroll
                    for (int i = 0; i < 8; ++i) { sA = fmaf(wr[i], relu_(acc[i]), sA); sB = fmaf(wr[8 + i], relu_(acc[8 + i]), sB); }
                    bool vA = true, vB = true;
                    if (j == qb) { vA = col <= 4 * w + 2 * half; vB = col <= 4 * w + 2 * half + 1; }
                    kA[j] = vA ? skey(sA) : 0u; kB[j] = vB ? skey(sB) : 0u;
                } else { kA[j] = 0u; kB[j] = 0u; }
            }
            asm volatile("s_waitcnt vmcnt(0)" ::: "memory"); __syncthreads();
        } else {
#pragma unroll
            for (int jj = 0; jj < 8; ++jj) { kA[8 * c + jj] = 0u; kB[8 * c + jj] = 0u; }
        }
    }
    }
#undef AT_STAGE
    const int nA = t0 + 4 * w + 2 * half + 1, nB = nA + 1;
    unsigned prefA = 0u, prefB = 0u, thrA = 1u, thrB = 1u; bool exA = nA <= TOPK, exB = nB <= TOPK;
    for (int reps_ = 0; reps_ < REP_SEL; ++reps_) {
    prefA = 0u; prefB = 0u; thrA = 1u; thrB = 1u; exA = nA <= TOPK; exB = nB <= TOPK; asm volatile("" : "+v"(prefA), "+v"(prefB));
    for (int bit = 31; bit >= 0; --bit) {
        if (__all(exA && exB)) break;
        const unsigned candA = prefA | (1u << bit), candB = prefB | (1u << bit);
        int cA = 0, cB = 0;
#pragma unroll
        for (int g = 0; g < 8; ++g) if (g < nch) {
#pragma unroll
            for (int jj = 0; jj < 8; ++jj) { cA += (kA[8 * g + jj] >= candA) ? 1 : 0; cB += (kB[8 * g + jj] >= candB) ? 1 : 0; } }
        cA = half_sum(cA); cB = half_sum(cB);
        if (!exA) { if (cA == TOPK) { thrA = candA; exA = true; } else if (cA > TOPK) prefA = candA; }
        if (!exB) { if (cB == TOPK) { thrB = candB; exB = true; } else if (cB > TOPK) prefB = candB; }
    }
    }
    const unsigned tA = exA ? thrA : prefA + 1u, tB = exB ? thrB : prefB + 1u;
    unsigned mA[2] = {0u, 0u}, mB[2] = {0u, 0u};
#pragma unroll
    for (int j = 0; j < 64; ++j) { mA[j >> 5] |= (kA[j] >= tA) ? (1u << (j & 31)) : 0u; mB[j >> 5] |= (kB[j] >= tB) ? (1u << (j & 31)) : 0u; }
    if (!__all(exA && exB)) {
        const int needA = TOPK - half_sum(__popc(mA[0]) + __popc(mA[1])), needB = TOPK - half_sum(__popc(mB[0]) + __popc(mB[1]));
        int befA = 0, befB = 0; const unsigned below = (1u << col) - 1u;
#pragma unroll
        for (int j = 0; j < 64; ++j) {
            const bool eA = !exA && kA[j] == prefA, eB = !exB && kB[j] == prefB;
            const unsigned long long balA = __ballot(eA), balB = __ballot(eB);
            const unsigned hA = half ? (unsigned)(balA >> 32) : (unsigned)balA, hB = half ? (unsigned)(balB >> 32) : (unsigned)balB;
            if (eA && befA + __popc(hA & below) < needA) mA[j >> 5] |= 1u << (j & 31);
            if (eB && befB + __popc(hB & below) < needB) mB[j >> 5] |= 1u << (j & 31);
            befA += __popc(hA); befB += __popc(hB);
        }
    }
    const bf16_t* qbuf = (const bf16_t*)(F.ws + WS_Q); const bf16_t* vt = (const bf16_t*)(F.ws + WS_VT); const bf16_t* az = (const bf16_t*)(F.ws + WS_AZ); bf16_t* yb = (bf16_t*)(F.ws + WS_YB);
    typedef unsigned long long u64;
    u64 mq[4];
    { const unsigned oa0 = __shfl_xor(mA[0], 32), oa1 = __shfl_xor(mA[1], 32), ob0 = __shfl_xor(mB[0], 32), ob1 = __shfl_xor(mB[1], 32);
      const u64 ownA = ((u64)mA[1] << 32) | mA[0], ownB = ((u64)mB[1] << 32) | mB[0], othA = ((u64)oa1 << 32) | oa0, othB = ((u64)ob1 << 32) | ob0;
      mq[0] = half ? othA : ownA; mq[1] = half ? othB : ownB; mq[2] = half ? ownA : othA; mq[3] = half ? ownB : othB; }
    const int qlc = col >> 3, hd = col & 7;
    bf16x8 bq[4];
#pragma unroll
    for (int ks = 0; ks < 4; ++ks) bq[ks] = *(const bf16x8*)(qbuf + (m0w + qlc) * 512 + hd * 64 + 16 * ks + 8 * half);
    const float cslope = exp2f(-(float)(hd + 1)) * 1.4426950408889634f;
    const unsigned c_hi = f2bf(cslope), c_lo = f2bf(cslope - bf2f((bf16_t)c_hi));
    float mref = cslope * (float)(t0 + 4 * w + qlc);
    u32x4 bau;
#define AT_MPIECES(mval) do { const float v_ = -(mval); const unsigned uh_ = __float_as_uint(v_) & 0xffff0000u; const float r_ = v_ - __uint_as_float(uh_); \
        const unsigned um_ = __float_as_uint(r_) & 0xffff0000u; const float r2_ = r_ - __uint_as_float(um_); bau.z = half ? ((uh_ >> 16) | um_) : 0u; bau.w = half ? (unsigned)f2bf(r2_) : 0u; } while (0)
    if (half) { bau.x = (unsigned)f2bf(16.f * bf2f((bf16_t)c_hi)) | ((unsigned)f2bf(16.f * bf2f((bf16_t)c_lo)) << 16); bau.y = c_hi | (c_lo << 16); }
    else { bau.x = (qlc == 0 ? 0x3f80u : 0u) | (qlc == 1 ? 0x3f800000u : 0u); bau.y = (qlc == 2 ? 0x3f80u : 0u) | (qlc == 3 ? 0x3f800000u : 0u); }
    AT_MPIECES(mref);
    const unsigned slo_b = __float_as_uint((float)(col & 15)) >> 16, slo2 = slo_b | (slo_b << 16);
    int offv[2][2];
#pragma unroll
    for (int dt = 0; dt < 2; ++dt)
#pragma unroll
        for (int s2 = 0; s2 < 2; ++s2) offv[dt][s2] = (32 * dt + col) * 64 + ((((2 * s2 + half) ^ ((col >> 2) & 3))) << 4);
    f32x16 oacc[2]; float lsum; bool anch;
    const f32x16 zero16 = {0.f, 0.f, 0.f, 0.f, 0.f, 0.f, 0.f, 0.f, 0.f, 0.f, 0.f, 0.f, 0.f, 0.f, 0.f, 0.f};
#define AT_STAGE2(c, bufsel) do { _Pragma("unroll") for (int i_ = 0; i_ < 4; ++i_) { const int seg = 4 * w + i_, kl = 8 * seg + (lane >> 3), sp = (lane & 7) ^ ((kl >> 1) & 7); \
        __builtin_amdgcn_global_load_lds((const unsigned*)(sm + (rowb + 256 * (c) + kl) * 256 + 8 * sp), (LAS unsigned*)(lds + (bufsel) * 32768 + seg * 1024), 16, 0, 0); \
        const int dd_ = 16 * (seg & 3) + (lane >> 2), vp_ = (lane & 3) ^ ((dd_ >> 2) & 3); \
        __builtin_amdgcn_global_load_lds((const unsigned*)(vt + ((size_t)b * 64 + dd_) * SEQ + 256 * (c) + 32 * (seg >> 2) + 8 * vp_), (LAS unsigned*)(lds + 65536 + (bufsel) * 32768 + seg * 1024), 16, 0, 0); } } while (0)
    for (int rep2_ = 0; rep2_ < REP_PASS2; ++rep2_) {
#pragma unroll
    for (int dt = 0; dt < 2; ++dt)
#pragma unroll
        for (int i = 0; i < 16; ++i) oacc[dt][i] = 0.f;
    lsum = 0.f; anch = false; mref = cslope * (float)(t0 + 4 * w + qlc); AT_MPIECES(mref);
    __syncthreads();
    AT_STAGE2(nch - 1, (nch - 1) & 1);
    asm volatile("s_waitcnt vmcnt(0)" ::: "memory"); __syncthreads();
    for (int c = nch - 1; c >= 0; --c) {
        if (c > 0) AT_STAGE2(c - 1, (c - 1) & 1);
        const LAS unsigned char* kimg = lds + (c & 1) * 32768; const LAS unsigned char* vimg = lds + 65536 + (c & 1) * 32768;
        for (int jj = 7; jj >= 0; --jj) { const int j = 8 * c + jj;
            if (j > qb) continue;
            bf16x8 ak[4];
#pragma unroll
            for (int ks = 0; ks < 4; ++ks) ak[ks] = *(const LAS bf16x8*)(kimg + jj * 4096 + offk[ks]);
            u32x4 aau;
            { const unsigned p0 = (unsigned)(~(mq[0] >> j) & 1ull) * 0xc700u, p1 = (unsigned)(~(mq[1] >> j) & 1ull) * 0xc700u, p2 = (unsigned)(~(mq[2] >> j) & 1ull) * 0xc700u, p3 = (unsigned)(~(mq[3] >> j) & 1ull) * 0xc700u;
              const unsigned shi_b = __float_as_uint((float)(2 * j + (col >> 4))) >> 16;
              aau.x = half ? (shi_b | (shi_b << 16)) : (p0 | (p1 << 16)); aau.y = half ? slo2 : (p2 | (p3 << 16)); aau.z = half ? 0x3f803f80u : 0u; aau.w = half ? 0x00003f80u : 0u; }
            f32x16 x = __builtin_amdgcn_mfma_f32_32x32x16_bf16(ak[0], bq[0], zero16, 0, 0, 0);
#pragma unroll
            for (int ks = 1; ks < 4; ++ks) x = __builtin_amdgcn_mfma_f32_32x32x16_bf16(ak[ks], bq[ks], x, 0, 0, 0);
            x = __builtin_amdgcn_mfma_f32_32x32x16_bf16(__builtin_bit_cast(bf16x8, aau), __builtin_bit_cast(bf16x8, bau), x, 0, 0, 0);
            asm volatile("s_nop 11" : "+v"(x));
            float lmax = max3f_(x[0], x[1], x[2]), lmx2 = max3f_(x[3], x[4], x[5]);
            lmax = max3f_(lmax, x[6], x[7]); lmx2 = max3f_(lmx2, x[8], x[9]); lmax = max3f_(lmax, x[10], x[11]); lmx2 = max3f_(lmx2, x[12], x[13]); lmax = max3f_(lmax, x[14], x[15]); lmax = max3f_(lmax, lmx2, lmx2);
            lmax = fmaxf(lmax, __shfl_xor(lmax, 32));
            const bool need = anch ? (lmax > 8.f) : (lmax > -30000.f);
            if (__any(need)) {
                const float dl = need ? lmax : 0.f, f = (need && anch) ? __builtin_amdgcn_exp2f(-dl) : 1.f;
                mref += dl; lsum *= f; anch = anch || need;
#pragma unroll
                for (int i = 0; i < 16; ++i) { x[i] -= dl; oacc[0][i] *= f; oacc[1][i] *= f; }
                AT_MPIECES(mref);
            }
            unsigned pw[8];
#pragma unroll
            for (int i = 0; i < 16; i += 2) { const float e0 = __builtin_amdgcn_exp2f(x[i]), e1 = __builtin_amdgcn_exp2f(x[i + 1]); lsum += e0 + e1; pw[i >> 1] = pk2(e0, e1); }
            const u32x4 pf0 = {pw[0], pw[1], pw[2], pw[3]}, pf1 = {pw[4], pw[5], pw[6], pw[7]};
#pragma unroll
            for (int dt = 0; dt < 2; ++dt) {
                const bf16x8 av0 = *(const LAS bf16x8*)(vimg + jj * 4096 + offv[dt][0]), av1 = *(const LAS bf16x8*)(vimg + jj * 4096 + offv[dt][1]);
                oacc[dt] = __builtin_amdgcn_mfma_f32_32x32x16_bf16(av0, __builtin_bit_cast(bf16x8, pf0), oacc[dt], 0, 0, 0);
                oacc[dt] = __builtin_amdgcn_mfma_f32_32x32x16_bf16(av1, __builtin_bit_cast(bf16x8, pf1), oacc[dt], 0, 0, 0); }
        }
        asm volatile("s_waitcnt vmcnt(0)" ::: "memory"); __syncthreads();
    }
    }
#undef AT_STAGE2
#undef AT_MPIECES
    { const float inv = __builtin_amdgcn_rcpf(lsum + __shfl_xor(lsum, 32)); const size_t mrow = (m0w + qlc) * 512 + hd * 64;
#pragma unroll
      for (int dt = 0; dt < 2; ++dt)
#pragma unroll
          for (int g4 = 0; g4 < 4; ++g4) { const int d0 = 32 * dt + 8 * g4 + 4 * half; const u32x2 zz = *(const u32x2*)(az + mrow + d0);
              const float y0 = oacc[dt][4 * g4 + 0] * inv * siluf_(bflo(zz.x)), y1 = oacc[dt][4 * g4 + 1] * inv * siluf_(bfhi(zz.x)), y2 = oacc[dt][4 * g4 + 2] * inv * siluf_(bflo(zz.y)), y3 = oacc[dt][4 * g4 + 3] * inv * siluf_(bfhi(zz.y));
              u32x2 o; o.x = pk2(y0, y1); o.y = pk2(y2, y3); *(u32x2*)(yb + mrow + d0) = o; } }
}
__device__ __forceinline__ void p2_attn(Frame& F) {
    const int b = F.vcu >> 4, r = F.vcu & 15;
    for (int i = 0; i < 4; ++i) { const int qb = (i == 0) ? r : (i == 1) ? 31 - r : (i == 2) ? 32 + r : 63 - r;
        attn_unit(F, b, qb, F.lds + RING_OFF);
    }
}

__device__ __forceinline__ void p6_final(Frame& F) {
    float* out = F.out; const float* ssp2 = (const float*)(F.ws + WS_SSP2); const float* fg = F.in[14];
    int tid_ = threadIdx.x; asm volatile("" : "+v"(tid_));
    const int lane = tid_ & 63, gw = F.vcu * NWAVES + __builtin_amdgcn_readfirstlane(tid_ >> 6), NGW = F.G * NWAVES;
    for (int m = gw; m < M; m += NGW) { float s = (lane < 16) ? ssp2[(size_t)m * 16 + lane] : 0.f; s = wave_sum(s);
        const float r = rsqrtf(s * (1.f / D) + EPS); f32x4* o = (f32x4*)(out + (size_t)m * D) + lane;
#pragma unroll
        for (int j = 0; j < 4; ++j) { const f32x4 gv = ((const f32x4*)fg)[lane + 64 * j]; f32x4 v = o[64 * j]; v = v * r * gv; o[64 * j] = v; } }
}

#ifndef REP_P0
#define REP_P0 1
#endif
#ifndef REP_P1
#define REP_P1 1
#endif
#ifndef REP_P2A
#define REP_P2A 1
#endif
#ifndef REP_P2B
#define REP_P2B 1
#endif
#ifndef REP_P4
#define REP_P4 1
#endif
struct Args { const float* in[15]; float* out; unsigned char* ws; };
__global__ void __launch_bounds__(NWAVES * 64, 2) fwd_kernel(Args args) {
    extern __shared__ __attribute__((aligned(16))) unsigned char lds_raw[];
    Frame F;
    F.lds = (LAS unsigned char*)lds_raw; F.MISC = (volatile LAS unsigned*)(F.lds + MISC_OFF);
    F.tid = threadIdx.x; F.lane = F.tid & 63; F.wave = __builtin_amdgcn_readfirstlane(F.tid >> 6);
    F.G = gridDim.x; { const int bx = blockIdx.x; F.vcu = (F.G % 8 == 0) ? (bx % 8) * (F.G / 8) + bx / 8 : bx; }
#pragma unroll
    for (int i = 0; i < 15; ++i) F.in[i] = args.in[i];
    F.out = args.out; F.ws = args.ws;
    unsigned char* ws = args.ws;
    for (int u = F.tid; u < (LDS_BYTES - LDSCTL_OFF) / 4; u += NWAVES * 64) ((LAS unsigned*)(F.lds + LDSCTL_OFF))[u] = 0u;
    __syncthreads();
    XcdBarrier bar = xcd_barrier_post((unsigned*)(ws + WS_CTL) + CW_BAR, F.MISC + 8);

    for (int rep_ = 0; rep_ < REP_P0; ++rep_) { p0_prep(F); if (rep_ + 1 < REP_P0) __syncthreads(); }
    xcd_barrier(bar);
    { pg8::Gemm g{(const bf16_t*)(ws + WS_XB), (const bf16_t*)(ws + WS_WIN), M, NINP, D}; pg8::StaticOrder S; S.init(M, NINP, F.G, (int)blockIdx.x);
      pg8::EpiInProj E{(const float*)(ws + WS_RINV), ws};
      for (int rep_ = 0; rep_ < REP_P1; ++rep_) pg8::gemm_phase<pg8::EpiInProj, pg8::StaticOrder, true, true>(F.lds + RING_OFF, g, S, E);
    }
    xcd_barrier(bar);
    for (int rep_ = 0; rep_ < REP_P2A; ++rep_) p2_conformer(F);
    for (int rep_ = 0; rep_ < REP_P2B; ++rep_) p2_attn(F);
    xcd_barrier(bar);
    { pg8::Gemm g{(const bf16_t*)(ws + WS_YA), (const bf16_t*)(ws + WS_WA), M, D, DC}; pg8::StaticOrder S; S.init(M, D, F.G, (int)blockIdx.x);
      pg8::EpiOutA E{(const bf16_t*)(ws + WS_GA), F.out};
      pg8::gemm_phase<pg8::EpiOutA, pg8::StaticOrder, true, true>(F.lds + RING_OFF, g, S, E);
    }
    { pg8::Gemm g{(const bf16_t*)(ws + WS_YB), (const bf16_t*)(ws + WS_WB), M, D, DC}; pg8::StaticOrder S; S.init(M, D, F.G, (int)blockIdx.x);
      pg8::EpiOutB E{(const bf16_t*)(ws + WS_GB), F.out, (bf16_t*)(ws + WS_MRG)};
      pg8::gemm_phase<pg8::EpiOutB, pg8::StaticOrder, true, true>(F.lds + RING_OFF, g, S, E);
    }
    xcd_barrier(bar);
    { pg8::Gemm g{(const bf16_t*)(ws + WS_MRG), (const bf16_t*)(ws + WS_WO), M, D, D}; pg8::StaticOrder S; S.init(M, D, F.G, (int)blockIdx.x);
      pg8::EpiWo E{F.in[0], F.out, (bf16_t*)(ws + WS_X1B), (float*)(ws + WS_SSP1)};
      for (int rep_ = 0; rep_ < REP_P4; ++rep_) pg8::gemm_phase<pg8::EpiWo, pg8::StaticOrder, true, true>(F.lds + RING_OFF, g, S, E);
    }
    xcd_barrier(bar);
    { pg8::Gemm g{(const bf16_t*)(ws + WS_PB), (const bf16_t*)(ws + WS_WP), M, D, DPLE}; pg8::StaticOrder S; S.init(M, D, F.G, (int)blockIdx.x);
      pg8::EpiPP E{(bf16_t*)(ws + WS_PP)};
      pg8::gemm_phase<pg8::EpiPP, pg8::StaticOrder, true, true>(F.lds + RING_OFF, g, S, E);
    }
    __builtin_amdgcn_sched_barrier(0); asm volatile("" ::: "memory");
    { pg8::Gemm g{(const bf16_t*)(ws + WS_X1B), (const bf16_t*)(ws + WS_WG), M, D, D}; pg8::StaticOrder S; S.init(M, D, F.G, (int)blockIdx.x);
      pg8::EpiGate E{F.out, (const bf16_t*)(ws + WS_PP), (const float*)(ws + WS_SSP1), (float*)(ws + WS_SSP2)};
      pg8::gemm_phase<pg8::EpiGate, pg8::StaticOrder, true, true>(F.lds + RING_OFF, g, S, E);
    }
    xcd_barrier(bar);
    p6_final(F);
}

extern "C" void kernel_launch(void* const* d_in, const int* in_sizes, int n_in, void* d_out, int out_size, void* d_ws, size_t ws_size, hipStream_t stream) {
    static int grid = 0;
    if (grid == 0) {
        if (n_in != 15 || out_size != M * D || ws_size < WS_END) { fprintf(stderr, "kernel_launch: unexpected sizes n_in %d out %d ws %zu\n", n_in, out_size, ws_size); grid = -1; return; }
        int dev = 0, cus = 0, per_cu = 0;
        if (hipGetDevice(&dev) != hipSuccess || hipDeviceGetAttribute(&cus, hipDeviceAttributeMultiprocessorCount, dev) != hipSuccess) { grid = -1; return; }
        if (hipFuncSetAttribute((const void*)fwd_kernel, hipFuncAttributeMaxDynamicSharedMemorySize, LDS_BYTES) != hipSuccess) { fprintf(stderr, "kernel_launch: hipFuncSetAttribute failed\n"); grid = -1; return; }
        if (hipOccupancyMaxActiveBlocksPerMultiprocessor(&per_cu, (const void*)fwd_kernel, NWAVES * 64, LDS_BYTES) != hipSuccess || per_cu < 1) { fprintf(stderr, "kernel_launch: occupancy query reports %d blocks per CU\n", per_cu); (void)hipGetLastError(); grid = -1; return; }
        grid = cus;
        if (M % grid != 0 || grid % 8 != 0) { fprintf(stderr, "kernel_launch: unsupported CU count %d\n", grid); grid = -1; return; }
    }
    if (grid < 0) return;
    (void)hipMemsetAsync((char*)d_ws + WS_CTL, 0, CTL_ZERO_BYTES, stream);
    Args a{};
    for (int i = 0; i < 15; ++i) a.in[i] = (const float*)d_in[i];
    a.out = (float*)d_out; a.ws = (unsigned char*)d_ws;
    hipLaunchKernelGGL(fwd_kernel, dim3(grid), dim3(NWAVES * 64), LDS_BYTES, stream, a);
}
```

```cpp
#include <hip/hip_runtime.h>
#include <cstdint>
#include <cstdio>

typedef unsigned short bf16_t;
typedef float f32x4 __attribute__((ext_vector_type(4)));
typedef unsigned u32x4 __attribute__((ext_vector_type(4)));
typedef unsigned u32x2 __attribute__((ext_vector_type(2)));
#define GAS __attribute__((address_space(1)))
#define LAS __attribute__((address_space(3)))
#define LDS_WAIT() asm volatile("s_waitcnt lgkmcnt(0)" ::: "memory")
#define VM_WAIT() asm volatile("s_waitcnt vmcnt(0)" ::: "memory")

constexpr int NB = 16, SEQ = 2048, D = 1024, M = NB * SEQ;
constexpr int DPLE = 256, DC = 512, CWID = 31, NH = 8, HD = 64, TOPK = 256;
constexpr int NIN = 5320, NINP = 5376;
constexpr float EPS = 1e-6f;

constexpr size_t MiB = 1u << 20;
constexpr size_t WS_CTL = 0;
constexpr size_t CTL_ZERO_BYTES = 64 * 1024;
constexpr int CW_BAR = 4096;
constexpr size_t WS_WIN = 2 * MiB;
constexpr size_t WS_WA = 13 * MiB;
constexpr size_t WS_WB = 14 * MiB;
constexpr size_t WS_WO = 15 * MiB;
constexpr size_t WS_WG = 17 * MiB;
constexpr size_t WS_WP = 19 * MiB;
constexpr size_t WS_RINV = 20 * MiB;
constexpr size_t WS_SSP1 = 22 * MiB;
constexpr size_t WS_SSP2 = 24 * MiB;
constexpr size_t WS_VT = 26 * MiB;
constexpr size_t WS_XB = 32 * MiB;
constexpr size_t WS_YA = 32 * MiB, WS_YB = 64 * MiB;
constexpr size_t WS_PB = 96 * MiB;
constexpr size_t WS_CIN = 112 * MiB;
constexpr size_t WS_MRG = 112 * MiB;
constexpr size_t WS_CZ = 176 * MiB;
constexpr size_t WS_Q = 208 * MiB;
constexpr size_t WS_X1B = 176 * MiB;
constexpr size_t WS_AZ = 240 * MiB;
constexpr size_t WS_IQ = 272 * MiB;
constexpr size_t WS_SM = 304 * MiB;
constexpr size_t WS_GA = 320 * MiB;
constexpr size_t WS_PP = 320 * MiB;
constexpr size_t WS_GB = 384 * MiB;
constexpr size_t WS_END = 448 * MiB;

__device__ __forceinline__ float bf2f(bf16_t h) { return __uint_as_float(((unsigned)h) << 16); }
typedef float f32x2_t __attribute__((ext_vector_type(2))); typedef __bf16 bf16x2_t __attribute__((ext_vector_type(2)));
__device__ __forceinline__ unsigned pk2(float lo, float hi) { const f32x2_t v = {lo, hi}; const bf16x2_t b = __builtin_convertvector(v, bf16x2_t); return __builtin_bit_cast(unsigned, b); }
__device__ __forceinline__ bf16_t f2bf(float f) { return (bf16_t)(pk2(f, 0.f) & 0xffffu); }
__device__ __forceinline__ float bflo(unsigned w) { return __uint_as_float(w << 16); }
__device__ __forceinline__ float bfhi(unsigned w) { return __uint_as_float(w & 0xffff0000u); }
__device__ __forceinline__ float sigmoidf_(float x) { return __builtin_amdgcn_rcpf(1.f + __builtin_amdgcn_exp2f(-1.4426950408889634f * x)); }
__device__ __forceinline__ float siluf_(float x) { return x * sigmoidf_(x); }
__device__ __forceinline__ float wave_sum(float v) {
#pragma unroll
    for (int o = 1; o < 64; o <<= 1) v += __shfl_xor(v, o);
    return v;
}

__host__ __device__ __forceinline__ int inmap(int n) {
    if (n < 2048) return n;
    if (n < 2560) return 2176 + (n - 2048);
    if (n < 3072) return 2688 + (n - 2560);
    if (n < 3328) { const int j = n - 3072;
        if (j < 64) return 2048 + j; if (j < 128) return 2112 + (j - 64); if (j < 192) return 3200 + (j - 128); if (j < 200) return 3264 + (j - 192); return -1; }
    if (n < 4352) return 3272 + (n - 3328);
    return 4296 + (n - 4352);
}
namespace pg8 {
#define PG8_LAS __attribute__((address_space(3)))
typedef unsigned short bf16_t;
typedef short bf16x8 __attribute__((ext_vector_type(8)));
typedef float f32x4 __attribute__((ext_vector_type(4)));
typedef unsigned u32x4 __attribute__((ext_vector_type(4)));
constexpr int BM = 256, BK = 64, HALF = 128, HTB = HALF * BK * 2  , STAGE_BYTES = 8 * HTB, NXCD = 8, WGM = 8;

__host__ __device__ __forceinline__ int lds_byte(int r, int c) { const int st = (r >> 4) * 2 + (c >> 5), rr = r & 15, cc = c & 31, ob = rr * 64 + cc * 2; return st * 1024 + (ob ^ (((ob >> 9) & 1) << 5)); }
__host__ __device__ __forceinline__ void stage_rc(int b, int& R, int& C) { const int st = b / 1024, sb = b % 1024, swz = sb ^ (((sb >> 9) & 1) << 5); R = (st >> 1) * 16 + swz / 64; C = (st & 1) * 32 + (swz % 64) / 2; }
__host__ __device__ __forceinline__ int perm32(int rho) { const int n = rho >> 4, i = rho & 15; return 8 * (i >> 2) + 4 * n + (i & 3); }

struct Unit { int pm, pn; };
struct Gemm { const bf16_t* A; const bf16_t* Bt; int M, N, K; };

struct StaticOrder {
    int nM, nN, nwg, G, c;
    __host__ __device__ void init(int M, int N, int G_, int c_) { nM = M / BM; nN = N / BM; nwg = nM * nN; G = G_; c = c_; }
    __host__ __device__ bool next(int i, Unit& u) const {
        const long L = (long)i * G + c; if (L >= nwg) return false;
        int wgid = (int)L; { const int q = nwg / NXCD, r = nwg % NXCD, xcd = wgid % NXCD, off = wgid / NXCD; wgid = (xcd < r ? xcd * (q + 1) : r * (q + 1) + (xcd - r) * q) + off; }
        const int nig = WGM * nN, gid = wgid / nig, fm = gid * WGM, gsz = (nM - fm) < WGM ? (nM - fm) : WGM;
        u.pm = fm + ((wgid % nig) % gsz); u.pn = (wgid % nig) / gsz; return true;
    }
    __device__ __forceinline__ void a_ready(const Unit&) const {}
    __device__ __forceinline__ void done(const Unit&) const {}
};
__device__ __forceinline__ unsigned cvt_pk_bf16(float lo, float hi) { unsigned r; asm volatile("v_cvt_pk_bf16_f32 %0, %1, %2" : "=v"(r) : "v"(lo), "v"(hi)); return r; }
struct EpiInProj {
    static constexpr bool PERM = true, AFTER_DRAIN = false;
    const float* rinv; unsigned char* ws;
    __device__ __forceinline__ void operator()(const f32x4 (&acc)[2][2][4][2], const Unit& u, int wr, int wc, int fr, int fq) const {
        size_t off; int ld, colt; const int pn = u.pn;
        if (pn < 4) { off = WS_CIN; ld = 1024; colt = pn * 256; }
        else if (pn < 6) { off = WS_CZ; ld = 512; colt = (pn - 4) * 256; }
        else if (pn < 8) { off = WS_Q; ld = 512; colt = (pn - 6) * 256; }
        else if (pn < 10) { off = WS_AZ; ld = 512; colt = (pn - 8) * 256; }
        else if (pn < 12) { off = WS_IQ; ld = 512; colt = (pn - 10) * 256; }
        else if (pn < 13) { off = WS_SM; ld = 256; colt = 0; }
        else if (pn < 17) { off = WS_GA; ld = 1024; colt = (pn - 13) * 256; }
        else { off = WS_GB; ld = 1024; colt = (pn - 17) * 256; }
        bf16_t* base = (bf16_t*)(ws + off);
        const float qs = (pn == 6 || pn == 7) ? 0.125f * 1.4426950408889634f : 1.f;
        const int row0 = u.pm * BM + wr * 64 + fr, col0 = colt + wc * 32 + 8 * fq;
#pragma unroll
        for (int ai = 0; ai < 2; ++ai)
#pragma unroll
            for (int m = 0; m < 4; ++m) { const int row = row0 + ai * HALF + m * 16; const float r = rinv[row] * qs; bf16_t* rowp = base + (size_t)row * ld + col0;
#pragma unroll
                for (int bj = 0; bj < 2; ++bj) { const f32x4 v0 = acc[ai][bj][m][0] * r, v1 = acc[ai][bj][m][1] * r;
                    u32x4 w; w.x = cvt_pk_bf16(v0[0], v0[1]); w.y = cvt_pk_bf16(v0[2], v0[3]); w.z = cvt_pk_bf16(v1[0], v1[1]); w.w = cvt_pk_bf16(v1[2], v1[3]);
                    *(u32x4*)(rowp + bj * HALF) = w; } }
        if (pn == 12 && wc >= 2) {
            bf16_t* vt = (bf16_t*)(ws + WS_VT); const int d0 = (wc - 2) * 32 + 8 * fq;
#pragma unroll
            for (int ai = 0; ai < 2; ++ai)
#pragma unroll
                for (int m = 0; m < 4; ++m) { const int row = row0 + ai * HALF + m * 16; const float r = rinv[row]; const int bb = row >> 11, sq = row & 2047, k5 = sq & 31;
                    const int pos = (sq & ~31) + ((k5 & 0x13) | ((k5 & 4) << 1) | ((k5 & 8) >> 1)); bf16_t* vp = vt + ((size_t)bb * 64 + d0) * 2048 + pos;
                    const f32x4 v0 = acc[ai][0][m][0] * r, v1 = acc[ai][0][m][1] * r;
#pragma unroll
                    for (int e = 0; e < 4; ++e) { vp[(size_t)e * 2048] = f2bf(v0[e]); vp[(size_t)(4 + e) * 2048] = f2bf(v1[e]); } }
        }
    }
};
__device__ __forceinline__ f32x4 sig4lo(unsigned a, unsigned b) { return (f32x4){sigmoidf_(bflo(a)), sigmoidf_(bfhi(a)), sigmoidf_(bflo(b)), sigmoidf_(bfhi(b))}; }
struct EpiOutA {
    static constexpr bool PERM = true, AFTER_DRAIN = false;
    const bf16_t* ga; float* part;
    __device__ __forceinline__ void operator()(const f32x4 (&acc)[2][2][4][2], const Unit& u, int wr, int wc, int fr, int fq) const {
        const int row0 = u.pm * BM + wr * 64 + fr, col0 = u.pn * BM + wc * 32 + 8 * fq;
#pragma unroll
        for (int ai = 0; ai < 2; ++ai)
#pragma unroll
            for (int m = 0; m < 4; ++m) { const size_t idx = (size_t)(row0 + ai * HALF + m * 16) * D + col0;
#pragma unroll
                for (int bj = 0; bj < 2; ++bj) { const u32x4 g = *(const u32x4*)(ga + idx + bj * HALF);
                    *(f32x4*)(part + idx + bj * HALF) = sig4lo(g.x, g.y) * acc[ai][bj][m][0]; *(f32x4*)(part + idx + bj * HALF + 4) = sig4lo(g.z, g.w) * acc[ai][bj][m][1]; } }
    }
};
struct EpiOutB {
    static constexpr bool PERM = true, AFTER_DRAIN = false;
    const bf16_t* gb; const float* part; bf16_t* mrg;
    __device__ __forceinline__ void operator()(const f32x4 (&acc)[2][2][4][2], const Unit& u, int wr, int wc, int fr, int fq) const {
        const int row0 = u.pm * BM + wr * 64 + fr, col0 = u.pn * BM + wc * 32 + 8 * fq;
#pragma unroll
        for (int ai = 0; ai < 2; ++ai)
#pragma unroll
            for (int m = 0; m < 4; ++m) { const size_t idx = (size_t)(row0 + ai * HALF + m * 16) * D + col0;
#pragma unroll
                for (int bj = 0; bj < 2; ++bj) { const u32x4 g = *(const u32x4*)(gb + idx + bj * HALF);
                    const f32x4 v0 = *(const f32x4*)(part + idx + bj * HALF) + sig4lo(g.x, g.y) * acc[ai][bj][m][0], v1 = *(const f32x4*)(part + idx + bj * HALF + 4) + sig4lo(g.z, g.w) * acc[ai][bj][m][1];
                    u32x4 w; w.x = cvt_pk_bf16(v0[0], v0[1]); w.y = cvt_pk_bf16(v0[2], v0[3]); w.z = cvt_pk_bf16(v1[0], v1[1]); w.w = cvt_pk_bf16(v1[2], v1[3]);
                    *(u32x4*)(mrg + idx + bj * HALF) = w; } }
    }
};
__device__ __forceinline__ float sq4(const f32x4 v) { return (v[0] * v[0] + v[1] * v[1]) + (v[2] * v[2] + v[3] * v[3]); }
struct EpiWo {
    static constexpr bool PERM = true, AFTER_DRAIN = false;
    const float* x; float* out; bf16_t* x1b; float* ssp;
    __device__ __forceinline__ void operator()(const f32x4 (&acc)[2][2][4][2], const Unit& u, int wr, int wc, int fr, int fq) const {
        const int row0 = u.pm * BM + wr * 64 + fr, col0 = u.pn * BM + wc * 32 + 8 * fq;
#pragma unroll
        for (int ai = 0; ai < 2; ++ai)
#pragma unroll
            for (int m = 0; m < 4; ++m) { const int row = row0 + ai * HALF + m * 16; const size_t idx = (size_t)row * D + col0; float s = 0.f;
#pragma unroll
                for (int bj = 0; bj < 2; ++bj) { const f32x4 v0 = *(const f32x4*)(x + idx + bj * HALF) + acc[ai][bj][m][0], v1 = *(const f32x4*)(x + idx + bj * HALF + 4) + acc[ai][bj][m][1];
                    *(f32x4*)(out + idx + bj * HALF) = v0; *(f32x4*)(out + idx + bj * HALF + 4) = v1; s += sq4(v0) + sq4(v1);
                    u32x4 w; w.x = cvt_pk_bf16(v0[0], v0[1]); w.y = cvt_pk_bf16(v0[2], v0[3]); w.z = cvt_pk_bf16(v1[0], v1[1]); w.w = cvt_pk_bf16(v1[2], v1[3]);
                    *(u32x4*)(x1b + idx + bj * HALF) = w; }
                s += __shfl_xor(s, 16); s += __shfl_xor(s, 32);
                if (fq == 0) ssp[(size_t)row * 16 + u.pn * 4 + wc] = s; }
    }
};
struct EpiPP {
    static constexpr bool PERM = true, AFTER_DRAIN = false;
    bf16_t* pp;
    __device__ __forceinline__ void operator()(const f32x4 (&acc)[2][2][4][2], const Unit& u, int wr, int wc, int fr, int fq) const {
        const int row0 = u.pm * BM + wr * 64 + fr, col0 = u.pn * BM + wc * 32 + 8 * fq;
#pragma unroll
        for (int ai = 0; ai < 2; ++ai)
#pragma unroll
            for (int m = 0; m < 4; ++m) { const size_t idx = (size_t)(row0 + ai * HALF + m * 16) * D + col0;
#pragma unroll
                for (int bj = 0; bj < 2; ++bj) { const f32x4 v0 = acc[ai][bj][m][0], v1 = acc[ai][bj][m][1];
                    u32x4 w; w.x = cvt_pk_bf16(v0[0], v0[1]); w.y = cvt_pk_bf16(v0[2], v0[3]); w.z = cvt_pk_bf16(v1[0], v1[1]); w.w = cvt_pk_bf16(v1[2], v1[3]);
                    *(u32x4*)(pp + idx + bj * HALF) = w; } }
    }
};
struct EpiGate {
    static constexpr bool PERM = true, AFTER_DRAIN = false;
    float* out; const bf16_t* pp; const float* ssp1; float* ssp2;
    __device__ __forceinline__ void operator()(const f32x4 (&acc)[2][2][4][2], const Unit& u, int wr, int wc, int fr, int fq) const {
        const int row0 = u.pm * BM + wr * 64 + fr, col0 = u.pn * BM + wc * 32 + 8 * fq;
#pragma unroll
        for (int ai = 0; ai < 2; ++ai)
#pragma unroll
            for (int m = 0; m < 4; ++m) { const int row = row0 + ai * HALF + m * 16; const size_t idx = (size_t)row * D + col0;
                const f32x4* sp = (const f32x4*)(ssp1 + (size_t)row * 16); const f32x4 t4 = (sp[0] + sp[1]) + (sp[2] + sp[3]);
                const float r1 = rsqrtf(((t4[0] + t4[1]) + (t4[2] + t4[3])) * (1.f / D) + EPS); float s = 0.f;
#pragma unroll
                for (int bj = 0; bj < 2; ++bj) { const u32x4 pw = *(const u32x4*)(pp + idx + bj * HALF); const f32x4 a0 = acc[ai][bj][m][0] * r1, a1 = acc[ai][bj][m][1] * r1;
                    const f32x4 g0 = (f32x4){sigmoidf_(a0[0]), sigmoidf_(a0[1]), sigmoidf_(a0[2]), sigmoidf_(a0[3])}, g1 = (f32x4){sigmoidf_(a1[0]), sigmoidf_(a1[1]), sigmoidf_(a1[2]), sigmoidf_(a1[3])};
                    const f32x4 p0 = (f32x4){bflo(pw.x), bfhi(pw.x), bflo(pw.y), bfhi(pw.y)}, p1 = (f32x4){bflo(pw.z), bfhi(pw.z), bflo(pw.w), bfhi(pw.w)};
                    const f32x4 v0 = *(const f32x4*)(out + idx + bj * HALF) + g0 * p0, v1 = *(const f32x4*)(out + idx + bj * HALF + 4) + g1 * p1;
                    *(f32x4*)(out + idx + bj * HALF) = v0; *(f32x4*)(out + idx + bj * HALF + 4) = v1; s += sq4(v0) + sq4(v1); }
                s += __shfl_xor(s, 16); s += __shfl_xor(s, 32);
                if (fq == 0) ssp2[(size_t)row * 16 + u.pn * 4 + wc] = s; }
    }
};
template <class Epi, class Sched, bool ALIGN_EPI = false, bool SP2 = false>
__device__ __forceinline__ void gemm_phase(PG8_LAS unsigned char* lds, const Gemm g, const Sched& S, const Epi& E) {
    int tid_ = threadIdx.x; asm volatile("" : "+v"(tid_));
    const int tid = tid_, wid = __builtin_amdgcn_readfirstlane(tid >> 6), lane = tid & 63, wr = wid >> 2, wc = wid & 3, fr = lane & 15, fq = lane >> 4;
    int K_ = g.K; asm volatile("" : "+s"(K_));
    const int K = K_, nt = K / BK;
    unsigned voffA[2], voffB[2];
#pragma unroll
    for (int i = 0; i < 2; ++i) { int R, C; stage_rc(tid * 16 + i * 8192, R, C); const int Rb = Epi::PERM ? ((R & ~31) + perm32(R & 31)) : R;
        voffA[i] = (unsigned)(R * K + C) * 2u; voffB[i] = (unsigned)(Rb * K + C) * 2u; }
    const size_t kstep = (size_t)(BK * 2);
    const size_t hstep = (size_t)HALF * K * 2;
    const size_t tstep = 2 * hstep;
    const unsigned ldsw = (unsigned)wid * 1024u;
    const int aoff = lds_byte(wr * 64 + fr, fq * 8), boff = lds_byte(wc * 32 + fr, fq * 8);
#define PG8_SA(b, h) (((b) * 2 + (h)) * HTB)
#define PG8_SB(b, h) ((4 + (b) * 2 + (h)) * HTB)
#define PG8_STAGE(bufoff, gbase, voff) do { _Pragma("unroll") for (int _i = 0; _i < 2; ++_i) \
        __builtin_amdgcn_global_load_lds((const unsigned*)((const char*)(gbase) + (voff)[_i]), (PG8_LAS unsigned*)(lds + (bufoff) + ldsw + _i * 8192), 16, 0, 0); } while (0)
#define PG8_LDA(dst, b, h) do { _Pragma("unroll") for (int m = 0; m < 4; ++m) _Pragma("unroll") for (int k = 0; k < 2; ++k) dst[m][k] = *(const PG8_LAS bf16x8*)(lds + PG8_SA(b, h) + aoff + m * 2048 + k * 1024); } while (0)
#define PG8_LDB(dst, b, h) do { _Pragma("unroll") for (int n = 0; n < 2; ++n) _Pragma("unroll") for (int k = 0; k < 2; ++k) dst[n][k] = *(const PG8_LAS bf16x8*)(lds + PG8_SB(b, h) + boff + n * 2048 + k * 1024); } while (0)
#define PG8_MMA(ai, bj, At, Bt) do { __builtin_amdgcn_s_setprio(1); _Pragma("unroll") for (int m = 0; m < 4; ++m) _Pragma("unroll") for (int n = 0; n < 2; ++n) _Pragma("unroll") for (int k = 0; k < 2; ++k) \
        acc[ai][bj][m][n] = __builtin_amdgcn_mfma_f32_16x16x32_bf16(Bt[n][k], At[m][k], acc[ai][bj][m][n], 0, 0, 0); __builtin_amdgcn_s_setprio(0); } while (0)
#define PG8_WAIT_V(n) asm volatile("s_waitcnt vmcnt(" #n ")" ::: "memory")
#define PG8_WAIT_L(n) asm volatile("s_waitcnt lgkmcnt(" #n ")" ::: "memory")
#define PG8_BAR __builtin_amdgcn_s_barrier()
#define PG8_SCHED __builtin_amdgcn_sched_barrier(0)
    Unit cur, nxt; int ui = 0;
    if (!S.next(0, cur)) return;
    f32x4 acc[2][2][4][2];
#pragma unroll
    for (int a = 0; a < 2; ++a)
#pragma unroll
        for (int b = 0; b < 2; ++b)
#pragma unroll
            for (int m = 0; m < 4; ++m)
#pragma unroll
                for (int n = 0; n < 2; ++n) acc[a][b][m][n] = (f32x4){0.f, 0.f, 0.f, 0.f};
    bf16x8 At[4][2], B0[2][2], B1[2][2];
    const char* cA = (const char*)g.A + (size_t)cur.pm * tstep; const char* cB = (const char*)g.Bt + (size_t)cur.pn * tstep;
    S.a_ready(cur);
    if constexpr (SP2) {
        PG8_STAGE(PG8_SB(0, 0), cB, voffB); PG8_STAGE(PG8_SB(0, 1), cB + hstep, voffB); PG8_STAGE(PG8_SA(0, 0), cA, voffA); PG8_STAGE(PG8_SA(0, 1), cA + hstep, voffA);
        if (wr == 1) PG8_BAR;
        PG8_WAIT_V(2); PG8_BAR;
        PG8_STAGE(PG8_SB(1, 0), cB + kstep, voffB); PG8_STAGE(PG8_SA(1, 0), cA + kstep, voffA); PG8_STAGE(PG8_SB(1, 1), cB + hstep + kstep, voffB);
        PG8_WAIT_V(6); PG8_BAR;
    } else {
        PG8_STAGE(PG8_SB(0, 0), cB, voffB); PG8_STAGE(PG8_SA(0, 0), cA, voffA); PG8_STAGE(PG8_SB(0, 1), cB + hstep, voffB); PG8_STAGE(PG8_SA(0, 1), cA + hstep, voffA);
        if (wr == 1) PG8_BAR;
        PG8_WAIT_V(4); PG8_BAR;
        PG8_STAGE(PG8_SB(1, 0), cB + kstep, voffB); PG8_STAGE(PG8_SA(1, 0), cA + kstep, voffA); PG8_STAGE(PG8_SB(1, 1), cB + hstep + kstep, voffB);
        PG8_WAIT_V(6); PG8_BAR;
    }
    for (;;) {
        const bool has_next = S.next(ui + 1, nxt);
        const char* nA = has_next ? (const char*)g.A + (size_t)nxt.pm * tstep : cA; const char* nB = has_next ? (const char*)g.Bt + (size_t)nxt.pn * tstep : cB;
        for (int t = 0; t < nt; t += 2) {
            const bool last = (t == nt - 2);
            const char* a1 = cA + (size_t)(t + 1) * kstep;
            const char* a2 = last ? nA : cA + (size_t)(t + 2) * kstep; const char* b2 = last ? nB : cB + (size_t)(t + 2) * kstep;
            const char* a3 = a2 + kstep; const char* b3 = b2 + kstep;
            if (last && has_next) S.a_ready(nxt);
            if constexpr (SP2) {
            PG8_LDB(B0, 0, 0); PG8_LDB(B1, 0, 1); PG8_SCHED; PG8_LDA(At, 0, 0); PG8_STAGE(PG8_SA(1, 1), a1 + hstep, voffA);
            PG8_WAIT_V(8); PG8_WAIT_L(0); PG8_BAR; PG8_MMA(0, 0, At, B0); PG8_MMA(0, 1, At, B1); PG8_BAR; PG8_SCHED;
            PG8_LDA(At, 0, 1); PG8_STAGE(PG8_SB(0, 0), b2, voffB); PG8_STAGE(PG8_SB(0, 1), b2 + hstep, voffB); PG8_STAGE(PG8_SA(0, 0), a2, voffA);
            PG8_WAIT_V(8); PG8_WAIT_L(0); PG8_BAR; PG8_MMA(1, 0, At, B0); PG8_MMA(1, 1, At, B1); PG8_BAR; PG8_SCHED;
            PG8_LDB(B0, 1, 0); PG8_LDB(B1, 1, 1); PG8_SCHED; PG8_LDA(At, 1, 0); PG8_STAGE(PG8_SA(0, 1), a2 + hstep, voffA);
            PG8_WAIT_V(8); PG8_WAIT_L(0); PG8_BAR; PG8_MMA(0, 0, At, B0); PG8_MMA(0, 1, At, B1); PG8_BAR; PG8_SCHED;
            PG8_LDA(At, 1, 1); PG8_STAGE(PG8_SB(1, 0), b3, voffB); PG8_STAGE(PG8_SB(1, 1), b3 + hstep, voffB); PG8_STAGE(PG8_SA(1, 0), a3, voffA);
            PG8_WAIT_V(8); PG8_WAIT_L(0); PG8_BAR; PG8_MMA(1, 0, At, B0); PG8_MMA(1, 1, At, B1); PG8_BAR; PG8_SCHED;
            } else {
            PG8_LDB(B0, 0, 0); PG8_SCHED; PG8_LDA(At, 0, 0); PG8_STAGE(PG8_SA(1, 1), a1 + hstep, voffA);
            PG8_WAIT_L(8); PG8_BAR; PG8_WAIT_L(0); PG8_MMA(0, 0, At, B0); PG8_BAR; PG8_SCHED;
            PG8_LDB(B1, 0, 1); PG8_STAGE(PG8_SB(0, 0), b2, voffB);
            PG8_BAR; PG8_WAIT_L(0); PG8_MMA(0, 1, At, B1); PG8_BAR;
            PG8_LDA(At, 0, 1); PG8_STAGE(PG8_SA(0, 0), a2, voffA);
            PG8_BAR; PG8_WAIT_L(0); PG8_MMA(1, 0, At, B0); PG8_BAR; PG8_SCHED;
            PG8_STAGE(PG8_SB(0, 1), b2 + hstep, voffB);
            PG8_WAIT_V(6); PG8_BAR; PG8_MMA(1, 1, At, B1); PG8_BAR;
            PG8_LDB(B0, 1, 0); PG8_SCHED; PG8_LDA(At, 1, 0); PG8_STAGE(PG8_SA(0, 1), a2 + hstep, voffA);
            PG8_WAIT_L(8); PG8_BAR; PG8_WAIT_L(0); PG8_MMA(0, 0, At, B0); PG8_BAR; PG8_SCHED;
            PG8_LDB(B1, 1, 1); PG8_STAGE(PG8_SB(1, 0), b3, voffB);
            PG8_BAR; PG8_WAIT_L(0); PG8_MMA(0, 1, At, B1); PG8_BAR;
            PG8_LDA(At, 1, 1); PG8_STAGE(PG8_SA(1, 0), a3, voffA);
            PG8_BAR; PG8_WAIT_L(0); PG8_MMA(1, 0, At, B0); PG8_BAR; PG8_SCHED;
            PG8_STAGE(PG8_SB(1, 1), b3 + hstep, voffB);
            PG8_WAIT_V(6); PG8_BAR; PG8_MMA(1, 1, At, B1); PG8_BAR;
            }
        }
        if constexpr (ALIGN_EPI) { if (wr == 0) PG8_BAR; }
        if constexpr (!Epi::AFTER_DRAIN) { E(acc, cur, wr, wc, fr, fq); S.done(cur); }
        if (!has_next) break;
#pragma unroll
        for (int a = 0; a < 2; ++a)
#pragma unroll
            for (int b = 0; b < 2; ++b)
#pragma unroll
                for (int m = 0; m < 4; ++m)
#pragma unroll
                    for (int n = 0; n < 2; ++n) acc[a][b][m][n] = (f32x4){0.f, 0.f, 0.f, 0.f};
        cur = nxt; cA = nA; cB = nB; ++ui;
        if constexpr (ALIGN_EPI) { if (wr == 1) PG8_BAR; }
    }
    PG8_WAIT_V(0);
    if constexpr (!ALIGN_EPI) { if (wr == 0) PG8_BAR; }
    PG8_BAR;
    if constexpr (Epi::AFTER_DRAIN) { E.fused(acc, cur, wr, wc, fr, fq, lds, wid, lane); S.done(cur); }
#undef PG8_SA
#undef PG8_SB
#undef PG8_STAGE
#undef PG8_LDA
#undef PG8_LDB
#undef PG8_MMA
#undef PG8_WAIT_V
#undef PG8_WAIT_L
#undef PG8_BAR
#undef PG8_SCHED
}
}
#define XB_TMO      128
#define XB_XCNT(j)  (256  + 64 * (j))
#define XB_XSUB(j)  (1280 + 64 * (j))
#define XB_XGEN(j)  (2304 + 64 * (j))
#define XB_TOP      3328
#define XB_TOPGEN   3392
#define XCD_BAR_WORDS 3456
#define XB_SPIN_CAP (1u << 18)

__device__ __forceinline__ unsigned xb_ld(unsigned* p)              { return __hip_atomic_load(p, __ATOMIC_RELAXED, __HIP_MEMORY_SCOPE_AGENT); }
__device__ __forceinline__ unsigned xb_add(unsigned* p, unsigned v) { return __hip_atomic_fetch_add(p, v, __ATOMIC_RELAXED, __HIP_MEMORY_SCOPE_AGENT); }
__device__ __forceinline__ unsigned xb_xcc_id() { return (unsigned)__builtin_amdgcn_s_getreg((3 << 11) | 20) & 0xFu; }
#define XB_SPIN(cond, bar) do { unsigned _sp = 0; while (cond) { __builtin_amdgcn_s_sleep(1); \
    if ((++_sp & 255u) == 0u) { if (xb_ld(&(bar)[XB_TMO])) break; if (_sp > XB_SPIN_CAP) { atomicAdd(&(bar)[XB_TMO], 1u); break; } } } } while (0)

struct XcdBarrier {
    unsigned* bar; unsigned x;
    volatile LAS unsigned* st;
};

__device__ __forceinline__ XcdBarrier xcd_barrier_post(unsigned* bar, volatile LAS unsigned* st) {
    XcdBarrier b; b.bar = bar; b.x = xb_xcc_id(); b.st = st;
    if (threadIdx.x == 0) (void)xb_add(&bar[XB_XCNT(b.x)], 1u);
    return b;
}
__device__ __forceinline__ void xcd_barrier_complete(unsigned* bar, unsigned x, unsigned& nloc, unsigned& nx) {
    const unsigned G = gridDim.x * gridDim.y * gridDim.z;
    unsigned sum, cnt, mine, sp = 0u;
    for (;;) {
        sum = 0u; cnt = 0u; mine = 0u;
#pragma unroll
        for (unsigned j = 0; j < 16; ++j) { const unsigned c = xb_ld(&bar[XB_XCNT(j)]); sum += c; cnt += (c > 0u) ? 1u : 0u; mine = (j == x) ? c : mine; }
        if (sum == G) break;
        __builtin_amdgcn_s_sleep(1);
        if ((++sp & 255u) == 0u) { if (xb_ld(&bar[XB_TMO])) break; if (sp > XB_SPIN_CAP) { atomicAdd(&bar[XB_TMO], 1u); break; } }
    }
    nloc = mine > 0u ? mine : 1u; nx = cnt > 0u ? cnt : 1u;
}

__device__ __forceinline__ void xcd_barrier(const XcdBarrier& b) {
    asm volatile("s_waitcnt vmcnt(0)" ::: "memory");
    __syncthreads();
    if (threadIdx.x == 0) {
        unsigned* bar = b.bar;
        __builtin_amdgcn_s_waitcnt(0);
        unsigned nloc = b.st[0], nx = b.st[1];
        if (nloc == 0u) { xcd_barrier_complete(bar, b.x, nloc, nx); b.st[0] = nloc; b.st[1] = nx; }
        const unsigned old = xb_add(&bar[XB_XSUB(b.x)], 1u);
        const unsigned gen = old / nloc;
        if (old + 1u == (gen + 1u) * nloc) {
            __builtin_amdgcn_fence(__ATOMIC_RELEASE, "agent");
            asm volatile("s_waitcnt vmcnt(0)" ::: "memory");
            const unsigned og = xb_add(&bar[XB_TOP], 1u);
            const unsigned tg = og / nx;
            if (og + 1u == (tg + 1u) * nx) xb_add(&bar[XB_TOPGEN], 1u);
            else XB_SPIN(xb_ld(&bar[XB_TOPGEN]) == tg, bar);
            __builtin_amdgcn_fence(__ATOMIC_ACQUIRE, "agent");
            xb_add(&bar[XB_XGEN(b.x)], 1u);
            asm volatile("s_waitcnt vmcnt(0)" ::: "memory");
        } else {
            XB_SPIN(xb_ld(&bar[XB_XGEN(b.x)]) == gen, bar);
            __builtin_amdgcn_fence(__ATOMIC_ACQUIRE, "agent");
            asm volatile("s_waitcnt vmcnt(0)" ::: "memory");
        }
    }
    __syncthreads();
}
constexpr int NWAVES = 8;
constexpr int RING_OFF = 0, RING_BYTES = 131072;
constexpr int LDSCTL_OFF = RING_BYTES, MISC_OFF = LDSCTL_OFF + 320;
constexpr int LDS_BYTES = 147456;

struct Frame {
    LAS unsigned char* lds; volatile LAS unsigned* MISC;
    int tid, lane, wave, G, vcu;
    const float* in[15]; float* out; unsigned char* ws;
};

__device__ __forceinline__ void prep_w_item(const float* W, const float* gain, int K, int Nsrc, bool map, bf16_t* Wt, LAS float* scr, int item, int nblk, int lane) {
    const int kb = item / nblk, nb = item % nblk, k0 = 64 * kb, n0 = 32 * nb;
    const int nn = n0 + (lane & 31); const int e = map ? inmap(nn) : nn;
#pragma unroll 8
    for (int i = 0; i < 32; ++i) { const int kk = 2 * i + (lane >> 5); float v = 0.f;
        if (e >= 0) v = W[(size_t)(k0 + kk) * Nsrc + e] * (gain ? gain[k0 + kk] : 1.f);
        scr[kk * 33 + (lane & 31)] = v; }
    LDS_WAIT(); asm volatile("" ::: "memory");
    const int c = lane & 7;
#pragma unroll
    for (int j = 0; j < 4; ++j) { const int n = (lane >> 3) + 8 * j; const LAS float* s = scr + (8 * c) * 33 + n;
        u32x4 o; o.x = pk2(s[0 * 33], s[1 * 33]); o.y = pk2(s[2 * 33], s[3 * 33]); o.z = pk2(s[4 * 33], s[5 * 33]); o.w = pk2(s[6 * 33], s[7 * 33]);
        *(u32x4*)(Wt + (size_t)(n0 + n) * K + k0 + 8 * c) = o; }
    LDS_WAIT(); asm volatile("" ::: "memory");
}
__device__ __forceinline__ void p0_prep(Frame& F) {
    LAS float* scr = (LAS float*)(F.lds + RING_OFF + F.wave * 16384);
    int tid_ = threadIdx.x; asm volatile("" : "+v"(tid_));
    const int lane = tid_ & 63, gw = F.vcu * NWAVES + __builtin_amdgcn_readfirstlane(tid_ >> 6), NGW = F.G * NWAVES;
    unsigned char* ws = F.ws;
    constexpr int I_IN = (D / 64) * (NINP / 32), I_A = (DC / 64) * (D / 32), I_O = (D / 64) * (D / 32), I_P = (DPLE / 64) * (D / 32);
    constexpr int NITEMS = I_IN + 2 * I_A + 2 * I_O + I_P;
    for (int it = gw; it < NITEMS; it += NGW) {
        int r = it;
        if (r < I_IN) { prep_w_item(F.in[3], F.in[2], D, NIN, true, (bf16_t*)(ws + WS_WIN), scr, r, NINP / 32, lane); continue; } r -= I_IN;
        if (r < I_A) { prep_w_item(F.in[8], nullptr, DC, D, false, (bf16_t*)(ws + WS_WA), scr, r, D / 32, lane); continue; } r -= I_A;
        if (r < I_A) { prep_w_item(F.in[9], nullptr, DC, D, false, (bf16_t*)(ws + WS_WB), scr, r, D / 32, lane); continue; } r -= I_A;
        if (r < I_O) { prep_w_item(F.in[10], nullptr, D, D, false, (bf16_t*)(ws + WS_WO), scr, r, D / 32, lane); continue; } r -= I_O;
        if (r < I_O) { prep_w_item(F.in[12], F.in[11], D, D, false, (bf16_t*)(ws + WS_WG), scr, r, D / 32, lane); continue; } r -= I_O;
        prep_w_item(F.in[13], nullptr, DPLE, D, false, (bf16_t*)(ws + WS_WP), scr, r, D / 32, lane);
    }
    const float* x = F.in[0]; const float* p = F.in[1]; bf16_t* xb = (bf16_t*)(ws + WS_XB); bf16_t* pb = (bf16_t*)(ws + WS_PB); float* rinv = (float*)(ws + WS_RINV);
    for (int m = gw; m < M; m += NGW) {
        const f32x4* xr = (const f32x4*)(x + (size_t)m * D) + lane; f32x4 v[4]; float s = 0.f;
#pragma unroll
        for (int j = 0; j < 4; ++j) { v[j] = xr[64 * j]; s += (v[j].x * v[j].x + v[j].y * v[j].y) + (v[j].z * v[j].z + v[j].w * v[j].w); }
        s = wave_sum(s);
        if (lane == 0) rinv[m] = rsqrtf(s * (1.f / D) + EPS);
        u32x2* o = (u32x2*)(xb + (size_t)m * D) + lane;
#pragma unroll
        for (int j = 0; j < 4; ++j) { u32x2 w; w.x = pk2(v[j].x, v[j].y); w.y = pk2(v[j].z, v[j].w); o[64 * j] = w; }
        const f32x4 pv = ((const f32x4*)(p + (size_t)m * DPLE))[lane];
        u32x2 w; w.x = pk2(pv.x, pv.y); w.y = pk2(pv.z, pv.w); ((u32x2*)(pb + (size_t)m * DPLE))[lane] = w;
    }
}

constexpr int CF_TOK = 128, CF_CH = 16;
__device__ __forceinline__ void p2_conformer(Frame& F) {
    LAS float* red = (LAS float*)(F.lds + RING_OFF);
    const bf16_t* cin = (const bf16_t*)(F.ws + WS_CIN); const bf16_t* cz = (const bf16_t*)(F.ws + WS_CZ); bf16_t* ya = (bf16_t*)(F.ws + WS_YA);
    const float* conv_w = F.in[4];
    int tid_ = threadIdx.x; asm volatile("" : "+v"(tid_));
    const int ch = tid_, lane = tid_ & 63, wv = __builtin_amdgcn_readfirstlane(tid_ >> 6);
    float w[CWID];
#pragma unroll
    for (int j = 0; j < CWID; ++j) w[j] = conv_w[j * DC + ch];
    const float cb = F.in[5][ch], g = F.in[6][ch], bb = F.in[7][ch];
    for (int item = F.vcu; item < M / CF_TOK; item += F.G) {
        const int b = item / (SEQ / CF_TOK), t0 = (item % (SEQ / CF_TOK)) * CF_TOK; const size_t rowb = (size_t)b * SEQ;
        float u[CF_CH + CWID - 1];
#pragma unroll
        for (int i = 0; i < CWID - 1; ++i) { const int t = t0 - (CWID - 1) + i; float v = 0.f;
            if (t >= 0) { const float a = bf2f(cin[(rowb + t) * 1024 + ch]), gt = bf2f(cin[(rowb + t) * 1024 + 512 + ch]); v = a * sigmoidf_(gt); }
            u[i] = v; }
        for (int tc = t0; tc < t0 + CF_TOK; tc += CF_CH) {
#pragma unroll
            for (int i = 0; i < CF_CH; ++i) { const size_t r = (rowb + tc + i) * 1024; const float a = bf2f(cin[r + ch]), gt = bf2f(cin[r + 512 + ch]); u[CWID - 1 + i] = a * sigmoidf_(gt); }
            float c[CF_CH];
#pragma unroll
            for (int i = 0; i < CF_CH; ++i) { float s = cb;
#pragma unroll
                for (int j = 0; j < CWID; ++j) s = fmaf(w[j], u[i + j], s);
                c[i] = s; }
#pragma unroll
            for (int i = 0; i < CF_CH; ++i) { const float s1 = wave_sum(c[i]), s2 = wave_sum(c[i] * c[i]); if (lane == 0) { red[wv * 32 + 2 * i] = s1; red[wv * 32 + 2 * i + 1] = s2; } }
            __syncthreads();
#pragma unroll
            for (int i = 0; i < CF_CH; ++i) { float s1 = 0.f, s2 = 0.f;
#pragma unroll
                for (int q = 0; q < 8; ++q) { s1 += red[q * 32 + 2 * i]; s2 += red[q * 32 + 2 * i + 1]; }
                const float mu = s1 * (1.f / DC), var = fmaxf(s2 * (1.f / DC) - mu * mu, 0.f), rs = rsqrtf(var + EPS);
                const float y = (c[i] - mu) * rs * g + bb; const float z = bf2f(cz[(rowb + tc + i) * DC + ch]);
                ya[(rowb + tc + i) * DC + ch] = f2bf(siluf_(y) * siluf_(z)); }
            __syncthreads();
#pragma unroll
            for (int i = 0; i < CWID - 1; ++i) u[i] = u[i + CF_CH];
        }
    }
}

#ifndef REP_PASS1
#define REP_PASS1 1
#endif
#ifndef REP_SEL
#define REP_SEL 1
#endif
#ifndef REP_PASS2
#define REP_PASS2 1
#endif
__device__ __forceinline__ float max3f_(float a, float b, float c) { float r; asm("v_max3_f32 %0, %1, %2, %3" : "=v"(r) : "v"(a), "v"(b), "v"(c)); return r; }
__device__ __forceinline__ float relu_(float a) { float r; asm("v_max_f32_e32 %0, 0, %1" : "=v"(r) : "v"(a)); return r; }
typedef short bf16x8 __attribute__((ext_vector_type(8)));
typedef float f32x16 __attribute__((ext_vector_type(16)));
__device__ __forceinline__ unsigned skey(float f) { const unsigned u = __float_as_uint(f + 0.f); return (u & 0x80000000u) ? ~u : (u | 0x80000000u); }
__device__ __forceinline__ int half_sum(int v) {
    v += __builtin_amdgcn_update_dpp(0, v, 0xB1, 0xf, 0xf, false);
    v += __builtin_amdgcn_update_dpp(0, v, 0x4E, 0xf, 0xf, false);
    v += __builtin_amdgcn_update_dpp(0, v, 0x141, 0xf, 0xf, false);
    v += __builtin_amdgcn_update_dpp(0, v, 0x140, 0xf, 0xf, false);
    v += __shfl_xor(v, 16);
    return v;
}
__device__ __forceinline__ void pk_count_below(unsigned& acc, unsigned cand2, unsigned keys2, unsigned one2) {
    unsigned t; asm("v_pk_sub_u16 %0, %2, %3 clamp\n\tv_pk_min_u16 %0, %0, %4\n\tv_pk_add_u16 %1, %1, %0" : "=&v"(t), "+v"(acc) : "v"(cand2), "v"(keys2), "v"(one2));
}
__device__ __forceinline__ void attn_pass1_select(Frame& F, int b, int qb, LAS unsigned char* lds, unsigned (&mAo)[2], unsigned (&mBo)[2]) {
    int tid_ = threadIdx.x; asm volatile("" : "+v"(tid_));
    const int lane = tid_ & 63, w = __builtin_amdgcn_readfirstlane(tid_ >> 6), col = lane & 31, half = lane >> 5;
    const bf16_t* iq = (const bf16_t*)(F.ws + WS_IQ); const bf16_t* sm = (const bf16_t*)(F.ws + WS_SM);
    const size_t rowb = (size_t)b * SEQ; const int t0 = 32 * qb; const size_t m0w = rowb + t0 + 4 * w;
    bf16x8 aq[4];
    { const int r = col, half_r = (r >> 2) & 1, qsel = r >> 4, head = (r & 3) + 4 * ((r >> 3) & 1), ql = 2 * half_r + qsel;
#pragma unroll
      for (int ks = 0; ks < 4; ++ks) aq[ks] = *(const bf16x8*)(iq + (m0w + ql) * 512 + head * 64 + 16 * ks + 8 * half); }
    float wr[16];
    { const u32x4 va = *(const u32x4*)(sm + (m0w + 2 * half) * 256 + 192), vb = *(const u32x4*)(sm + (m0w + 2 * half + 1) * 256 + 192);
      const float wa[8] = {bflo(va.x), bfhi(va.x), bflo(va.y), bfhi(va.y), bflo(va.z), bfhi(va.z), bflo(va.w), bfhi(va.w)};
      const float wb[8] = {bflo(vb.x), bfhi(vb.x), bflo(vb.y), bfhi(vb.y), bflo(vb.z), bfhi(vb.z), bflo(vb.w), bfhi(vb.w)};
      const float sc = 0.125f * 0.35355339059327373f;
#pragma unroll
      for (int i = 0; i < 8; ++i) { wr[i] = wa[(i & 3) + 4 * (i >> 2)] * sc; wr[8 + i] = wb[(i & 3) + 4 * (i >> 2)] * sc; } }
    LAS f32x4* wl = (LAS f32x4*)(lds + 65536 + w * 128 + half * 64);
    if (col == 0) {
#pragma unroll
        for (int i = 0; i < 4; ++i) wl[i] = (f32x4){wr[4 * i], wr[4 * i + 1], wr[4 * i + 2], wr[4 * i + 3]}; }
    int offk[4];
#pragma unroll
    for (int ks = 0; ks < 4; ++ks) offk[ks] = col * 128 + ((((2 * ks + half) ^ ((col >> 1) & 7))) << 4);
    const int nch = qb / 8 + 1;
    unsigned vok[2];
#pragma unroll
    for (int i_ = 0; i_ < 2; ++i_) vok[i_] = (unsigned)((lane >> 3) * 512 + 16 * ((lane & 7) ^ ((4 * i_ + (lane >> 4)) & 7)));
#define AT_STAGE(c, bufsel) do { _Pragma("unroll") for (int i_ = 0; i_ < 4; ++i_) { const int seg = 4 * w + i_; unsigned vo_ = vok[i_ & 1]; asm volatile("" : "+v"(vo_)); \
        __builtin_amdgcn_global_load_lds((const unsigned*)((const char*)sm + ((rowb + 256 * (c) + 8 * seg) * 256 + 128) * 2 + vo_), (LAS unsigned*)(lds + (bufsel) * 32768 + seg * 1024), 16, 0, 0); } } while (0)
    unsigned kA[64], kB[64];
    const int sh = 8 * (8 - nch);
    for (int rep1_ = 0; rep1_ < REP_PASS1; ++rep1_) {
#pragma unroll
    for (int i = 0; i < 64; ++i) { kA[i] = 0u; kB[i] = 0u; }
    AT_STAGE(0, 0);
    asm volatile("s_waitcnt vmcnt(0)" ::: "memory"); __syncthreads();
    for (int c = 0; c < nch; ++c) {
        if (c + 1 < nch) AT_STAGE(c + 1, (c + 1) & 1);
#pragma unroll
        for (int i = 0; i < 56; ++i) { kA[i] = kA[i + 8]; kB[i] = kB[i + 8]; }
        const LAS unsigned char* img = lds + (c & 1) * 32768;
#pragma unroll
        for (int jj = 0; jj < 8; ++jj) { const int dq = qb - (8 * c + jj);
            bf16x8 bk[4];
#pragma unroll
            for (int ks = 0; ks < 4; ++ks) bk[ks] = *(const LAS bf16x8*)(img + jj * 4096 + offk[ks]);
            f32x16 acc = {0.f, 0.f, 0.f, 0.f, 0.f, 0.f, 0.f, 0.f, 0.f, 0.f, 0.f, 0.f, 0.f, 0.f, 0.f, 0.f};
#pragma unroll
            for (int ks = 0; ks < 4; ++ks) acc = __builtin_amdgcn_mfma_f32_32x32x16_bf16(aq[ks], bk[ks], acc, 0, 0, 0);
            float sA = 0.f, sB = 0.f;
            { const f32x4 w0 = wl[0], w1 = wl[1], w2 = wl[2], w3 = wl[3];
#pragma unroll
              for (int i = 0; i < 4; ++i) { sA = fmaf(w0[i], __builtin_amdgcn_fmed3f(acc[i], 0.f, INFINITY), sA); sA = fmaf(w1[i], __builtin_amdgcn_fmed3f(acc[4 + i], 0.f, INFINITY), sA);
                                            sB = fmaf(w2[i], __builtin_amdgcn_fmed3f(acc[8 + i], 0.f, INFINITY), sB); sB = fmaf(w3[i], __builtin_amdgcn_fmed3f(acc[12 + i], 0.f, INFINITY), sB); } }
            const int limA = dq > 0 ? 31 : (dq == 0 ? 4 * w + 2 * half : -1), limB = dq > 0 ? 31 : (dq == 0 ? 4 * w + 2 * half + 1 : -1);
            kA[56 + jj] = (col <= limA) ? skey(sA) : 0u; kB[56 + jj] = (col <= limB) ? skey(sB) : 0u;
            __builtin_amdgcn_sched_barrier(0);
        }
        asm volatile("s_waitcnt vmcnt(0)" ::: "memory"); __syncthreads();
    }
    }
#undef AT_STAGE
    const int nA = t0 + 4 * w + 2 * half + 1, nB = nA + 1;
    unsigned prefA = 0u, prefB = 0u, thrA = 1u, thrB = 1u; bool exA = nA <= TOPK, exB = nB <= TOPK;
    unsigned pA[32], pB[32];
#pragma unroll
    for (int i = 0; i < 32; ++i) { pA[i] = (kA[2 * i] >> 16) | (kA[2 * i + 1] & 0xffff0000u); pB[i] = (kB[2 * i] >> 16) | (kB[2 * i + 1] & 0xffff0000u); }
    const int nproc = 8 * nch;
    for (int reps_ = 0; reps_ < REP_SEL; ++reps_) {
    prefA = 0u; prefB = 0u; thrA = 1u; thrB = 1u; exA = nA <= TOPK; exB = nB <= TOPK; asm volatile("" : "+v"(prefA), "+v"(prefB));
    for (int bit = 31; bit >= 16; --bit) {
        if (__all(exA && exB)) break;
        const unsigned candA = prefA | (1u << bit), candB = prefB | (1u << bit);
        const unsigned cA2 = (candA >> 16) * 0x10001u, cB2 = (candB >> 16) * 0x10001u; unsigned one2 = 0x00010001u; asm volatile("" : "+v"(one2));
        unsigned aA = 0u, aB = 0u;
#pragma unroll
        for (int g = 0; g < 8; ++g) if (g >= 8 - nch) {
#pragma unroll
            for (int jj = 0; jj < 4; ++jj) { pk_count_below(aA, cA2, pA[4 * g + jj], one2); pk_count_below(aB, cB2, pB[4 * g + jj], one2); } }
        const int cA = half_sum(nproc - (int)(aA & 0xffffu) - (int)(aA >> 16)), cB = half_sum(nproc - (int)(aB & 0xffffu) - (int)(aB >> 16));
        if (!exA) { if (cA == TOPK) { thrA = candA; exA = true; } else if (cA > TOPK) prefA = candA; }
        if (!exB) { if (cB == TOPK) { thrB = candB; exB = true; } else if (cB > TOPK) prefB = candB; }
    }
    for (int bit = 15; bit >= 0; --bit) {
        if (__all(exA && exB)) break;
        const unsigned candA = prefA | (1u << bit), candB = prefB | (1u << bit);
        int cA = 0, cB = 0;
#pragma unroll
        for (int g = 0; g < 8; ++g) if (g >= 8 - nch) {
#pragma unroll
            for (int jj = 0; jj < 8; ++jj) { cA += (kA[8 * g + jj] >= candA) ? 1 : 0; cB += (kB[8 * g + jj] >= candB) ? 1 : 0; } }
        cA = half_sum(cA); cB = half_sum(cB);
        if (!exA) { if (cA == TOPK) { thrA = candA; exA = true; } else if (cA > TOPK) prefA = candA; }
        if (!exB) { if (cB == TOPK) { thrB = candB; exB = true; } else if (cB > TOPK) prefB = candB; }
    }
    }
    const unsigned tA = exA ? thrA : prefA + 1u, tB = exB ? thrB : prefB + 1u;
    unsigned mA[2] = {0u, 0u}, mB[2] = {0u, 0u};
#pragma unroll
    for (int j = 0; j < 64; ++j) { mA[j >> 5] |= (kA[j] >= tA) ? (1u << (j & 31)) : 0u; mB[j >> 5] |= (kB[j] >= tB) ? (1u << (j & 31)) : 0u; }
    if (!__all(exA && exB)) {
        const int needA = TOPK - half_sum(__popc(mA[0]) + __popc(mA[1])), needB = TOPK - half_sum(__popc(mB[0]) + __popc(mB[1]));
        int befA = 0, befB = 0; const unsigned below = (1u << col) - 1u;
#pragma unroll
        for (int j = 0; j < 64; ++j) {
            const bool eA = !exA && kA[j] == prefA, eB = !exB && kB[j] == prefB;
            const unsigned long long balA = __ballot(eA), balB = __ballot(eB);
            const unsigned hA = half ? (unsigned)(balA >> 32) : (unsigned)balA, hB = half ? (unsigned)(balB >> 32) : (unsigned)balB;
            if (eA && befA + __popc(hA & below) < needA) mA[j >> 5] |= 1u << (j & 31);
            if (eB && befB + __popc(hB & below) < needB) mB[j >> 5] |= 1u << (j & 31);
            befA += __popc(hA); befB += __popc(hB);
        }
    }
#ifdef SELCHECK
    { unsigned mnA = 0xffffffffu, mxA = 0u, mnB = 0xffffffffu, mxB = 0u;
#pragma unroll
      for (int i = 0; i < 64; ++i) { const bool sa = (mA[i >> 5] >> (i & 31)) & 1u, sb = (mB[i >> 5] >> (i & 31)) & 1u;
          if (sa) mnA = min(mnA, kA[i]); else mxA = max(mxA, kA[i]); if (sb) mnB = min(mnB, kB[i]); else mxB = max(mxB, kB[i]); }
#pragma unroll
      for (int o = 1; o < 32; o <<= 1) { mnA = min(mnA, (unsigned)__shfl_xor((int)mnA, o)); mxA = max(mxA, (unsigned)__shfl_xor((int)mxA, o)); mnB = min(mnB, (unsigned)__shfl_xor((int)mnB, o)); mxB = max(mxB, (unsigned)__shfl_xor((int)mxB, o)); }
      const int csA = half_sum(__popc(mA[0]) + __popc(mA[1])), csB = half_sum(__popc(mB[0]) + __popc(mB[1]));
      const bool bad = csA != (nA < TOPK ? nA : TOPK) || csB != (nB < TOPK ? nB : TOPK) || mxA > mnA || mxB > mnB || mnA == 0u || mnB == 0u;
      if (bad) atomicOr((unsigned*)(F.ws + WS_CTL + 8192), 1u); }
#endif
    { const unsigned long long a64 = (((unsigned long long)mA[1] << 32) | mA[0]) >> sh, b64 = (((unsigned long long)mB[1] << 32) | mB[0]) >> sh;
      mA[0] = (unsigned)a64; mA[1] = (unsigned)(a64 >> 32); mB[0] = (unsigned)b64; mB[1] = (unsigned)(b64 >> 32); }
    mAo[0] = mA[0]; mAo[1] = mA[1]; mBo[0] = mB[0]; mBo[1] = mB[1];
}
__device__ __forceinline__ void attn_pass2(Frame& F, int b, int qb, LAS unsigned char* lds, unsigned (&mA)[2], unsigned (&mB)[2]) {
    int tid_ = threadIdx.x; asm volatile("" : "+v"(tid_), "+v"(mA[0]), "+v"(mA[1]), "+v"(mB[0]), "+v"(mB[1]));
    const int lane = tid_ & 63, w = __builtin_amdgcn_readfirstlane(tid_ >> 6), col = lane & 31, half = lane >> 5;
    const bf16_t* sm = (const bf16_t*)(F.ws + WS_SM);
    const size_t rowb = (size_t)b * SEQ; const int t0 = 32 * qb; const size_t m0w = rowb + t0 + 4 * w;
    const int nch = qb / 8 + 1;
    int offk[4];
#pragma unroll
    for (int ks = 0; ks < 4; ++ks) offk[ks] = col * 128 + ((((2 * ks + half) ^ ((col >> 1) & 7))) << 4);
    const bf16_t* qbuf = (const bf16_t*)(F.ws + WS_Q); const bf16_t* vt = (const bf16_t*)(F.ws + WS_VT); const bf16_t* az = (const bf16_t*)(F.ws + WS_AZ); bf16_t* yb = (bf16_t*)(F.ws + WS_YB);
    typedef unsigned long long u64;
    u64 mq[4];
    { const unsigned oa0 = __shfl_xor(mA[0], 32), oa1 = __shfl_xor(mA[1], 32), ob0 = __shfl_xor(mB[0], 32), ob1 = __shfl_xor(mB[1], 32);
      const u64 ownA = ((u64)mA[1] << 32) | mA[0], ownB = ((u64)mB[1] << 32) | mB[0], othA = ((u64)oa1 << 32) | oa0, othB = ((u64)ob1 << 32) | ob0;
      mq[0] = half ? othA : ownA; mq[1] = half ? othB : ownB; mq[2] = half ? ownA : othA; mq[3] = half ? ownB : othB; }
    const int qlc = col >> 3, hd = col & 7;
    bf16x8 bq[4];
#pragma unroll
    for (int ks = 0; ks < 4; ++ks) bq[ks] = *(const bf16x8*)(qbuf + (m0w + qlc) * 512 + hd * 64 + 16 * ks + 8 * half);
    const float cslope = exp2f(-(float)(hd + 1)) * 1.4426950408889634f;
    const unsigned c_hi = f2bf(cslope), c_lo = f2bf(cslope - bf2f((bf16_t)c_hi));
    float mref = cslope * (float)(t0 + 4 * w + qlc);
    u32x4 bau;
#define AT_MPIECES(mval) do { const float v_ = -(mval); const unsigned uh_ = __float_as_uint(v_) & 0xffff0000u; const float r_ = v_ - __uint_as_float(uh_); \
        const unsigned um_ = __float_as_uint(r_) & 0xffff0000u; const float r2_ = r_ - __uint_as_float(um_); bau.z = half ? ((uh_ >> 16) | um_) : 0u; bau.w = half ? (unsigned)f2bf(r2_) : 0u; } while (0)
    if (half) { bau.x = (unsigned)f2bf(16.f * bf2f((bf16_t)c_hi)) | ((unsigned)f2bf(16.f * bf2f((bf16_t)c_lo)) << 16); bau.y = c_hi | (c_lo << 16); }
    else { bau.x = (qlc == 0 ? 0x3f80u : 0u) | (qlc == 1 ? 0x3f800000u : 0u); bau.y = (qlc == 2 ? 0x3f80u : 0u) | (qlc == 3 ? 0x3f800000u : 0u); }
    AT_MPIECES(mref);
    const unsigned slo_b = __float_as_uint((float)(col & 15)) >> 16, slo2 = slo_b | (slo_b << 16);
    int offv[2][2];
#pragma unroll
    for (int dt = 0; dt < 2; ++dt)
#pragma unroll
        for (int s2 = 0; s2 < 2; ++s2) offv[dt][s2] = (32 * dt + col) * 64 + ((((2 * s2 + half) ^ ((col >> 2) & 3))) << 4);
    f32x16 oacc[2]; float lsum; bool anch;
    const f32x16 zero16 = {0.f, 0.f, 0.f, 0.f, 0.f, 0.f, 0.f, 0.f, 0.f, 0.f, 0.f, 0.f, 0.f, 0.f, 0.f, 0.f};
    unsigned vok[2], vov[4];
#pragma unroll
    for (int i_ = 0; i_ < 2; ++i_) vok[i_] = (unsigned)((lane >> 3) * 512 + 16 * ((lane & 7) ^ ((4 * i_ + (lane >> 4)) & 7)));
#pragma unroll
    for (int i_ = 0; i_ < 4; ++i_) { const int dd_ = 16 * i_ + (lane >> 2); vov[i_] = (unsigned)(dd_ * (SEQ * 2) + 16 * ((lane & 3) ^ ((dd_ >> 2) & 3))); }
#define AT_STAGE2(c, bufsel) do { _Pragma("unroll") for (int i_ = 0; i_ < 4; ++i_) { const int seg = 4 * w + i_; unsigned vo_ = vok[i_ & 1], vv_ = vov[i_]; asm volatile("" : "+v"(vo_), "+v"(vv_)); \
        __builtin_amdgcn_global_load_lds((const unsigned*)((const char*)sm + ((rowb + 256 * (c) + 8 * seg) * 256) * 2 + vo_), (LAS unsigned*)(lds + (bufsel) * 32768 + seg * 1024), 16, 0, 0); \
        __builtin_amdgcn_global_load_lds((const unsigned*)((const char*)vt + ((size_t)b * 64 * SEQ + 256 * (c) + 32 * w) * 2 + vv_), (LAS unsigned*)(lds + 65536 + (bufsel) * 32768 + seg * 1024), 16, 0, 0); } } while (0)
    for (int rep2_ = 0; rep2_ < REP_PASS2; ++rep2_) {
#pragma unroll
    for (int dt = 0; dt < 2; ++dt)
#pragma unroll
        for (int i = 0; i < 16; ++i) oacc[dt][i] = 0.f;
    lsum = 0.f; anch = false; mref = cslope * (float)(t0 + 4 * w + qlc); AT_MPIECES(mref);
    __syncthreads();
    AT_STAGE2(nch - 1, (nch - 1) & 1);
    asm volatile("s_waitcnt vmcnt(0)" ::: "memory"); __syncthreads();
    for (int c = nch - 1; c >= 0; --c) {
        if (c > 0) AT_STAGE2(c - 1, (c - 1) & 1);
        const LAS unsigned char* kimg = lds + (c & 1) * 32768; const LAS unsigned char* vimg = lds + 65536 + (c & 1) * 32768;
        for (int jj = 7; jj >= 0; --jj) { const int j = 8 * c + jj;
            if (j > qb) continue;
            bf16x8 ak[4];
#pragma unroll
            for (int ks = 0; ks < 4; ++ks) ak[ks] = *(const LAS bf16x8*)(kimg + jj * 4096 + offk[ks]);
            u32x4 aau;
            { const unsigned p0 = (unsigned)(~(mq[0] >> j) & 1ull) * 0xc700u, p1 = (unsigned)(~(mq[1] >> j) & 1ull) * 0xc700u, p2 = (unsigned)(~(mq[2] >> j) & 1ull) * 0xc700u, p3 = (unsigned)(~(mq[3] >> j) & 1ull) * 0xc700u;
              const unsigned shi_b = __float_as_uint((float)(2 * j + (col >> 4))) >> 16;
              aau.x = half ? (shi_b | (shi_b << 16)) : (p0 | (p1 << 16)); aau.y = half ? slo2 : (p2 | (p3 << 16)); aau.z = half ? 0x3f803f80u : 0u; aau.w = half ? 0x00003f80u : 0u; }
            f32x16 x = __builtin_amdgcn_mfma_f32_32x32x16_bf16(ak[0], bq[0], zero16, 0, 0, 0);
#pragma unroll
            for (int ks = 1; ks < 4; ++ks) x = __builtin_amdgcn_mfma_f32_32x32x16_bf16(ak[ks], bq[ks], x, 0, 0, 0);
            x = __builtin_amdgcn_mfma_f32_32x32x16_bf16(__builtin_bit_cast(bf16x8, aau), __builtin_bit_cast(bf16x8, bau), x, 0, 0, 0);
            asm volatile("s_nop 11" : "+v"(x));
            float lmax = max3f_(x[0], x[1], x[2]), lmx2 = max3f_(x[3], x[4], x[5]);
            lmax = max3f_(lmax, x[6], x[7]); lmx2 = max3f_(lmx2, x[8], x[9]); lmax = max3f_(lmax, x[10], x[11]); lmx2 = max3f_(lmx2, x[12], x[13]); lmax = max3f_(lmax, x[14], x[15]); lmax = max3f_(lmax, lmx2, lmx2);
            lmax = fmaxf(lmax, __shfl_xor(lmax, 32));
            const bool need = anch ? (lmax > 8.f) : (lmax > -30000.f);
            if (__any(need)) {
                const float dl = need ? lmax : 0.f, f = (need && anch) ? __builtin_amdgcn_exp2f(-dl) : 1.f;
                mref += dl; lsum *= f; anch = anch || need;
#pragma unroll
                for (int i = 0; i < 16; ++i) { x[i] -= dl; oacc[0][i] *= f; oacc[1][i] *= f; }
                AT_MPIECES(mref);
            }
            unsigned pw[8];
#pragma unroll
            for (int i = 0; i < 16; i += 2) { const float e0 = __builtin_amdgcn_exp2f(x[i]), e1 = __builtin_amdgcn_exp2f(x[i + 1]); lsum += e0 + e1; pw[i >> 1] = pk2(e0, e1); }
            const u32x4 pf0 = {pw[0], pw[1], pw[2], pw[3]}, pf1 = {pw[4], pw[5], pw[6], pw[7]};
#pragma unroll
            for (int dt = 0; dt < 2; ++dt) {
                const bf16x8 av0 = *(const LAS bf16x8*)(vimg + jj * 4096 + offv[dt][0]), av1 = *(const LAS bf16x8*)(vimg + jj * 4096 + offv[dt][1]);
                oacc[dt] = __builtin_amdgcn_mfma_f32_32x32x16_bf16(av0, __builtin_bit_cast(bf16x8, pf0), oacc[dt], 0, 0, 0);
                oacc[dt] = __builtin_amdgcn_mfma_f32_32x32x16_bf16(av1, __builtin_bit_cast(bf16x8, pf1), oacc[dt], 0, 0, 0); }
        }
        asm volatile("s_waitcnt vmcnt(0)" ::: "memory"); __syncthreads();
    }
    }
#undef AT_STAGE2
#undef AT_MPIECES
    { const float inv = __builtin_amdgcn_rcpf(lsum + __shfl_xor(lsum, 32)); const size_t mrow = (m0w + qlc) * 512 + hd * 64;
#pragma unroll
      for (int dt = 0; dt < 2; ++dt)
#pragma unroll
          for (int g4 = 0; g4 < 4; ++g4) { const int d0 = 32 * dt + 8 * g4 + 4 * half; const u32x2 zz = *(const u32x2*)(az + mrow + d0);
              const float y0 = oacc[dt][4 * g4 + 0] * inv * siluf_(bflo(zz.x)), y1 = oacc[dt][4 * g4 + 1] * inv * siluf_(bfhi(zz.x)), y2 = oacc[dt][4 * g4 + 2] * inv * siluf_(bflo(zz.y)), y3 = oacc[dt][4 * g4 + 3] * inv * siluf_(bfhi(zz.y));
              u32x2 o; o.x = pk2(y0, y1); o.y = pk2(y2, y3); *(u32x2*)(yb + mrow + d0) = o; } }
}
__device__ __forceinline__ void p2_attn(Frame& F) {
    const int b = F.vcu >> 4, r = F.vcu & 15;
    for (int i = 0; i < 4; ++i) { const int qb = (i == 0) ? r : (i == 1) ? 31 - r : (i == 2) ? 32 + r : 63 - r;
        unsigned mA[2], mB[2];
        attn_pass1_select(F, b, qb, F.lds + RING_OFF, mA, mB);
        attn_pass2(F, b, qb, F.lds + RING_OFF, mA, mB);
    }
}

__device__ __forceinline__ void p6_final(Frame& F) {
    float* out = F.out; const float* ssp2 = (const float*)(F.ws + WS_SSP2); const float* fg = F.in[14];
    int tid_ = threadIdx.x; asm volatile("" : "+v"(tid_));
    const int lane = tid_ & 63, gw = F.vcu * NWAVES + __builtin_amdgcn_readfirstlane(tid_ >> 6), NGW = F.G * NWAVES;
#ifdef SELCHECK
    const float poison = (*(volatile unsigned*)(F.ws + WS_CTL + 8192)) ? __builtin_nanf("") : 1.f;
#else
    const float poison = 1.f;
#endif
    for (int m = gw; m < M; m += NGW) { float s = (lane < 16) ? ssp2[(size_t)m * 16 + lane] : 0.f; s = wave_sum(s);
        const float r = rsqrtf(s * (1.f / D) + EPS) * poison; f32x4* o = (f32x4*)(out + (size_t)m * D) + lane;
#pragma unroll
        for (int j = 0; j < 4; ++j) { const f32x4 gv = ((const f32x4*)fg)[lane + 64 * j]; f32x4 v = o[64 * j]; v = v * r * gv; o[64 * j] = v; } }
}

#ifndef REP_P0
#define REP_P0 1
#endif
#ifndef REP_P1
#define REP_P1 1
#endif
#ifndef REP_P2A
#define REP_P2A 1
#endif
#ifndef REP_P2B
#define REP_P2B 1
#endif
#ifndef REP_P4
#define REP_P4 1
#endif
struct Args { const float* in[15]; float* out; unsigned char* ws; };
__global__ void __launch_bounds__(NWAVES * 64, 2) fwd_kernel(Args args) {
    extern __shared__ __attribute__((aligned(16))) unsigned char lds_raw[];
    Frame F;
    F.lds = (LAS unsigned char*)lds_raw; F.MISC = (volatile LAS unsigned*)(F.lds + MISC_OFF);
    F.tid = threadIdx.x; F.lane = F.tid & 63; F.wave = __builtin_amdgcn_readfirstlane(F.tid >> 6);
    F.G = gridDim.x; { const int bx = blockIdx.x; F.vcu = (F.G % 8 == 0) ? (bx % 8) * (F.G / 8) + bx / 8 : bx; }
#pragma unroll
    for (int i = 0; i < 15; ++i) F.in[i] = args.in[i];
    F.out = args.out; F.ws = args.ws;
    unsigned char* ws = args.ws;
    for (int u = F.tid; u < (LDS_BYTES - LDSCTL_OFF) / 4; u += NWAVES * 64) ((LAS unsigned*)(F.lds + LDSCTL_OFF))[u] = 0u;
    __syncthreads();
    XcdBarrier bar = xcd_barrier_post((unsigned*)(ws + WS_CTL) + CW_BAR, F.MISC + 8);

    for (int rep_ = 0; rep_ < REP_P0; ++rep_) { p0_prep(F); if (rep_ + 1 < REP_P0) __syncthreads(); }
    xcd_barrier(bar);
    { pg8::Gemm g{(const bf16_t*)(ws + WS_XB), (const bf16_t*)(ws + WS_WIN), M, NINP, D}; pg8::StaticOrder S; S.init(M, NINP, F.G, (int)blockIdx.x);
      pg8::EpiInProj E{(const float*)(ws + WS_RINV), ws};
      for (int rep_ = 0; rep_ < REP_P1; ++rep_) pg8::gemm_phase<pg8::EpiInProj, pg8::StaticOrder, true, true>(F.lds + RING_OFF, g, S, E);
    }
    xcd_barrier(bar);
    for (int rep_ = 0; rep_ < REP_P2A; ++rep_) p2_conformer(F);
    for (int rep_ = 0; rep_ < REP_P2B; ++rep_) p2_attn(F);
    xcd_barrier(bar);
    { pg8::Gemm g{(const bf16_t*)(ws + WS_YA), (const bf16_t*)(ws + WS_WA), M, D, DC}; pg8::StaticOrder S; S.init(M, D, F.G, (int)blockIdx.x);
      pg8::EpiOutA E{(const bf16_t*)(ws + WS_GA), F.out};
      pg8::gemm_phase<pg8::EpiOutA, pg8::StaticOrder, true, true>(F.lds + RING_OFF, g, S, E);
    }
    { pg8::Gemm g{(const bf16_t*)(ws + WS_YB), (const bf16_t*)(ws + WS_WB), M, D, DC}; pg8::StaticOrder S; S.init(M, D, F.G, (int)blockIdx.x);
      pg8::EpiOutB E{(const bf16_t*)(ws + WS_GB), F.out, (bf16_t*)(ws + WS_MRG)};
      pg8::gemm_phase<pg8::EpiOutB, pg8::StaticOrder, true, true>(F.lds + RING_OFF, g, S, E);
    }
    xcd_barrier(bar);
    { pg8::Gemm g{(const bf16_t*)(ws + WS_MRG), (const bf16_t*)(ws + WS_WO), M, D, D}; pg8::StaticOrder S; S.init(M, D, F.G, (int)blockIdx.x);
      pg8::EpiWo E{F.in[0], F.out, (bf16_t*)(ws + WS_X1B), (float*)(ws + WS_SSP1)};
      for (int rep_ = 0; rep_ < REP_P4; ++rep_) pg8::gemm_phase<pg8::EpiWo, pg8::StaticOrder, true, true>(F.lds + RING_OFF, g, S, E);
    }
    xcd_barrier(bar);
    { pg8::Gemm g{(const bf16_t*)(ws + WS_PB), (const bf16_t*)(ws + WS_WP), M, D, DPLE}; pg8::StaticOrder S; S.init(M, D, F.G, (int)blockIdx.x);
      pg8::EpiPP E{(bf16_t*)(ws + WS_PP)};
      pg8::gemm_phase<pg8::EpiPP, pg8::StaticOrder, true, true>(F.lds + RING_OFF, g, S, E);
    }
    __builtin_amdgcn_sched_barrier(0); asm volatile("" ::: "memory");
    { pg8::Gemm g{(const bf16_t*)(ws + WS_X1B), (const bf16_t*)(ws + WS_WG), M, D, D}; pg8::StaticOrder S; S.init(M, D, F.G, (int)blockIdx.x);
      pg8::EpiGate E{F.out, (const bf16_t*)(ws + WS_PP), (const float*)(ws + WS_SSP1), (float*)(ws + WS_SSP2)};
      pg8::gemm_phase<pg8::EpiGate, pg8::StaticOrder, true, true>(F.lds + RING_OFF, g, S, E);
    }
    xcd_barrier(bar);
    p6_final(F);
}

extern "C" void kernel_launch(void* const* d_in, const int* in_sizes, int n_in, void* d_out, int out_size, void* d_ws, size_t ws_size, hipStream_t stream) {
    static int grid = 0;
    if (grid == 0) {
        if (n_in != 15 || out_size != M * D || ws_size < WS_END) { fprintf(stderr, "kernel_launch: unexpected sizes n_in %d out %d ws %zu\n", n_in, out_size, ws_size); grid = -1; return; }
        int dev = 0, cus = 0, per_cu = 0;
        if (hipGetDevice(&dev) != hipSuccess || hipDeviceGetAttribute(&cus, hipDeviceAttributeMultiprocessorCount, dev) != hipSuccess) { grid = -1; return; }
        if (hipFuncSetAttribute((const void*)fwd_kernel, hipFuncAttributeMaxDynamicSharedMemorySize, LDS_BYTES) != hipSuccess) { fprintf(stderr, "kernel_launch: hipFuncSetAttribute failed\n"); grid = -1; return; }
        if (hipOccupancyMaxActiveBlocksPerMultiprocessor(&per_cu, (const void*)fwd_kernel, NWAVES * 64, LDS_BYTES) != hipSuccess || per_cu < 1) { fprintf(stderr, "kernel_launch: occupancy query reports %d blocks per CU\n", per_cu); (void)hipGetLastError(); grid = -1; return; }
        grid = cus;
        if (M % grid != 0 || grid % 8 != 0) { fprintf(stderr, "kernel_launch: unsupported CU count %d\n", grid); grid = -1; return; }
    }
    if (grid < 0) return;
    (void)hipMemsetAsync((char*)d_ws + WS_CTL, 0, CTL_ZERO_BYTES, stream);
    Args a{};
    for (int i = 0; i < 15; ++i) a.in[i] = (const float*)d_in[i];
    a.out = (float*)d_out; a.ws = (unsigned char*)d_ws;
    hipLaunchKernelGGL(fwd_kernel, dim3(grid), dim3(NWAVES * 64), LDS_BYTES, stream, a);
}
```

```cpp
#include <hip/hip_runtime.h>
#include <cstdint>
#include <cstdio>

typedef unsigned short bf16_t;
typedef float f32x4 __attribute__((ext_vector_type(4)));
typedef unsigned u32x4 __attribute__((ext_vector_type(4)));
typedef unsigned u32x2 __attribute__((ext_vector_type(2)));
#define GAS __attribute__((address_space(1)))
#define LAS __attribute__((address_space(3)))
#define LDS_WAIT() asm volatile("s_waitcnt lgkmcnt(0)" ::: "memory")
#define VM_WAIT() asm volatile("s_waitcnt vmcnt(0)" ::: "memory")

constexpr int NB = 16, SEQ = 2048, D = 1024, M = NB * SEQ;
constexpr int DPLE = 256, DC = 512, CWID = 31, NH = 8, HD = 64, TOPK = 256;
constexpr int NIN = 5320, NINP = 5376;
constexpr float EPS = 1e-6f;

constexpr size_t MiB = 1u << 20;
constexpr size_t WS_CTL = 0;
constexpr size_t CTL_ZERO_BYTES = 64 * 1024;
constexpr int CW_BAR = 4096;
constexpr size_t WS_WIN = 2 * MiB;
constexpr size_t WS_WA = 13 * MiB;
constexpr size_t WS_WB = 14 * MiB;
constexpr size_t WS_WO = 15 * MiB;
constexpr size_t WS_WG = 17 * MiB;
constexpr size_t WS_WP = 19 * MiB;
constexpr size_t WS_RINV = 20 * MiB;
constexpr size_t WS_SSP1 = 22 * MiB;
constexpr size_t WS_SSP2 = 24 * MiB;
constexpr size_t WS_VT = 26 * MiB;
constexpr size_t WS_XB = 32 * MiB;
constexpr size_t WS_YA = 32 * MiB, WS_YB = 64 * MiB;
constexpr size_t WS_PB = 96 * MiB;
constexpr size_t WS_CIN = 112 * MiB;
constexpr size_t WS_MRG = 112 * MiB;
constexpr size_t WS_CZ = 176 * MiB;
constexpr size_t WS_Q = 208 * MiB;
constexpr size_t WS_X1B = 176 * MiB;
constexpr size_t WS_PART = 176 * MiB;
constexpr size_t WS_X2B = 32 * MiB;
constexpr size_t WS_AZ = 240 * MiB;
constexpr size_t WS_IQ = 272 * MiB;
constexpr size_t WS_SM = 304 * MiB;
constexpr size_t WS_GA = 320 * MiB;
constexpr size_t WS_PP = 320 * MiB;
constexpr size_t WS_GB = 384 * MiB;
constexpr size_t WS_END = 448 * MiB;

__device__ __forceinline__ float bf2f(bf16_t h) { return __uint_as_float(((unsigned)h) << 16); }
typedef float f32x2_t __attribute__((ext_vector_type(2))); typedef __bf16 bf16x2_t __attribute__((ext_vector_type(2)));
__device__ __forceinline__ unsigned pk2(float lo, float hi) { const f32x2_t v = {lo, hi}; const bf16x2_t b = __builtin_convertvector(v, bf16x2_t); return __builtin_bit_cast(unsigned, b); }
__device__ __forceinline__ bf16_t f2bf(float f) { return (bf16_t)(pk2(f, 0.f) & 0xffffu); }
__device__ __forceinline__ float bflo(unsigned w) { return __uint_as_float(w << 16); }
__device__ __forceinline__ float bfhi(unsigned w) { return __uint_as_float(w & 0xffff0000u); }
__device__ __forceinline__ float sigmoidf_(float x) { return __builtin_amdgcn_rcpf(1.f + __builtin_amdgcn_exp2f(-1.4426950408889634f * x)); }
__device__ __forceinline__ float siluf_(float x) { return x * sigmoidf_(x); }
__device__ __forceinline__ float wave_sum(float v) {
#pragma unroll
    for (int o = 1; o < 64; o <<= 1) v += __shfl_xor(v, o);
    return v;
}

__host__ __device__ __forceinline__ int inmap(int n) {
    if (n < 2048) return n;
    if (n < 2560) return 2176 + (n - 2048);
    if (n < 3072) return 2688 + (n - 2560);
    if (n < 3328) { const int j = n - 3072;
        if (j < 64) return 2048 + j; if (j < 128) return 2112 + (j - 64); if (j < 192) return 3200 + (j - 128); if (j < 200) return 3264 + (j - 192); return -1; }
    if (n < 4352) return 3272 + (n - 3328);
    return 4296 + (n - 4352);
}
namespace pg8 {
#define PG8_LAS __attribute__((address_space(3)))
typedef unsigned short bf16_t;
typedef short bf16x8 __attribute__((ext_vector_type(8)));
typedef float f32x4 __attribute__((ext_vector_type(4)));
typedef unsigned u32x4 __attribute__((ext_vector_type(4)));
constexpr int BM = 256, BK = 64, HALF = 128, HTB = HALF * BK * 2  , STAGE_BYTES = 8 * HTB, NXCD = 8, WGM = 8;

__host__ __device__ __forceinline__ int lds_byte(int r, int c) { const int st = (r >> 4) * 2 + (c >> 5), rr = r & 15, cc = c & 31, ob = rr * 64 + cc * 2; return st * 1024 + (ob ^ (((ob >> 9) & 1) << 5)); }
__host__ __device__ __forceinline__ void stage_rc(int b, int& R, int& C) { const int st = b / 1024, sb = b % 1024, swz = sb ^ (((sb >> 9) & 1) << 5); R = (st >> 1) * 16 + swz / 64; C = (st & 1) * 32 + (swz % 64) / 2; }
__host__ __device__ __forceinline__ int perm32(int rho) { const int n = rho >> 4, i = rho & 15; return 8 * (i >> 2) + 4 * n + (i & 3); }

struct Unit { int pm, pn; };
struct Gemm { const bf16_t* A; const bf16_t* Bt; int M, N, K; };

struct StaticOrder {
    int nM, nN, nwg, G, c;
    __host__ __device__ void init(int M, int N, int G_, int c_) { nM = M / BM; nN = N / BM; nwg = nM * nN; G = G_; c = c_; }
    __host__ __device__ bool next(int i, Unit& u) const {
        const long L = (long)i * G + c; if (L >= nwg) return false;
        int wgid = (int)L; { const int q = nwg / NXCD, r = nwg % NXCD, xcd = wgid % NXCD, off = wgid / NXCD; wgid = (xcd < r ? xcd * (q + 1) : r * (q + 1) + (xcd - r) * q) + off; }
        const int nig = WGM * nN, gid = wgid / nig, fm = gid * WGM, gsz = (nM - fm) < WGM ? (nM - fm) : WGM;
        u.pm = fm + ((wgid % nig) % gsz); u.pn = (wgid % nig) / gsz; return true;
    }
    __device__ __forceinline__ void a_ready(const Unit&) const {}
    __device__ __forceinline__ void done(const Unit&) const {}
};
__device__ __forceinline__ unsigned cvt_pk_bf16(float lo, float hi) { unsigned r; asm volatile("v_cvt_pk_bf16_f32 %0, %1, %2" : "=v"(r) : "v"(lo), "v"(hi)); return r; }
struct EpiInProj {
    static constexpr bool PERM = true, AFTER_DRAIN = false;
    const float* rinv; unsigned char* ws;
    __device__ __forceinline__ void operator()(const f32x4 (&acc)[2][2][4][2], const Unit& u, int wr, int wc, int fr, int fq) const {
        size_t off; int ld, colt; const int pn = u.pn;
        if (pn < 4) { off = WS_CIN; ld = 1024; colt = pn * 256; }
        else if (pn < 6) { off = WS_CZ; ld = 512; colt = (pn - 4) * 256; }
        else if (pn < 8) { off = WS_Q; ld = 512; colt = (pn - 6) * 256; }
        else if (pn < 10) { off = WS_AZ; ld = 512; colt = (pn - 8) * 256; }
        else if (pn < 12) { off = WS_IQ; ld = 512; colt = (pn - 10) * 256; }
        else if (pn < 13) { off = WS_SM; ld = 256; colt = 0; }
        else if (pn < 17) { off = WS_GA; ld = 1024; colt = (pn - 13) * 256; }
        else { off = WS_GB; ld = 1024; colt = (pn - 17) * 256; }
        bf16_t* base = (bf16_t*)(ws + off);
        const float qs = (pn == 6 || pn == 7) ? 0.125f * 1.4426950408889634f : 1.f;
        const int row0 = u.pm * BM + wr * 64 + fr, col0 = colt + wc * 32 + 8 * fq;
#pragma unroll
        for (int ai = 0; ai < 2; ++ai)
#pragma unroll
            for (int m = 0; m < 4; ++m) { const int row = row0 + ai * HALF + m * 16; const float r = rinv[row] * qs; bf16_t* rowp = base + (size_t)row * ld + col0;
#pragma unroll
                for (int bj = 0; bj < 2; ++bj) { const f32x4 v0 = acc[ai][bj][m][0] * r, v1 = acc[ai][bj][m][1] * r;
                    u32x4 w; w.x = cvt_pk_bf16(v0[0], v0[1]); w.y = cvt_pk_bf16(v0[2], v0[3]); w.z = cvt_pk_bf16(v1[0], v1[1]); w.w = cvt_pk_bf16(v1[2], v1[3]);
                    *(u32x4*)(rowp + bj * HALF) = w; } }
        if (pn == 12 && wc >= 2) {
            bf16_t* vt = (bf16_t*)(ws + WS_VT); const int d0 = (wc - 2) * 32 + 8 * fq;
#pragma unroll
            for (int ai = 0; ai < 2; ++ai)
#pragma unroll
                for (int m = 0; m < 4; ++m) { const int row = row0 + ai * HALF + m * 16; const float r = rinv[row]; const int bb = row >> 11, sq = row & 2047, k5 = sq & 31;
                    const int pos = (sq & ~31) + ((k5 & 0x13) | ((k5 & 4) << 1) | ((k5 & 8) >> 1)); bf16_t* vp = vt + ((size_t)bb * 64 + d0) * 2048 + pos;
                    const f32x4 v0 = acc[ai][0][m][0] * r, v1 = acc[ai][0][m][1] * r;
#pragma unroll
                    for (int e = 0; e < 4; ++e) { vp[(size_t)e * 2048] = f2bf(v0[e]); vp[(size_t)(4 + e) * 2048] = f2bf(v1[e]); } }
        }
    }
};
__device__ __forceinline__ f32x4 sig4lo(unsigned a, unsigned b) { return (f32x4){sigmoidf_(bflo(a)), sigmoidf_(bfhi(a)), sigmoidf_(bflo(b)), sigmoidf_(bfhi(b))}; }
struct EpiOutA {
    static constexpr bool PERM = true, AFTER_DRAIN = false;
    const bf16_t* ga; bf16_t* part;
    __device__ __forceinline__ void operator()(const f32x4 (&acc)[2][2][4][2], const Unit& u, int wr, int wc, int fr, int fq) const {
        const int row0 = u.pm * BM + wr * 64 + fr, col0 = u.pn * BM + wc * 32 + 8 * fq;
#pragma unroll
        for (int ai = 0; ai < 2; ++ai)
#pragma unroll
            for (int m = 0; m < 4; ++m) { const size_t idx = (size_t)(row0 + ai * HALF + m * 16) * D + col0;
#pragma unroll
                for (int bj = 0; bj < 2; ++bj) { const u32x4 g = *(const u32x4*)(ga + idx + bj * HALF);
                    const f32x4 v0 = sig4lo(g.x, g.y) * acc[ai][bj][m][0], v1 = sig4lo(g.z, g.w) * acc[ai][bj][m][1];
                    u32x4 w; w.x = cvt_pk_bf16(v0[0], v0[1]); w.y = cvt_pk_bf16(v0[2], v0[3]); w.z = cvt_pk_bf16(v1[0], v1[1]); w.w = cvt_pk_bf16(v1[2], v1[3]);
                    *(u32x4*)(part + idx + bj * HALF) = w; } }
    }
};
__device__ __forceinline__ f32x4 bf4lo(unsigned a, unsigned b) { return (f32x4){bflo(a), bfhi(a), bflo(b), bfhi(b)}; }
struct EpiOutB {
    static constexpr bool PERM = true, AFTER_DRAIN = false;
    const bf16_t* gb; const bf16_t* part; bf16_t* mrg;
    __device__ __forceinline__ void operator()(const f32x4 (&acc)[2][2][4][2], const Unit& u, int wr, int wc, int fr, int fq) const {
        const int row0 = u.pm * BM + wr * 64 + fr, col0 = u.pn * BM + wc * 32 + 8 * fq;
#pragma unroll
        for (int ai = 0; ai < 2; ++ai)
#pragma unroll
            for (int m = 0; m < 4; ++m) { const size_t idx = (size_t)(row0 + ai * HALF + m * 16) * D + col0;
#pragma unroll
                for (int bj = 0; bj < 2; ++bj) { const u32x4 g = *(const u32x4*)(gb + idx + bj * HALF), pw = *(const u32x4*)(part + idx + bj * HALF);
                    const f32x4 v0 = bf4lo(pw.x, pw.y) + sig4lo(g.x, g.y) * acc[ai][bj][m][0], v1 = bf4lo(pw.z, pw.w) + sig4lo(g.z, g.w) * acc[ai][bj][m][1];
                    u32x4 w; w.x = cvt_pk_bf16(v0[0], v0[1]); w.y = cvt_pk_bf16(v0[2], v0[3]); w.z = cvt_pk_bf16(v1[0], v1[1]); w.w = cvt_pk_bf16(v1[2], v1[3]);
                    *(u32x4*)(mrg + idx + bj * HALF) = w; } }
    }
};
__device__ __forceinline__ float sq4(const f32x4 v) { return (v[0] * v[0] + v[1] * v[1]) + (v[2] * v[2] + v[3] * v[3]); }
struct EpiWo {
    static constexpr bool PERM = true, AFTER_DRAIN = false;
    const float* x; bf16_t* x1b; float* ssp;
    __device__ __forceinline__ void operator()(const f32x4 (&acc)[2][2][4][2], const Unit& u, int wr, int wc, int fr, int fq) const {
        const int row0 = u.pm * BM + wr * 64 + fr, col0 = u.pn * BM + wc * 32 + 8 * fq;
#pragma unroll
        for (int ai = 0; ai < 2; ++ai)
#pragma unroll
            for (int m = 0; m < 4; ++m) { const int row = row0 + ai * HALF + m * 16; const size_t idx = (size_t)row * D + col0; float s = 0.f;
#pragma unroll
                for (int bj = 0; bj < 2; ++bj) { const f32x4 v0 = *(const f32x4*)(x + idx + bj * HALF) + acc[ai][bj][m][0], v1 = *(const f32x4*)(x + idx + bj * HALF + 4) + acc[ai][bj][m][1];
                    s += sq4(v0) + sq4(v1);
                    u32x4 w; w.x = cvt_pk_bf16(v0[0], v0[1]); w.y = cvt_pk_bf16(v0[2], v0[3]); w.z = cvt_pk_bf16(v1[0], v1[1]); w.w = cvt_pk_bf16(v1[2], v1[3]);
                    *(u32x4*)(x1b + idx + bj * HALF) = w; }
                s += __shfl_xor(s, 16); s += __shfl_xor(s, 32);
                if (fq == 0) ssp[(size_t)row * 16 + u.pn * 4 + wc] = s; }
    }
};
struct EpiPP {
    static constexpr bool PERM = true, AFTER_DRAIN = false;
    bf16_t* pp;
    __device__ __forceinline__ void operator()(const f32x4 (&acc)[2][2][4][2], const Unit& u, int wr, int wc, int fr, int fq) const {
        const int row0 = u.pm * BM + wr * 64 + fr, col0 = u.pn * BM + wc * 32 + 8 * fq;
#pragma unroll
        for (int ai = 0; ai < 2; ++ai)
#pragma unroll
            for (int m = 0; m < 4; ++m) { const size_t idx = (size_t)(row0 + ai * HALF + m * 16) * D + col0;
#pragma unroll
                for (int bj = 0; bj < 2; ++bj) { const f32x4 v0 = acc[ai][bj][m][0], v1 = acc[ai][bj][m][1];
                    u32x4 w; w.x = cvt_pk_bf16(v0[0], v0[1]); w.y = cvt_pk_bf16(v0[2], v0[3]); w.z = cvt_pk_bf16(v1[0], v1[1]); w.w = cvt_pk_bf16(v1[2], v1[3]);
                    *(u32x4*)(pp + idx + bj * HALF) = w; } }
    }
};
struct EpiGate {
    static constexpr bool PERM = true, AFTER_DRAIN = false;
    const bf16_t* x1b; const bf16_t* pp; bf16_t* x2b; const float* ssp1; float* ssp2;
    __device__ __forceinline__ void operator()(const f32x4 (&acc)[2][2][4][2], const Unit& u, int wr, int wc, int fr, int fq) const {
        const int row0 = u.pm * BM + wr * 64 + fr, col0 = u.pn * BM + wc * 32 + 8 * fq;
#pragma unroll
        for (int ai = 0; ai < 2; ++ai)
#pragma unroll
            for (int m = 0; m < 4; ++m) { const int row = row0 + ai * HALF + m * 16; const size_t idx = (size_t)row * D + col0;
                const f32x4* sp = (const f32x4*)(ssp1 + (size_t)row * 16); const f32x4 t4 = (sp[0] + sp[1]) + (sp[2] + sp[3]);
                const float r1 = rsqrtf(((t4[0] + t4[1]) + (t4[2] + t4[3])) * (1.f / D) + EPS); float s = 0.f;
#pragma unroll
                for (int bj = 0; bj < 2; ++bj) { const u32x4 pw = *(const u32x4*)(pp + idx + bj * HALF), xw = *(const u32x4*)(x1b + idx + bj * HALF); const f32x4 a0 = acc[ai][bj][m][0] * r1, a1 = acc[ai][bj][m][1] * r1;
                    const f32x4 g0 = (f32x4){sigmoidf_(a0[0]), sigmoidf_(a0[1]), sigmoidf_(a0[2]), sigmoidf_(a0[3])}, g1 = (f32x4){sigmoidf_(a1[0]), sigmoidf_(a1[1]), sigmoidf_(a1[2]), sigmoidf_(a1[3])};
                    const f32x4 v0 = bf4lo(xw.x, xw.y) + g0 * bf4lo(pw.x, pw.y), v1 = bf4lo(xw.z, xw.w) + g1 * bf4lo(pw.z, pw.w);
                    s += sq4(v0) + sq4(v1);
                    u32x4 w; w.x = cvt_pk_bf16(v0[0], v0[1]); w.y = cvt_pk_bf16(v0[2], v0[3]); w.z = cvt_pk_bf16(v1[0], v1[1]); w.w = cvt_pk_bf16(v1[2], v1[3]);
                    *(u32x4*)(x2b + idx + bj * HALF) = w; }
                s += __shfl_xor(s, 16); s += __shfl_xor(s, 32);
                if (fq == 0) ssp2[(size_t)row * 16 + u.pn * 4 + wc] = s; }
    }
};
template <class Epi, class Sched, bool ALIGN_EPI = false, bool SP2 = false>
__device__ __forceinline__ void gemm_phase(PG8_LAS unsigned char* lds, const Gemm g, const Sched& S, const Epi& E) {
    int tid_ = threadIdx.x; asm volatile("" : "+v"(tid_));
    const int tid = tid_, wid = __builtin_amdgcn_readfirstlane(tid >> 6), lane = tid & 63, wr = wid >> 2, wc = wid & 3, fr = lane & 15, fq = lane >> 4;
    int K_ = g.K; asm volatile("" : "+s"(K_));
    const int K = K_, nt = K / BK;
    unsigned voffA[2], voffB[2];
#pragma unroll
    for (int i = 0; i < 2; ++i) { int R, C; stage_rc(tid * 16 + i * 8192, R, C); const int Rb = Epi::PERM ? ((R & ~31) + perm32(R & 31)) : R;
        voffA[i] = (unsigned)(R * K + C) * 2u; voffB[i] = (unsigned)(Rb * K + C) * 2u; }
    const size_t kstep = (size_t)(BK * 2);
    const size_t hstep = (size_t)HALF * K * 2;
    const size_t tstep = 2 * hstep;
    const unsigned ldsw = (unsigned)wid * 1024u;
    const int aoff = lds_byte(wr * 64 + fr, fq * 8), boff = lds_byte(wc * 32 + fr, fq * 8);
#define PG8_SA(b, h) (((b) * 2 + (h)) * HTB)
#define PG8_SB(b, h) ((4 + (b) * 2 + (h)) * HTB)
#define PG8_STAGE(bufoff, gbase, voff) do { _Pragma("unroll") for (int _i = 0; _i < 2; ++_i) \
        __builtin_amdgcn_global_load_lds((const unsigned*)((const char*)(gbase) + (voff)[_i]), (PG8_LAS unsigned*)(lds + (bufoff) + ldsw + _i * 8192), 16, 0, 0); } while (0)
#define PG8_LDA(dst, b, h) do { _Pragma("unroll") for (int m = 0; m < 4; ++m) _Pragma("unroll") for (int k = 0; k < 2; ++k) dst[m][k] = *(const PG8_LAS bf16x8*)(lds + PG8_SA(b, h) + aoff + m * 2048 + k * 1024); } while (0)
#define PG8_LDB(dst, b, h) do { _Pragma("unroll") for (int n = 0; n < 2; ++n) _Pragma("unroll") for (int k = 0; k < 2; ++k) dst[n][k] = *(const PG8_LAS bf16x8*)(lds + PG8_SB(b, h) + boff + n * 2048 + k * 1024); } while (0)
#define PG8_MMA(ai, bj, At, Bt) do { __builtin_amdgcn_s_setprio(1); _Pragma("unroll") for (int m = 0; m < 4; ++m) _Pragma("unroll") for (int n = 0; n < 2; ++n) _Pragma("unroll") for (int k = 0; k < 2; ++k) \
        acc[ai][bj][m][n] = __builtin_amdgcn_mfma_f32_16x16x32_bf16(Bt[n][k], At[m][k], acc[ai][bj][m][n], 0, 0, 0); __builtin_amdgcn_s_setprio(0); } while (0)
#define PG8_WAIT_V(n) asm volatile("s_waitcnt vmcnt(" #n ")" ::: "memory")
#define PG8_WAIT_L(n) asm volatile("s_waitcnt lgkmcnt(" #n ")" ::: "memory")
#define PG8_BAR __builtin_amdgcn_s_barrier()
#define PG8_SCHED __builtin_amdgcn_sched_barrier(0)
    Unit cur, nxt; int ui = 0;
    if (!S.next(0, cur)) return;
    f32x4 acc[2][2][4][2];
#pragma unroll
    for (int a = 0; a < 2; ++a)
#pragma unroll
        for (int b = 0; b < 2; ++b)
#pragma unroll
            for (int m = 0; m < 4; ++m)
#pragma unroll
                for (int n = 0; n < 2; ++n) acc[a][b][m][n] = (f32x4){0.f, 0.f, 0.f, 0.f};
    bf16x8 At[4][2], B0[2][2], B1[2][2];
    const char* cA = (const char*)g.A + (size_t)cur.pm * tstep; const char* cB = (const char*)g.Bt + (size_t)cur.pn * tstep;
    S.a_ready(cur);
    if constexpr (SP2) {
        PG8_STAGE(PG8_SB(0, 0), cB, voffB); PG8_STAGE(PG8_SB(0, 1), cB + hstep, voffB); PG8_STAGE(PG8_SA(0, 0), cA, voffA); PG8_STAGE(PG8_SA(0, 1), cA + hstep, voffA);
        if (wr == 1) PG8_BAR;
        PG8_WAIT_V(2); PG8_BAR;
        PG8_STAGE(PG8_SB(1, 0), cB + kstep, voffB); PG8_STAGE(PG8_SA(1, 0), cA + kstep, voffA); PG8_STAGE(PG8_SB(1, 1), cB + hstep + kstep, voffB);
        PG8_WAIT_V(6); PG8_BAR;
    } else {
        PG8_STAGE(PG8_SB(0, 0), cB, voffB); PG8_STAGE(PG8_SA(0, 0), cA, voffA); PG8_STAGE(PG8_SB(0, 1), cB + hstep, voffB); PG8_STAGE(PG8_SA(0, 1), cA + hstep, voffA);
        if (wr == 1) PG8_BAR;
        PG8_WAIT_V(4); PG8_BAR;
        PG8_STAGE(PG8_SB(1, 0), cB + kstep, voffB); PG8_STAGE(PG8_SA(1, 0), cA + kstep, voffA); PG8_STAGE(PG8_SB(1, 1), cB + hstep + kstep, voffB);
        PG8_WAIT_V(6); PG8_BAR;
    }
    for (;;) {
        const bool has_next = S.next(ui + 1, nxt);
        const char* nA = has_next ? (const char*)g.A + (size_t)nxt.pm * tstep : cA; const char* nB = has_next ? (const char*)g.Bt + (size_t)nxt.pn * tstep : cB;
        for (int t = 0; t < nt; t += 2) {
            const bool last = (t == nt - 2);
            const char* a1 = cA + (size_t)(t + 1) * kstep;
            const char* a2 = last ? nA : cA + (size_t)(t + 2) * kstep; const char* b2 = last ? nB : cB + (size_t)(t + 2) * kstep;
            const char* a3 = a2 + kstep; const char* b3 = b2 + kstep;
            if (last && has_next) S.a_ready(nxt);
            if constexpr (SP2) {
            PG8_LDB(B0, 0, 0); PG8_LDB(B1, 0, 1); PG8_SCHED; PG8_LDA(At, 0, 0); PG8_STAGE(PG8_SA(1, 1), a1 + hstep, voffA);
            PG8_WAIT_V(8); PG8_WAIT_L(0); PG8_BAR; PG8_MMA(0, 0, At, B0); PG8_MMA(0, 1, At, B1); PG8_BAR; PG8_SCHED;
            PG8_LDA(At, 0, 1); PG8_STAGE(PG8_SB(0, 0), b2, voffB); PG8_STAGE(PG8_SB(0, 1), b2 + hstep, voffB); PG8_STAGE(PG8_SA(0, 0), a2, voffA);
            PG8_WAIT_V(8); PG8_WAIT_L(0); PG8_BAR; PG8_MMA(1, 0, At, B0); PG8_MMA(1, 1, At, B1); PG8_BAR; PG8_SCHED;
            PG8_LDB(B0, 1, 0); PG8_LDB(B1, 1, 1); PG8_SCHED; PG8_LDA(At, 1, 0); PG8_STAGE(PG8_SA(0, 1), a2 + hstep, voffA);
            PG8_WAIT_V(8); PG8_WAIT_L(0); PG8_BAR; PG8_MMA(0, 0, At, B0); PG8_MMA(0, 1, At, B1); PG8_BAR; PG8_SCHED;
            PG8_LDA(At, 1, 1); PG8_STAGE(PG8_SB(1, 0), b3, voffB); PG8_STAGE(PG8_SB(1, 1), b3 + hstep, voffB); PG8_STAGE(PG8_SA(1, 0), a3, voffA);
            PG8_WAIT_V(8); PG8_WAIT_L(0); PG8_BAR; PG8_MMA(1, 0, At, B0); PG8_MMA(1, 1, At, B1); PG8_BAR; PG8_SCHED;
            } else {
            PG8_LDB(B0, 0, 0); PG8_SCHED; PG8_LDA(At, 0, 0); PG8_STAGE(PG8_SA(1, 1), a1 + hstep, voffA);
            PG8_WAIT_L(8); PG8_BAR; PG8_WAIT_L(0); PG8_MMA(0, 0, At, B0); PG8_BAR; PG8_SCHED;
            PG8_LDB(B1, 0, 1); PG8_STAGE(PG8_SB(0, 0), b2, voffB);
            PG8_BAR; PG8_WAIT_L(0); PG8_MMA(0, 1, At, B1); PG8_BAR;
            PG8_LDA(At, 0, 1); PG8_STAGE(PG8_SA(0, 0), a2, voffA);
            PG8_BAR; PG8_WAIT_L(0); PG8_MMA(1, 0, At, B0); PG8_BAR; PG8_SCHED;
            PG8_STAGE(PG8_SB(0, 1), b2 + hstep, voffB);
            PG8_WAIT_V(6); PG8_BAR; PG8_MMA(1, 1, At, B1); PG8_BAR;
            PG8_LDB(B0, 1, 0); PG8_SCHED; PG8_LDA(At, 1, 0); PG8_STAGE(PG8_SA(0, 1), a2 + hstep, voffA);
            PG8_WAIT_L(8); PG8_BAR; PG8_WAIT_L(0); PG8_MMA(0, 0, At, B0); PG8_BAR; PG8_SCHED;
            PG8_LDB(B1, 1, 1); PG8_STAGE(PG8_SB(1, 0), b3, voffB);
            PG8_BAR; PG8_WAIT_L(0); PG8_MMA(0, 1, At, B1); PG8_BAR;
            PG8_LDA(At, 1, 1); PG8_STAGE(PG8_SA(1, 0), a3, voffA);
            PG8_BAR; PG8_WAIT_L(0); PG8_MMA(1, 0, At, B0); PG8_BAR; PG8_SCHED;
            PG8_STAGE(PG8_SB(1, 1), b3 + hstep, voffB);
            PG8_WAIT_V(6); PG8_BAR; PG8_MMA(1, 1, At, B1); PG8_BAR;
            }
        }
        if constexpr (ALIGN_EPI) { if (wr == 0) PG8_BAR; }
        if constexpr (!Epi::AFTER_DRAIN) { E(acc, cur, wr, wc, fr, fq); S.done(cur); }
        if (!has_next) break;
#pragma unroll
        for (int a = 0; a < 2; ++a)
#pragma unroll
            for (int b = 0; b < 2; ++b)
#pragma unroll
                for (int m = 0; m < 4; ++m)
#pragma unroll
                    for (int n = 0; n < 2; ++n) acc[a][b][m][n] = (f32x4){0.f, 0.f, 0.f, 0.f};
        cur = nxt; cA = nA; cB = nB; ++ui;
        if constexpr (ALIGN_EPI) { if (wr == 1) PG8_BAR; }
    }
    PG8_WAIT_V(0);
    if constexpr (!ALIGN_EPI) { if (wr == 0) PG8_BAR; }
    PG8_BAR;
    if constexpr (Epi::AFTER_DRAIN) { E.fused(acc, cur, wr, wc, fr, fq, lds, wid, lane); S.done(cur); }
#undef PG8_SA
#undef PG8_SB
#undef PG8_STAGE
#undef PG8_LDA
#undef PG8_LDB
#undef PG8_MMA
#undef PG8_WAIT_V
#undef PG8_WAIT_L
#undef PG8_BAR
#undef PG8_SCHED
}
}
#define XB_TMO      128
#define XB_XCNT(j)  (256  + 64 * (j))
#define XB_XSUB(j)  (1280 + 64 * (j))
#define XB_XGEN(j)  (2304 + 64 * (j))
#define XB_TOP      3328
#define XB_TOPGEN   3392
#define XCD_BAR_WORDS 3456
#define XB_SPIN_CAP (1u << 18)

__device__ __forceinline__ unsigned xb_ld(unsigned* p)              { return __hip_atomic_load(p, __ATOMIC_RELAXED, __HIP_MEMORY_SCOPE_AGENT); }
__device__ __forceinline__ unsigned xb_add(unsigned* p, unsigned v) { return __hip_atomic_fetch_add(p, v, __ATOMIC_RELAXED, __HIP_MEMORY_SCOPE_AGENT); }
__device__ __forceinline__ unsigned xb_xcc_id() { return (unsigned)__builtin_amdgcn_s_getreg((3 << 11) | 20) & 0xFu; }
#define XB_SPIN(cond, bar) do { unsigned _sp = 0; while (cond) { __builtin_amdgcn_s_sleep(1); \
    if ((++_sp & 255u) == 0u) { if (xb_ld(&(bar)[XB_TMO])) break; if (_sp > XB_SPIN_CAP) { atomicAdd(&(bar)[XB_TMO], 1u); break; } } } } while (0)

struct XcdBarrier {
    unsigned* bar; unsigned x;
    volatile LAS unsigned* st;
};

__device__ __forceinline__ XcdBarrier xcd_barrier_post(unsigned* bar, volatile LAS unsigned* st) {
    XcdBarrier b; b.bar = bar; b.x = xb_xcc_id(); b.st = st;
    if (threadIdx.x == 0) (void)xb_add(&bar[XB_XCNT(b.x)], 1u);
    return b;
}
__device__ __forceinline__ void xcd_barrier_complete(unsigned* bar, unsigned x, unsigned& nloc, unsigned& nx) {
    const unsigned G = gridDim.x * gridDim.y * gridDim.z;
    unsigned sum, cnt, mine, sp = 0u;
    for (;;) {
        sum = 0u; cnt = 0u; mine = 0u;
#pragma unroll
        for (unsigned j = 0; j < 16; ++j) { const unsigned c = xb_ld(&bar[XB_XCNT(j)]); sum += c; cnt += (c > 0u) ? 1u : 0u; mine = (j == x) ? c : mine; }
        if (sum == G) break;
        __builtin_amdgcn_s_sleep(1);
        if ((++sp & 255u) == 0u) { if (xb_ld(&bar[XB_TMO])) break; if (sp > XB_SPIN_CAP) { atomicAdd(&bar[XB_TMO], 1u); break; } }
    }
    nloc = mine > 0u ? mine : 1u; nx = cnt > 0u ? cnt : 1u;
}

__device__ __forceinline__ void xcd_barrier(const XcdBarrier& b) {
    asm volatile("s_waitcnt vmcnt(0)" ::: "memory");
    __syncthreads();
    if (threadIdx.x == 0) {
        unsigned* bar = b.bar;
        __builtin_amdgcn_s_waitcnt(0);
        unsigned nloc = b.st[0], nx = b.st[1];
        if (nloc == 0u) { xcd_barrier_complete(bar, b.x, nloc, nx); b.st[0] = nloc; b.st[1] = nx; }
        const unsigned old = xb_add(&bar[XB_XSUB(b.x)], 1u);
        const unsigned gen = old / nloc;
        if (old + 1u == (gen + 1u) * nloc) {
            __builtin_amdgcn_fence(__ATOMIC_RELEASE, "agent");
            asm volatile("s_waitcnt vmcnt(0)" ::: "memory");
            const unsigned og = xb_add(&bar[XB_TOP], 1u);
            const unsigned tg = og / nx;
            if (og + 1u == (tg + 1u) * nx) xb_add(&bar[XB_TOPGEN], 1u);
            else XB_SPIN(xb_ld(&bar[XB_TOPGEN]) == tg, bar);
            __builtin_amdgcn_fence(__ATOMIC_ACQUIRE, "agent");
            xb_add(&bar[XB_XGEN(b.x)], 1u);
            asm volatile("s_waitcnt vmcnt(0)" ::: "memory");
        } else {
            XB_SPIN(xb_ld(&bar[XB_XGEN(b.x)]) == gen, bar);
            __builtin_amdgcn_fence(__ATOMIC_ACQUIRE, "agent");
            asm volatile("s_waitcnt vmcnt(0)" ::: "memory");
        }
    }
    __syncthreads();
}
constexpr int NWAVES = 8;
constexpr int RING_OFF = 0, RING_BYTES = 131072;
constexpr int LDSCTL_OFF = RING_BYTES, MISC_OFF = LDSCTL_OFF + 320;
constexpr int LDS_BYTES = 147456;

struct Frame {
    LAS unsigned char* lds; volatile LAS unsigned* MISC;
    int tid, lane, wave, G, vcu;
    const float* in[15]; float* out; unsigned char* ws;
};

__device__ __forceinline__ void prep_w_item(const float* W, const float* gain, int K, int Nsrc, bool map, bf16_t* Wt, LAS float* scr, int item, int nblk, int lane) {
    const int kb = item / nblk, nb = item % nblk, k0 = 64 * kb, n0 = 32 * nb;
    const int nn = n0 + (lane & 31); const int e = map ? inmap(nn) : nn;
#pragma unroll 8
    for (int i = 0; i < 32; ++i) { const int kk = 2 * i + (lane >> 5); float v = 0.f;
        if (e >= 0) v = W[(size_t)(k0 + kk) * Nsrc + e] * (gain ? gain[k0 + kk] : 1.f);
        scr[kk * 33 + (lane & 31)] = v; }
    LDS_WAIT(); asm volatile("" ::: "memory");
    const int c = lane & 7;
#pragma unroll
    for (int j = 0; j < 4; ++j) { const int n = (lane >> 3) + 8 * j; const LAS float* s = scr + (8 * c) * 33 + n;
        u32x4 o; o.x = pk2(s[0 * 33], s[1 * 33]); o.y = pk2(s[2 * 33], s[3 * 33]); o.z = pk2(s[4 * 33], s[5 * 33]); o.w = pk2(s[6 * 33], s[7 * 33]);
        *(u32x4*)(Wt + (size_t)(n0 + n) * K + k0 + 8 * c) = o; }
    LDS_WAIT(); asm volatile("" ::: "memory");
}
__device__ __forceinline__ void p0_prep(Frame& F) {
    LAS float* scr = (LAS float*)(F.lds + RING_OFF + F.wave * 16384);
    int tid_ = threadIdx.x; asm volatile("" : "+v"(tid_));
    const int lane = tid_ & 63, gw = F.vcu * NWAVES + __builtin_amdgcn_readfirstlane(tid_ >> 6), NGW = F.G * NWAVES;
    unsigned char* ws = F.ws;
    constexpr int I_IN = (D / 64) * (NINP / 32), I_A = (DC / 64) * (D / 32), I_O = (D / 64) * (D / 32), I_P = (DPLE / 64) * (D / 32);
    constexpr int NITEMS = I_IN + 2 * I_A + 2 * I_O + I_P;
    for (int it = gw; it < NITEMS; it += NGW) {
        int r = it;
        if (r < I_IN) { prep_w_item(F.in[3], F.in[2], D, NIN, true, (bf16_t*)(ws + WS_WIN), scr, r, NINP / 32, lane); continue; } r -= I_IN;
        if (r < I_A) { prep_w_item(F.in[8], nullptr, DC, D, false, (bf16_t*)(ws + WS_WA), scr, r, D / 32, lane); continue; } r -= I_A;
        if (r < I_A) { prep_w_item(F.in[9], nullptr, DC, D, false, (bf16_t*)(ws + WS_WB), scr, r, D / 32, lane); continue; } r -= I_A;
        if (r < I_O) { prep_w_item(F.in[10], nullptr, D, D, false, (bf16_t*)(ws + WS_WO), scr, r, D / 32, lane); continue; } r -= I_O;
        if (r < I_O) { prep_w_item(F.in[12], F.in[11], D, D, false, (bf16_t*)(ws + WS_WG), scr, r, D / 32, lane); continue; } r -= I_O;
        prep_w_item(F.in[13], nullptr, DPLE, D, false, (bf16_t*)(ws + WS_WP), scr, r, D / 32, lane);
    }
    const float* x = F.in[0]; const float* p = F.in[1]; bf16_t* xb = (bf16_t*)(ws + WS_XB); bf16_t* pb = (bf16_t*)(ws + WS_PB); float* rinv = (float*)(ws + WS_RINV);
    for (int m = gw; m < M; m += NGW) {
        const f32x4* xr = (const f32x4*)(x + (size_t)m * D) + lane; f32x4 v[4]; float s = 0.f;
#pragma unroll
        for (int j = 0; j < 4; ++j) { v[j] = xr[64 * j]; s += (v[j].x * v[j].x + v[j].y * v[j].y) + (v[j].z * v[j].z + v[j].w * v[j].w); }
        s = wave_sum(s);
        if (lane == 0) rinv[m] = rsqrtf(s * (1.f / D) + EPS);
        u32x2* o = (u32x2*)(xb + (size_t)m * D) + lane;
#pragma unroll
        for (int j = 0; j < 4; ++j) { u32x2 w; w.x = pk2(v[j].x, v[j].y); w.y = pk2(v[j].z, v[j].w); o[64 * j] = w; }
        const f32x4 pv = ((const f32x4*)(p + (size_t)m * DPLE))[lane];
        u32x2 w; w.x = pk2(pv.x, pv.y); w.y = pk2(pv.z, pv.w); ((u32x2*)(pb + (size_t)m * DPLE))[lane] = w;
    }
}

constexpr int CF_TOK = 128, CF_CH = 16;
__device__ __forceinline__ void p2_conformer(Frame& F) {
    LAS float* red = (LAS float*)(F.lds + RING_OFF);
    const bf16_t* cin = (const bf16_t*)(F.ws + WS_CIN); const bf16_t* cz = (const bf16_t*)(F.ws + WS_CZ); bf16_t* ya = (bf16_t*)(F.ws + WS_YA);
    const float* conv_w = F.in[4];
    int tid_ = threadIdx.x; asm volatile("" : "+v"(tid_));
    const int ch = tid_, lane = tid_ & 63, wv = __builtin_amdgcn_readfirstlane(tid_ >> 6);
    float w[CWID];
#pragma unroll
    for (int j = 0; j < CWID; ++j) w[j] = conv_w[j * DC + ch];
    const float cb = F.in[5][ch], g = F.in[6][ch], bb = F.in[7][ch];
    for (int item = F.vcu; item < M / CF_TOK; item += F.G) {
        const int b = item / (SEQ / CF_TOK), t0 = (item % (SEQ / CF_TOK)) * CF_TOK; const size_t rowb = (size_t)b * SEQ;
        float u[CF_CH + CWID - 1];
#pragma unroll
        for (int i = 0; i < CWID - 1; ++i) { const int t = t0 - (CWID - 1) + i; float v = 0.f;
            if (t >= 0) { const float a = bf2f(cin[(rowb + t) * 1024 + ch]), gt = bf2f(cin[(rowb + t) * 1024 + 512 + ch]); v = a * sigmoidf_(gt); }
            u[i] = v; }
        for (int tc = t0; tc < t0 + CF_TOK; tc += CF_CH) {
#pragma unroll
            for (int i = 0; i < CF_CH; ++i) { const size_t r = (rowb + tc + i) * 1024; const float a = bf2f(cin[r + ch]), gt = bf2f(cin[r + 512 + ch]); u[CWID - 1 + i] = a * sigmoidf_(gt); }
            float c[CF_CH];
#pragma unroll
            for (int i = 0; i < CF_CH; ++i) { float s = cb;
#pragma unroll
                for (int j = 0; j < CWID; ++j) s = fmaf(w[j], u[i + j], s);
                c[i] = s; }
#pragma unroll
            for (int i = 0; i < CF_CH; ++i) { const float s1 = wave_sum(c[i]), s2 = wave_sum(c[i] * c[i]); if (lane == 0) { red[wv * 32 + 2 * i] = s1; red[wv * 32 + 2 * i + 1] = s2; } }
            __syncthreads();
#pragma unroll
            for (int i = 0; i < CF_CH; ++i) { float s1 = 0.f, s2 = 0.f;
#pragma unroll
                for (int q = 0; q < 8; ++q) { s1 += red[q * 32 + 2 * i]; s2 += red[q * 32 + 2 * i + 1]; }
                const float mu = s1 * (1.f / DC), var = fmaxf(s2 * (1.f / DC) - mu * mu, 0.f), rs = rsqrtf(var + EPS);
                const float y = (c[i] - mu) * rs * g + bb; const float z = bf2f(cz[(rowb + tc + i) * DC + ch]);
                ya[(rowb + tc + i) * DC + ch] = f2bf(siluf_(y) * siluf_(z)); }
            __syncthreads();
#pragma unroll
            for (int i = 0; i < CWID - 1; ++i) u[i] = u[i + CF_CH];
        }
    }
}

#ifndef REP_PASS1
#define REP_PASS1 1
#endif
#ifndef REP_SEL
#define REP_SEL 1
#endif
#ifndef REP_PASS2
#define REP_PASS2 1
#endif
__device__ __forceinline__ float max3f_(float a, float b, float c) { float r; asm("v_max3_f32 %0, %1, %2, %3" : "=v"(r) : "v"(a), "v"(b), "v"(c)); return r; }
__device__ __forceinline__ float relu_(float a) { float r; asm("v_max_f32_e32 %0, 0, %1" : "=v"(r) : "v"(a)); return r; }
typedef short bf16x8 __attribute__((ext_vector_type(8)));
typedef float f32x16 __attribute__((ext_vector_type(16)));
__device__ __forceinline__ unsigned skey(float f) { const unsigned u = __float_as_uint(f + 0.f); return (u & 0x80000000u) ? ~u : (u | 0x80000000u); }
__device__ __forceinline__ int half_sum(int v) {
    v += __builtin_amdgcn_update_dpp(0, v, 0xB1, 0xf, 0xf, false);
    v += __builtin_amdgcn_update_dpp(0, v, 0x4E, 0xf, 0xf, false);
    v += __builtin_amdgcn_update_dpp(0, v, 0x141, 0xf, 0xf, false);
    v += __builtin_amdgcn_update_dpp(0, v, 0x140, 0xf, 0xf, false);
    v += __shfl_xor(v, 16);
    return v;
}
__device__ __forceinline__ void pk_count_below4(unsigned& acc, unsigned cand2, unsigned k0, unsigned k1, unsigned k2, unsigned k3, unsigned one2) {
    unsigned t0, t1;
    asm("v_pk_sub_u16 %0, %3, %4 clamp\n\tv_pk_sub_u16 %1, %3, %5 clamp\n\tv_pk_min_u16 %0, %0, %8\n\tv_pk_min_u16 %1, %1, %8\n\tv_pk_add_u16 %2, %2, %0\n\tv_pk_add_u16 %2, %2, %1\n\t"
        "v_pk_sub_u16 %0, %3, %6 clamp\n\tv_pk_sub_u16 %1, %3, %7 clamp\n\tv_pk_min_u16 %0, %0, %8\n\tv_pk_min_u16 %1, %1, %8\n\tv_pk_add_u16 %2, %2, %0\n\tv_pk_add_u16 %2, %2, %1"
        : "=&v"(t0), "=&v"(t1), "+v"(acc) : "v"(cand2), "v"(k0), "v"(k1), "v"(k2), "v"(k3), "v"(one2));
}
__device__ __forceinline__ void attn_pass1_select(Frame& F, int b, int qb, LAS unsigned char* lds, unsigned (&mAo)[2], unsigned (&mBo)[2]) {
    int tid_ = threadIdx.x; asm volatile("" : "+v"(tid_));
    const int lane = tid_ & 63, w = __builtin_amdgcn_readfirstlane(tid_ >> 6), col = lane & 31, half = lane >> 5;
    const bf16_t* iq = (const bf16_t*)(F.ws + WS_IQ); const bf16_t* sm = (const bf16_t*)(F.ws + WS_SM);
    const size_t rowb = (size_t)b * SEQ; const int t0 = 32 * qb; const size_t m0w = rowb + t0 + 4 * w;
    bf16x8 aq[4];
    { const int r = col, half_r = (r >> 2) & 1, qsel = r >> 4, head = (r & 3) + 4 * ((r >> 3) & 1), ql = 2 * half_r + qsel;
#pragma unroll
      for (int ks = 0; ks < 4; ++ks) aq[ks] = *(const bf16x8*)(iq + (m0w + ql) * 512 + head * 64 + 16 * ks + 8 * half); }
    float wr[16];
    { const u32x4 va = *(const u32x4*)(sm + (m0w + 2 * half) * 256 + 192), vb = *(const u32x4*)(sm + (m0w + 2 * half + 1) * 256 + 192);
      const float wa[8] = {bflo(va.x), bfhi(va.x), bflo(va.y), bfhi(va.y), bflo(va.z), bfhi(va.z), bflo(va.w), bfhi(va.w)};
      const float wb[8] = {bflo(vb.x), bfhi(vb.x), bflo(vb.y), bfhi(vb.y), bflo(vb.z), bfhi(vb.z), bflo(vb.w), bfhi(vb.w)};
      const float sc = 0.125f * 0.35355339059327373f;
#pragma unroll
      for (int i = 0; i < 8; ++i) { wr[i] = wa[(i & 3) + 4 * (i >> 2)] * sc; wr[8 + i] = wb[(i & 3) + 4 * (i >> 2)] * sc; } }
    LAS f32x4* wl = (LAS f32x4*)(lds + 65536 + w * 128 + half * 64);
    if (col == 0) {
#pragma unroll
        for (int i = 0; i < 4; ++i) wl[i] = (f32x4){wr[4 * i], wr[4 * i + 1], wr[4 * i + 2], wr[4 * i + 3]}; }
    int offk[4];
#pragma unroll
    for (int ks = 0; ks < 4; ++ks) offk[ks] = col * 128 + ((((2 * ks + half) ^ ((col >> 1) & 7))) << 4);
    const int nch = qb / 8 + 1;
    unsigned vok[2];
#pragma unroll
    for (int i_ = 0; i_ < 2; ++i_) vok[i_] = (unsigned)((lane >> 3) * 512 + 16 * ((lane & 7) ^ ((4 * i_ + (lane >> 4)) & 7)));
#define AT_STAGE(c, bufsel) do { _Pragma("unroll") for (int i_ = 0; i_ < 4; ++i_) { const int seg = 4 * w + i_; unsigned vo_ = vok[i_ & 1]; asm volatile("" : "+v"(vo_)); \
        __builtin_amdgcn_global_load_lds((const unsigned*)((const char*)sm + ((rowb + 256 * (c) + 8 * seg) * 256 + 128) * 2 + vo_), (LAS unsigned*)(lds + (bufsel) * 32768 + seg * 1024), 16, 0, 0); } } while (0)
    unsigned kA[64], kB[64];
    const int sh = 8 * (8 - nch);
    for (int rep1_ = 0; rep1_ < REP_PASS1; ++rep1_) {
#pragma unroll
    for (int i = 0; i < 64; ++i) { kA[i] = 0u; kB[i] = 0u; }
    AT_STAGE(0, 0);
    asm volatile("s_waitcnt vmcnt(0)" ::: "memory"); __syncthreads();
    for (int c = 0; c < nch; ++c) {
        if (c + 1 < nch) AT_STAGE(c + 1, (c + 1) & 1);
#pragma unroll
        for (int i = 0; i < 56; ++i) { kA[i] = kA[i + 8]; kB[i] = kB[i + 8]; }
        const LAS unsigned char* img = lds + (c & 1) * 32768;
#pragma unroll
        for (int jj = 0; jj < 8; ++jj) { const int dq = qb - (8 * c + jj);
            bf16x8 bk[4];
#pragma unroll
            for (int ks = 0; ks < 4; ++ks) bk[ks] = *(const LAS bf16x8*)(img + jj * 4096 + offk[ks]);
            f32x16 acc = {0.f, 0.f, 0.f, 0.f, 0.f, 0.f, 0.f, 0.f, 0.f, 0.f, 0.f, 0.f, 0.f, 0.f, 0.f, 0.f};
#pragma unroll
            for (int ks = 0; ks < 4; ++ks) acc = __builtin_amdgcn_mfma_f32_32x32x16_bf16(aq[ks], bk[ks], acc, 0, 0, 0);
            float sA = 0.f, sB = 0.f;
            { const f32x4 w0 = wl[0], w1 = wl[1], w2 = wl[2], w3 = wl[3];
#pragma unroll
              for (int i = 0; i < 4; ++i) { sA = fmaf(w0[i], __builtin_amdgcn_fmed3f(acc[i], 0.f, INFINITY), sA); sA = fmaf(w1[i], __builtin_amdgcn_fmed3f(acc[4 + i], 0.f, INFINITY), sA);
                                            sB = fmaf(w2[i], __builtin_amdgcn_fmed3f(acc[8 + i], 0.f, INFINITY), sB); sB = fmaf(w3[i], __builtin_amdgcn_fmed3f(acc[12 + i], 0.f, INFINITY), sB); } }
            const int limA = dq > 0 ? 31 : (dq == 0 ? 4 * w + 2 * half : -1), limB = dq > 0 ? 31 : (dq == 0 ? 4 * w + 2 * half + 1 : -1);
            kA[56 + jj] = (col <= limA) ? skey(sA) : 0u; kB[56 + jj] = (col <= limB) ? skey(sB) : 0u;
            __builtin_amdgcn_sched_barrier(0);
        }
        asm volatile("s_waitcnt vmcnt(0)" ::: "memory"); __syncthreads();
    }
    }
#undef AT_STAGE
    const int nA = t0 + 4 * w + 2 * half + 1, nB = nA + 1;
    unsigned prefA = 0u, prefB = 0u, thrA = 1u, thrB = 1u; bool exA = nA <= TOPK, exB = nB <= TOPK;
    unsigned pA[32], pB[32];
#pragma unroll
    for (int i = 0; i < 32; ++i) { pA[i] = (kA[2 * i] >> 16) | (kA[2 * i + 1] & 0xffff0000u); pB[i] = (kB[2 * i] >> 16) | (kB[2 * i + 1] & 0xffff0000u); }
    const int nproc = 8 * nch;
    for (int reps_ = 0; reps_ < REP_SEL; ++reps_) {
    prefA = 0u; prefB = 0u; thrA = 1u; thrB = 1u; exA = nA <= TOPK; exB = nB <= TOPK; asm volatile("" : "+v"(prefA), "+v"(prefB));
    for (int bit = 31; bit >= 16; --bit) {
        if (__all(exA && exB)) break;
        const unsigned candA = prefA | (1u << bit), candB = prefB | (1u << bit);
        const unsigned cA2 = (candA >> 16) * 0x10001u, cB2 = (candB >> 16) * 0x10001u; unsigned one2 = 0x00010001u; asm volatile("" : "+v"(one2));
        unsigned aA = 0u, aB = 0u;
#pragma unroll
        for (int g = 0; g < 8; ++g) if (g >= 8 - nch) {
            pk_count_below4(aA, cA2, pA[4 * g], pA[4 * g + 1], pA[4 * g + 2], pA[4 * g + 3], one2); pk_count_below4(aB, cB2, pB[4 * g], pB[4 * g + 1], pB[4 * g + 2], pB[4 * g + 3], one2); }
        const int cA = half_sum(nproc - (int)(aA & 0xffffu) - (int)(aA >> 16)), cB = half_sum(nproc - (int)(aB & 0xffffu) - (int)(aB >> 16));
        if (!exA) { if (cA == TOPK) { thrA = candA; exA = true; } else if (cA > TOPK) prefA = candA; }
        if (!exB) { if (cB == TOPK) { thrB = candB; exB = true; } else if (cB > TOPK) prefB = candB; }
    }
    for (int bit = 15; bit >= 0; --bit) {
        if (__all(exA && exB)) break;
        const unsigned candA = prefA | (1u << bit), candB = prefB | (1u << bit);
        int cA = 0, cB = 0;
#pragma unroll
        for (int g = 0; g < 8; ++g) if (g >= 8 - nch) {
#pragma unroll
            for (int jj = 0; jj < 8; ++jj) { cA += (kA[8 * g + jj] >= candA) ? 1 : 0; cB += (kB[8 * g + jj] >= candB) ? 1 : 0; } }
        cA = half_sum(cA); cB = half_sum(cB);
        if (!exA) { if (cA == TOPK) { thrA = candA; exA = true; } else if (cA > TOPK) prefA = candA; }
        if (!exB) { if (cB == TOPK) { thrB = candB; exB = true; } else if (cB > TOPK) prefB = candB; }
    }
    }
    const unsigned tA = exA ? thrA : prefA + 1u, tB = exB ? thrB : prefB + 1u;
    unsigned mA[2] = {0u, 0u}, mB[2] = {0u, 0u};
#pragma unroll
    for (int j = 0; j < 64; ++j) { mA[j >> 5] |= (kA[j] >= tA) ? (1u << (j & 31)) : 0u; mB[j >> 5] |= (kB[j] >= tB) ? (1u << (j & 31)) : 0u; }
    if (!__all(exA && exB)) {
        const int needA = TOPK - half_sum(__popc(mA[0]) + __popc(mA[1])), needB = TOPK - half_sum(__popc(mB[0]) + __popc(mB[1]));
        int befA = 0, befB = 0; const unsigned below = (1u << col) - 1u;
#pragma unroll
        for (int j = 0; j < 64; ++j) {
            const bool eA = !exA && kA[j] == prefA, eB = !exB && kB[j] == prefB;
            const unsigned long long balA = __ballot(eA), balB = __ballot(eB);
            const unsigned hA = half ? (unsigned)(balA >> 32) : (unsigned)balA, hB = half ? (unsigned)(balB >> 32) : (unsigned)balB;
            if (eA && befA + __popc(hA & below) < needA) mA[j >> 5] |= 1u << (j & 31);
            if (eB && befB + __popc(hB & below) < needB) mB[j >> 5] |= 1u << (j & 31);
            befA += __popc(hA); befB += __popc(hB);
        }
    }
#ifdef SELCHECK
    { unsigned mnA = 0xffffffffu, mxA = 0u, mnB = 0xffffffffu, mxB = 0u;
#pragma unroll
      for (int i = 0; i < 64; ++i) { const bool sa = (mA[i >> 5] >> (i & 31)) & 1u, sb = (mB[i >> 5] >> (i & 31)) & 1u;
          if (sa) mnA = min(mnA, kA[i]); else mxA = max(mxA, kA[i]); if (sb) mnB = min(mnB, kB[i]); else mxB = max(mxB, kB[i]); }
#pragma unroll
      for (int o = 1; o < 32; o <<= 1) { mnA = min(mnA, (unsigned)__shfl_xor((int)mnA, o)); mxA = max(mxA, (unsigned)__shfl_xor((int)mxA, o)); mnB = min(mnB, (unsigned)__shfl_xor((int)mnB, o)); mxB = max(mxB, (unsigned)__shfl_xor((int)mxB, o)); }
      const int csA = half_sum(__popc(mA[0]) + __popc(mA[1])), csB = half_sum(__popc(mB[0]) + __popc(mB[1]));
      const bool bad = csA != (nA < TOPK ? nA : TOPK) || csB != (nB < TOPK ? nB : TOPK) || mxA > mnA || mxB > mnB || mnA == 0u || mnB == 0u;
      if (bad) atomicOr((unsigned*)(F.ws + WS_CTL + 8192), 1u); }
#endif
    { const unsigned long long a64 = (((unsigned long long)mA[1] << 32) | mA[0]) >> sh, b64 = (((unsigned long long)mB[1] << 32) | mB[0]) >> sh;
      mA[0] = (unsigned)a64; mA[1] = (unsigned)(a64 >> 32); mB[0] = (unsigned)b64; mB[1] = (unsigned)(b64 >> 32); }
    mAo[0] = mA[0]; mAo[1] = mA[1]; mBo[0] = mB[0]; mBo[1] = mB[1];
}
__device__ __forceinline__ void attn_pass2(Frame& F, int b, int qb, LAS unsigned char* lds, unsigned (&mA)[2], unsigned (&mB)[2]) {
    int tid_ = threadIdx.x; asm volatile("" : "+v"(tid_), "+v"(mA[0]), "+v"(mA[1]), "+v"(mB[0]), "+v"(mB[1]));
    const int lane = tid_ & 63, w = __builtin_amdgcn_readfirstlane(tid_ >> 6), col = lane & 31, half = lane >> 5;
    const bf16_t* sm = (const bf16_t*)(F.ws + WS_SM);
    const size_t rowb = (size_t)b * SEQ; const int t0 = 32 * qb; const size_t m0w = rowb + t0 + 4 * w;
    const int nch = qb / 8 + 1;
    int offk[4];
#pragma unroll
    for (int ks = 0; ks < 4; ++ks) offk[ks] = col * 128 + ((((2 * ks + half) ^ ((col >> 1) & 7))) << 4);
    const bf16_t* qbuf = (const bf16_t*)(F.ws + WS_Q); const bf16_t* vt = (const bf16_t*)(F.ws + WS_VT); const bf16_t* az = (const bf16_t*)(F.ws + WS_AZ); bf16_t* yb = (bf16_t*)(F.ws + WS_YB);
    typedef unsigned long long u64;
    u64 mq[4];
    { const unsigned oa0 = __shfl_xor(mA[0], 32), oa1 = __shfl_xor(mA[1], 32), ob0 = __shfl_xor(mB[0], 32), ob1 = __shfl_xor(mB[1], 32);
      const u64 ownA = ((u64)mA[1] << 32) | mA[0], ownB = ((u64)mB[1] << 32) | mB[0], othA = ((u64)oa1 << 32) | oa0, othB = ((u64)ob1 << 32) | ob0;
      mq[0] = half ? othA : ownA; mq[1] = half ? othB : ownB; mq[2] = half ? ownA : othA; mq[3] = half ? ownB : othB; }
    const int qlc = col >> 3, hd = col & 7;
    bf16x8 bq[4];
#pragma unroll
    for (int ks = 0; ks < 4; ++ks) bq[ks] = *(const bf16x8*)(qbuf + (m0w + qlc) * 512 + hd * 64 + 16 * ks + 8 * half);
    const float cslope = exp2f(-(float)(hd + 1)) * 1.4426950408889634f;
    const unsigned c_hi = f2bf(cslope), c_lo = f2bf(cslope - bf2f((bf16_t)c_hi));
    float mref = cslope * (float)(t0 + 4 * w + qlc);
    u32x4 bau;
#define AT_MPIECES(mval) do { const float v_ = -(mval); const unsigned uh_ = __float_as_uint(v_) & 0xffff0000u; const float r_ = v_ - __uint_as_float(uh_); \
        const unsigned um_ = __float_as_uint(r_) & 0xffff0000u; const float r2_ = r_ - __uint_as_float(um_); bau.z = half ? ((uh_ >> 16) | um_) : 0u; bau.w = half ? (unsigned)f2bf(r2_) : 0u; } while (0)
    if (half) { bau.x = (unsigned)f2bf(16.f * bf2f((bf16_t)c_hi)) | ((unsigned)f2bf(16.f * bf2f((bf16_t)c_lo)) << 16); bau.y = c_hi | (c_lo << 16); }
    else { bau.x = (qlc == 0 ? 0x3f80u : 0u) | (qlc == 1 ? 0x3f800000u : 0u); bau.y = (qlc == 2 ? 0x3f80u : 0u) | (qlc == 3 ? 0x3f800000u : 0u); }
    AT_MPIECES(mref);
    const unsigned slo_b = __float_as_uint((float)(col & 15)) >> 16, slo2 = slo_b | (slo_b << 16);
    int offv[2][2];
#pragma unroll
    for (int dt = 0; dt < 2; ++dt)
#pragma unroll
        for (int s2 = 0; s2 < 2; ++s2) offv[dt][s2] = (32 * dt + col) * 64 + ((((2 * s2 + half) ^ ((col >> 2) & 3))) << 4);
    f32x16 oacc[2]; float lsum; bool anch;
    const f32x16 zero16 = {0.f, 0.f, 0.f, 0.f, 0.f, 0.f, 0.f, 0.f, 0.f, 0.f, 0.f, 0.f, 0.f, 0.f, 0.f, 0.f};
    unsigned vok[2], vov[4];
#pragma unroll
    for (int i_ = 0; i_ < 2; ++i_) vok[i_] = (unsigned)((lane >> 3) * 512 + 16 * ((lane & 7) ^ ((4 * i_ + (lane >> 4)) & 7)));
#pragma unroll
    for (int i_ = 0; i_ < 4; ++i_) { const int dd_ = 16 * i_ + (lane >> 2); vov[i_] = (unsigned)(dd_ * (SEQ * 2) + 16 * ((lane & 3) ^ ((dd_ >> 2) & 3))); }
#define AT_STAGE2(c, bufsel) do { _Pragma("unroll") for (int i_ = 0; i_ < 4; ++i_) { const int seg = 4 * w + i_; unsigned vo_ = vok[i_ & 1], vv_ = vov[i_]; asm volatile("" : "+v"(vo_), "+v"(vv_)); \
        __builtin_amdgcn_global_load_lds((const unsigned*)((const char*)sm + ((rowb + 256 * (c) + 8 * seg) * 256) * 2 + vo_), (LAS unsigned*)(lds + (bufsel) * 32768 + seg * 1024), 16, 0, 0); \
        __builtin_amdgcn_global_load_lds((const unsigned*)((const char*)vt + ((size_t)b * 64 * SEQ + 256 * (c) + 32 * w) * 2 + vv_), (LAS unsigned*)(lds + 65536 + (bufsel) * 32768 + seg * 1024), 16, 0, 0); } } while (0)
    for (int rep2_ = 0; rep2_ < REP_PASS2; ++rep2_) {
#pragma unroll
    for (int dt = 0; dt < 2; ++dt)
#pragma unroll
        for (int i = 0; i < 16; ++i) oacc[dt][i] = 0.f;
    lsum = 0.f; anch = false; mref = cslope * (float)(t0 + 4 * w + qlc); AT_MPIECES(mref);
    __syncthreads();
    AT_STAGE2(nch - 1, (nch - 1) & 1);
    asm volatile("s_waitcnt vmcnt(0)" ::: "memory"); __syncthreads();
    for (int c = nch - 1; c >= 0; --c) {
        if (c > 0) AT_STAGE2(c - 1, (c - 1) & 1);
        const LAS unsigned char* kimg = lds + (c & 1) * 32768; const LAS unsigned char* vimg = lds + 65536 + (c & 1) * 32768;
        for (int jj = 7; jj >= 0; --jj) { const int j = 8 * c + jj;
            if (j > qb) continue;
            bf16x8 ak[4];
#pragma unroll
            for (int ks = 0; ks < 4; ++ks) ak[ks] = *(const LAS bf16x8*)(kimg + jj * 4096 + offk[ks]);
            u32x4 aau;
            { const unsigned p0 = (unsigned)(~(mq[0] >> j) & 1ull) * 0xc700u, p1 = (unsigned)(~(mq[1] >> j) & 1ull) * 0xc700u, p2 = (unsigned)(~(mq[2] >> j) & 1ull) * 0xc700u, p3 = (unsigned)(~(mq[3] >> j) & 1ull) * 0xc700u;
              const unsigned shi_b = __float_as_uint((float)(2 * j + (col >> 4))) >> 16;
              aau.x = half ? (shi_b | (shi_b << 16)) : (p0 | (p1 << 16)); aau.y = half ? slo2 : (p2 | (p3 << 16)); aau.z = half ? 0x3f803f80u : 0u; aau.w = half ? 0x00003f80u : 0u; }
            f32x16 x = __builtin_amdgcn_mfma_f32_32x32x16_bf16(ak[0], bq[0], zero16, 0, 0, 0);
#pragma unroll
            for (int ks = 1; ks < 4; ++ks) x = __builtin_amdgcn_mfma_f32_32x32x16_bf16(ak[ks], bq[ks], x, 0, 0, 0);
            x = __builtin_amdgcn_mfma_f32_32x32x16_bf16(__builtin_bit_cast(bf16x8, aau), __builtin_bit_cast(bf16x8, bau), x, 0, 0, 0);
            asm volatile("s_nop 11" : "+v"(x));
            float lmax = max3f_(x[0], x[1], x[2]), lmx2 = max3f_(x[3], x[4], x[5]);
            lmax = max3f_(lmax, x[6], x[7]); lmx2 = max3f_(lmx2, x[8], x[9]); lmax = max3f_(lmax, x[10], x[11]); lmx2 = max3f_(lmx2, x[12], x[13]); lmax = max3f_(lmax, x[14], x[15]); lmax = max3f_(lmax, lmx2, lmx2);
            lmax = fmaxf(lmax, __shfl_xor(lmax, 32));
            const bool need = anch ? (lmax > 8.f) : (lmax > -30000.f);
            if (__any(need)) {
                const float dl = need ? lmax : 0.f, f = (need && anch) ? __builtin_amdgcn_exp2f(-dl) : 1.f;
                mref += dl; lsum *= f; anch = anch || need;
#pragma unroll
                for (int i = 0; i < 16; ++i) { x[i] -= dl; oacc[0][i] *= f; oacc[1][i] *= f; }
                AT_MPIECES(mref);
            }
            unsigned pw[8];
#pragma unroll
            for (int i = 0; i < 16; i += 2) { const float e0 = __builtin_amdgcn_exp2f(x[i]), e1 = __builtin_amdgcn_exp2f(x[i + 1]); lsum += e0 + e1; pw[i >> 1] = pk2(e0, e1); }
            const u32x4 pf0 = {pw[0], pw[1], pw[2], pw[3]}, pf1 = {pw[4], pw[5], pw[6], pw[7]};
#pragma unroll
            for (int dt = 0; dt < 2; ++dt) {
                const bf16x8 av0 = *(const LAS bf16x8*)(vimg + jj * 4096 + offv[dt][0]), av1 = *(const LAS bf16x8*)(vimg + jj * 4096 + offv[dt][1]);
                oacc[dt] = __builtin_amdgcn_mfma_f32_32x32x16_bf16(av0, __builtin_bit_cast(bf16x8, pf0), oacc[dt], 0, 0, 0);
                oacc[dt] = __builtin_amdgcn_mfma_f32_32x32x16_bf16(av1, __builtin_bit_cast(bf16x8, pf1), oacc[dt], 0, 0, 0); }
        }
        asm volatile("s_waitcnt vmcnt(0)" ::: "memory"); __syncthreads();
    }
    }
#undef AT_STAGE2
#undef AT_MPIECES
    { const float inv = __builtin_amdgcn_rcpf(lsum + __shfl_xor(lsum, 32)); const size_t mrow = (m0w + qlc) * 512 + hd * 64;
#pragma unroll
      for (int dt = 0; dt < 2; ++dt)
#pragma unroll
          for (int g4 = 0; g4 < 4; ++g4) { const int d0 = 32 * dt + 8 * g4 + 4 * half; const u32x2 zz = *(const u32x2*)(az + mrow + d0);
              const float y0 = oacc[dt][4 * g4 + 0] * inv * siluf_(bflo(zz.x)), y1 = oacc[dt][4 * g4 + 1] * inv * siluf_(bfhi(zz.x)), y2 = oacc[dt][4 * g4 + 2] * inv * siluf_(bflo(zz.y)), y3 = oacc[dt][4 * g4 + 3] * inv * siluf_(bfhi(zz.y));
              u32x2 o; o.x = pk2(y0, y1); o.y = pk2(y2, y3); *(u32x2*)(yb + mrow + d0) = o; } }
}
__device__ __forceinline__ void p2_attn(Frame& F) {
    const int b = F.vcu >> 4, r = F.vcu & 15;
    for (int i = 0; i < 4; ++i) { const int qb = (i == 0) ? r : (i == 1) ? 31 - r : (i == 2) ? 32 + r : 63 - r;
        unsigned mA[2], mB[2];
        attn_pass1_select(F, b, qb, F.lds + RING_OFF, mA, mB);
        attn_pass2(F, b, qb, F.lds + RING_OFF, mA, mB);
    }
}

__device__ __forceinline__ void p6_final(Frame& F) {
    float* out = F.out; const float* ssp2 = (const float*)(F.ws + WS_SSP2); const float* fg = F.in[14]; const bf16_t* x2b = (const bf16_t*)(F.ws + WS_X2B);
    int tid_ = threadIdx.x; asm volatile("" : "+v"(tid_));
    const int lane = tid_ & 63, gw = F.vcu * NWAVES + __builtin_amdgcn_readfirstlane(tid_ >> 6), NGW = F.G * NWAVES;
#ifdef SELCHECK
    const float poison = (*(volatile unsigned*)(F.ws + WS_CTL + 8192)) ? __builtin_nanf("") : 1.f;
#else
    const float poison = 1.f;
#endif
    for (int m = gw; m < M; m += NGW) { float s = (lane < 16) ? ssp2[(size_t)m * 16 + lane] : 0.f; s = wave_sum(s);
        const float r = rsqrtf(s * (1.f / D) + EPS) * poison; f32x4* o = (f32x4*)(out + (size_t)m * D); const u32x4* xi = (const u32x4*)(x2b + (size_t)m * D);
#pragma unroll
        for (int j = 0; j < 2; ++j) { const u32x4 xw = xi[lane + 64 * j]; const f32x4 g0 = ((const f32x4*)fg)[2 * (lane + 64 * j)], g1 = ((const f32x4*)fg)[2 * (lane + 64 * j) + 1];
            o[2 * (lane + 64 * j)] = (f32x4){bflo(xw.x), bfhi(xw.x), bflo(xw.y), bfhi(xw.y)} * r * g0; o[2 * (lane + 64 * j) + 1] = (f32x4){bflo(xw.z), bfhi(xw.z), bflo(xw.w), bfhi(xw.w)} * r * g1; } }
}

#ifndef REP_P0
#define REP_P0 1
#endif
#ifndef REP_P1
#define REP_P1 1
#endif
#ifndef REP_P2A
#define REP_P2A 1
#endif
#ifndef REP_P2B
#define REP_P2B 1
#endif
#ifndef REP_P4
#define REP_P4 1
#endif
struct Args { const float* in[15]; float* out; unsigned char* ws; };
__global__ void __launch_bounds__(NWAVES * 64, 2) fwd_kernel(Args args) {
    extern __shared__ __attribute__((aligned(16))) unsigned char lds_raw[];
    Frame F;
    F.lds = (LAS unsigned char*)lds_raw; F.MISC = (volatile LAS unsigned*)(F.lds + MISC_OFF);
    F.tid = threadIdx.x; F.lane = F.tid & 63; F.wave = __builtin_amdgcn_readfirstlane(F.tid >> 6);
    F.G = gridDim.x; { const int bx = blockIdx.x; F.vcu = (F.G % 8 == 0) ? (bx % 8) * (F.G / 8) + bx / 8 : bx; }
#pragma unroll
    for (int i = 0; i < 15; ++i) F.in[i] = args.in[i];
    F.out = args.out; F.ws = args.ws;
    unsigned char* ws = args.ws;
    for (int u = F.tid; u < (LDS_BYTES - LDSCTL_OFF) / 4; u += NWAVES * 64) ((LAS unsigned*)(F.lds + LDSCTL_OFF))[u] = 0u;
    __syncthreads();
    XcdBarrier bar = xcd_barrier_post((unsigned*)(ws + WS_CTL) + CW_BAR, F.MISC + 8);

    for (int rep_ = 0; rep_ < REP_P0; ++rep_) { p0_prep(F); if (rep_ + 1 < REP_P0) __syncthreads(); }
    xcd_barrier(bar);
    { pg8::Gemm g{(const bf16_t*)(ws + WS_XB), (const bf16_t*)(ws + WS_WIN), M, NINP, D}; pg8::StaticOrder S; S.init(M, NINP, F.G, (int)blockIdx.x);
      pg8::EpiInProj E{(const float*)(ws + WS_RINV), ws};
      for (int rep_ = 0; rep_ < REP_P1; ++rep_) pg8::gemm_phase<pg8::EpiInProj, pg8::StaticOrder, true, true>(F.lds + RING_OFF, g, S, E);
    }
    xcd_barrier(bar);
    for (int rep_ = 0; rep_ < REP_P2A; ++rep_) p2_conformer(F);
    for (int rep_ = 0; rep_ < REP_P2B; ++rep_) p2_attn(F);
    xcd_barrier(bar);
    { pg8::Gemm g{(const bf16_t*)(ws + WS_YA), (const bf16_t*)(ws + WS_WA), M, D, DC}; pg8::StaticOrder S; S.init(M, D, F.G, (int)blockIdx.x);
      pg8::EpiOutA E{(const bf16_t*)(ws + WS_GA), (bf16_t*)(ws + WS_PART)};
      pg8::gemm_phase<pg8::EpiOutA, pg8::StaticOrder, true, true>(F.lds + RING_OFF, g, S, E);
    }
    { pg8::Gemm g{(const bf16_t*)(ws + WS_YB), (const bf16_t*)(ws + WS_WB), M, D, DC}; pg8::StaticOrder S; S.init(M, D, F.G, (int)blockIdx.x);
      pg8::EpiOutB E{(const bf16_t*)(ws + WS_GB), (const bf16_t*)(ws + WS_PART), (bf16_t*)(ws + WS_MRG)};
      pg8::gemm_phase<pg8::EpiOutB, pg8::StaticOrder, true, true>(F.lds + RING_OFF, g, S, E);
    }
    xcd_barrier(bar);
    { pg8::Gemm g{(const bf16_t*)(ws + WS_MRG), (const bf16_t*)(ws + WS_WO), M, D, D}; pg8::StaticOrder S; S.init(M, D, F.G, (int)blockIdx.x);
      pg8::EpiWo E{F.in[0], (bf16_t*)(ws + WS_X1B), (float*)(ws + WS_SSP1)};
      for (int rep_ = 0; rep_ < REP_P4; ++rep_) pg8::gemm_phase<pg8::EpiWo, pg8::StaticOrder, true, true>(F.lds + RING_OFF, g, S, E);
    }
    xcd_barrier(bar);
    { pg8::Gemm g{(const bf16_t*)(ws + WS_PB), (const bf16_t*)(ws + WS_WP), M, D, DPLE}; pg8::StaticOrder S; S.init(M, D, F.G, (int)blockIdx.x);
      pg8::EpiPP E{(bf16_t*)(ws + WS_PP)};
      pg8::gemm_phase<pg8::EpiPP, pg8::StaticOrder, true, true>(F.lds + RING_OFF, g, S, E);
    }
    __builtin_amdgcn_sched_barrier(0); asm volatile("" ::: "memory");
    { pg8::Gemm g{(const bf16_t*)(ws + WS_X1B), (const bf16_t*)(ws + WS_WG), M, D, D}; pg8::StaticOrder S; S.init(M, D, F.G, (int)blockIdx.x);
      pg8::EpiGate E{(const bf16_t*)(ws + WS_X1B), (const bf16_t*)(ws + WS_PP), (bf16_t*)(ws + WS_X2B), (const float*)(ws + WS_SSP1), (float*)(ws + WS_SSP2)};
      pg8::gemm_phase<pg8::EpiGate, pg8::StaticOrder, true, true>(F.lds + RING_OFF, g, S, E);
    }
    xcd_barrier(bar);
    p6_final(F);
}

extern "C" void kernel_launch(void* const* d_in, const int* in_sizes, int n_in, void* d_out, int out_size, void* d_ws, size_t ws_size, hipStream_t stream) {
    static int grid = 0;
    if (grid == 0) {
        if (n_in != 15 || out_size != M * D || ws_size < WS_END) { fprintf(stderr, "kernel_launch: unexpected sizes n_in %d out %d ws %zu\n", n_in, out_size, ws_size); grid = -1; return; }
        int dev = 0, cus = 0, per_cu = 0;
        if (hipGetDevice(&dev) != hipSuccess || hipDeviceGetAttribute(&cus, hipDeviceAttributeMultiprocessorCount, dev) != hipSuccess) { grid = -1; return; }
        if (hipFuncSetAttribute((const void*)fwd_kernel, hipFuncAttributeMaxDynamicSharedMemorySize, LDS_BYTES) != hipSuccess) { fprintf(stderr, "kernel_launch: hipFuncSetAttribute failed\n"); grid = -1; return; }
        if (hipOccupancyMaxActiveBlocksPerMultiprocessor(&per_cu, (const void*)fwd_kernel, NWAVES * 64, LDS_BYTES) != hipSuccess || per_cu < 1) { fprintf(stderr, "kernel_launch: occupancy query reports %d blocks per CU\n", per_cu); (void)hipGetLastError(); grid = -1; return; }
        grid = cus;
        if (M % grid != 0 || grid % 8 != 0) { fprintf(stderr, "kernel_launch: unsupported CU count %d\n", grid); grid = -1; return; }
    }
    if (grid < 0) return;
    (void)hipMemsetAsync((char*)d_ws + WS_CTL, 0, CTL_ZERO_BYTES, stream);
    Args a{};
    for (int i = 0; i < 15; ++i) a.in[i] = (const float*)d_in[i];
    a.out = (float*)d_out; a.ws = (unsigned char*)d_ws;
    hipLaunchKernelGGL(fwd_kernel, dim3(grid), dim3(NWAVES * 64), LDS_BYTES, stream, a);
}
```

```cpp
#include <hip/hip_runtime.h>
#include <cstdint>
#include <cstdio>

typedef unsigned short bf16_t;
typedef float f32x4 __attribute__((ext_vector_type(4)));
typedef unsigned u32x4 __attribute__((ext_vector_type(4)));
typedef unsigned u32x2 __attribute__((ext_vector_type(2)));
#define GAS __attribute__((address_space(1)))
#define LAS __attribute__((address_space(3)))
#define LDS_WAIT() asm volatile("s_waitcnt lgkmcnt(0)" ::: "memory")
#define VM_WAIT() asm volatile("s_waitcnt vmcnt(0)" ::: "memory")

constexpr int NB = 16, SEQ = 2048, D = 1024, M = NB * SEQ;
constexpr int DPLE = 256, DC = 512, CWID = 31, NH = 8, HD = 64, TOPK = 256;
constexpr int NIN = 5320, NINP = 5376;
constexpr float EPS = 1e-6f;

constexpr size_t MiB = 1u << 20;
constexpr size_t WS_CTL = 0;
constexpr size_t CTL_ZERO_BYTES = 64 * 1024;
constexpr int CW_BAR = 4096;
constexpr size_t WS_WIN = 2 * MiB;
constexpr size_t WS_WA = 13 * MiB;
constexpr size_t WS_WB = 14 * MiB;
constexpr size_t WS_WO = 15 * MiB;
constexpr size_t WS_WG = 17 * MiB;
constexpr size_t WS_WP = 19 * MiB;
constexpr size_t WS_RINV = 20 * MiB;
constexpr size_t WS_SSP1 = 22 * MiB;
constexpr size_t WS_SSP2 = 24 * MiB;
constexpr size_t WS_VT = 26 * MiB;
constexpr size_t WS_XB = 32 * MiB;
constexpr size_t WS_YA = 32 * MiB, WS_YB = 64 * MiB;
constexpr size_t WS_PB = 96 * MiB;
constexpr size_t WS_CIN = 112 * MiB;
constexpr size_t WS_MRG = 112 * MiB;
constexpr size_t WS_CZ = 176 * MiB;
constexpr size_t WS_Q = 208 * MiB;
constexpr size_t WS_X1B = 176 * MiB;
constexpr size_t WS_PART = 176 * MiB;
constexpr size_t WS_X2B = 32 * MiB;
constexpr size_t WS_AZ = 240 * MiB;
constexpr size_t WS_IQ = 272 * MiB;
constexpr size_t WS_SM = 304 * MiB;
constexpr size_t WS_GA = 320 * MiB;
constexpr size_t WS_PP = 320 * MiB;
constexpr size_t WS_GB = 384 * MiB;
constexpr size_t WS_END = 448 * MiB;

__device__ __forceinline__ float bf2f(bf16_t h) { return __uint_as_float(((unsigned)h) << 16); }
typedef float f32x2_t __attribute__((ext_vector_type(2))); typedef __bf16 bf16x2_t __attribute__((ext_vector_type(2)));
__device__ __forceinline__ unsigned pk2(float lo, float hi) { const f32x2_t v = {lo, hi}; const bf16x2_t b = __builtin_convertvector(v, bf16x2_t); return __builtin_bit_cast(unsigned, b); }
__device__ __forceinline__ bf16_t f2bf(float f) { return (bf16_t)(pk2(f, 0.f) & 0xffffu); }
__device__ __forceinline__ float bflo(unsigned w) { return __uint_as_float(w << 16); }
__device__ __forceinline__ float bfhi(unsigned w) { return __uint_as_float(w & 0xffff0000u); }
__device__ __forceinline__ float sigmoidf_(float x) { return __builtin_amdgcn_rcpf(1.f + __builtin_amdgcn_exp2f(-1.4426950408889634f * x)); }
__device__ __forceinline__ float siluf_(float x) { return x * sigmoidf_(x); }
__device__ __forceinline__ float wave_sum(float v) {
#pragma unroll
    for (int o = 1; o < 64; o <<= 1) v += __shfl_xor(v, o);
    return v;
}

__host__ __device__ __forceinline__ int inmap(int n) {
    if (n < 1024) { const int g = n >> 3, r = n & 7; return r < 4 ? 4 * g + r : 512 + 4 * g + (r - 4); }
    if (n < 2048) return n;
    if (n < 2560) return 2176 + (n - 2048);
    if (n < 3072) return 2688 + (n - 2560);
    if (n < 3328) { const int j = n - 3072;
        if (j < 64) return 2048 + j; if (j < 128) return 2112 + (j - 64); if (j < 192) return 3200 + (j - 128); if (j < 200) return 3264 + (j - 192); return -1; }
    if (n < 4352) return 3272 + (n - 3328);
    return 4296 + (n - 4352);
}
namespace pg8 {
#define PG8_LAS __attribute__((address_space(3)))
typedef unsigned short bf16_t;
typedef short bf16x8 __attribute__((ext_vector_type(8)));
typedef float f32x4 __attribute__((ext_vector_type(4)));
typedef unsigned u32x4 __attribute__((ext_vector_type(4)));
constexpr int BM = 256, BK = 64, HALF = 128, HTB = HALF * BK * 2  , STAGE_BYTES = 8 * HTB, NXCD = 8, WGM = 8;

__host__ __device__ __forceinline__ int lds_byte(int r, int c) { const int st = (r >> 4) * 2 + (c >> 5), rr = r & 15, cc = c & 31, ob = rr * 64 + cc * 2; return st * 1024 + (ob ^ (((ob >> 9) & 1) << 5)); }
__host__ __device__ __forceinline__ void stage_rc(int b, int& R, int& C) { const int st = b / 1024, sb = b % 1024, swz = sb ^ (((sb >> 9) & 1) << 5); R = (st >> 1) * 16 + swz / 64; C = (st & 1) * 32 + (swz % 64) / 2; }
__host__ __device__ __forceinline__ int perm32(int rho) { const int n = rho >> 4, i = rho & 15; return 8 * (i >> 2) + 4 * n + (i & 3); }

struct Unit { int pm, pn; };
struct Gemm { const bf16_t* A; const bf16_t* Bt; int M, N, K; };

struct StaticOrder {
    int nM, nN, nwg, G, c;
    __host__ __device__ void init(int M, int N, int G_, int c_) { nM = M / BM; nN = N / BM; nwg = nM * nN; G = G_; c = c_; }
    __host__ __device__ bool next(int i, Unit& u) const {
        const long L = (long)i * G + c; if (L >= nwg) return false;
        int wgid = (int)L; { const int q = nwg / NXCD, r = nwg % NXCD, xcd = wgid % NXCD, off = wgid / NXCD; wgid = (xcd < r ? xcd * (q + 1) : r * (q + 1) + (xcd - r) * q) + off; }
        const int nig = WGM * nN, gid = wgid / nig, fm = gid * WGM, gsz = (nM - fm) < WGM ? (nM - fm) : WGM;
        u.pm = fm + ((wgid % nig) % gsz); u.pn = (wgid % nig) / gsz; return true;
    }
    __device__ __forceinline__ void a_ready(const Unit&) const {}
    __device__ __forceinline__ void done(const Unit&) const {}
};
__device__ __forceinline__ unsigned cvt_pk_bf16(float lo, float hi) { unsigned r; asm volatile("v_cvt_pk_bf16_f32 %0, %1, %2" : "=v"(r) : "v"(lo), "v"(hi)); return r; }
struct EpiInProj {
    static constexpr bool PERM = true, AFTER_DRAIN = false;
    const float* rinv; unsigned char* ws;
    __device__ __forceinline__ void operator()(const f32x4 (&acc)[2][2][4][2], const Unit& u, int wr, int wc, int fr, int fq) const {
        size_t off; int ld, colt; const int pn = u.pn;
        if (pn < 4) { off = WS_CIN; ld = 1024; colt = pn * 256; }
        else if (pn < 6) { off = WS_CZ; ld = 512; colt = (pn - 4) * 256; }
        else if (pn < 8) { off = WS_Q; ld = 512; colt = (pn - 6) * 256; }
        else if (pn < 10) { off = WS_AZ; ld = 512; colt = (pn - 8) * 256; }
        else if (pn < 12) { off = WS_IQ; ld = 512; colt = (pn - 10) * 256; }
        else if (pn < 13) { off = WS_SM; ld = 256; colt = 0; }
        else if (pn < 17) { off = WS_GA; ld = 1024; colt = (pn - 13) * 256; }
        else { off = WS_GB; ld = 1024; colt = (pn - 17) * 256; }
        const int row0g = u.pm * BM + wr * 64 + fr;
        if (pn < 4) {
            bf16_t* ub = (bf16_t*)(ws + WS_CIN); const int ch0 = pn * 128 + wc * 16 + 4 * fq;
#pragma unroll
            for (int ai = 0; ai < 2; ++ai)
#pragma unroll
                for (int m = 0; m < 4; ++m) { const int row = row0g + ai * HALF + m * 16; const float r = rinv[row];
#pragma unroll
                    for (int bj = 0; bj < 2; ++bj) { const f32x4 v0 = acc[ai][bj][m][0] * r, v1 = acc[ai][bj][m][1] * r;
                        u32x2 w; w.x = cvt_pk_bf16(v0[0] * sigmoidf_(v1[0]), v0[1] * sigmoidf_(v1[1])); w.y = cvt_pk_bf16(v0[2] * sigmoidf_(v1[2]), v0[3] * sigmoidf_(v1[3]));
                        *(u32x2*)(ub + (size_t)row * 512 + ch0 + bj * 64) = w; } }
            return;
        }
        bf16_t* base = (bf16_t*)(ws + off);
        const float qs = (pn == 6 || pn == 7) ? 0.125f * 1.4426950408889634f : 1.f;
        const int row0 = u.pm * BM + wr * 64 + fr, col0 = colt + wc * 32 + 8 * fq;
#pragma unroll
        for (int ai = 0; ai < 2; ++ai)
#pragma unroll
            for (int m = 0; m < 4; ++m) { const int row = row0 + ai * HALF + m * 16; const float r = rinv[row] * qs; bf16_t* rowp = base + (size_t)row * ld + col0;
#pragma unroll
                for (int bj = 0; bj < 2; ++bj) { const f32x4 v0 = acc[ai][bj][m][0] * r, v1 = acc[ai][bj][m][1] * r;
                    u32x4 w; w.x = cvt_pk_bf16(v0[0], v0[1]); w.y = cvt_pk_bf16(v0[2], v0[3]); w.z = cvt_pk_bf16(v1[0], v1[1]); w.w = cvt_pk_bf16(v1[2], v1[3]);
                    *(u32x4*)(rowp + bj * HALF) = w; } }
        if (pn == 12 && wc >= 2) {
            bf16_t* vt = (bf16_t*)(ws + WS_VT); const int d0 = (wc - 2) * 32 + 8 * fq;
#pragma unroll
            for (int ai = 0; ai < 2; ++ai)
#pragma unroll
                for (int m = 0; m < 4; ++m) { const int row = row0 + ai * HALF + m * 16; const float r = rinv[row]; const int bb = row >> 11, sq = row & 2047, k5 = sq & 31;
                    const int pos = (sq & ~31) + ((k5 & 0x13) | ((k5 & 4) << 1) | ((k5 & 8) >> 1)); bf16_t* vp = vt + ((size_t)bb * 64 + d0) * 2048 + pos;
                    const f32x4 v0 = acc[ai][0][m][0] * r, v1 = acc[ai][0][m][1] * r;
#pragma unroll
                    for (int e = 0; e < 4; ++e) { vp[(size_t)e * 2048] = f2bf(v0[e]); vp[(size_t)(4 + e) * 2048] = f2bf(v1[e]); } }
        }
    }
};
__device__ __forceinline__ f32x4 sig4lo(unsigned a, unsigned b) { return (f32x4){sigmoidf_(bflo(a)), sigmoidf_(bfhi(a)), sigmoidf_(bflo(b)), sigmoidf_(bfhi(b))}; }
struct EpiOutA {
    static constexpr bool PERM = true, AFTER_DRAIN = false;
    const bf16_t* ga; bf16_t* part;
    __device__ __forceinline__ void operator()(const f32x4 (&acc)[2][2][4][2], const Unit& u, int wr, int wc, int fr, int fq) const {
        const int row0 = u.pm * BM + wr * 64 + fr, col0 = u.pn * BM + wc * 32 + 8 * fq;
#pragma unroll
        for (int ai = 0; ai < 2; ++ai)
#pragma unroll
            for (int m = 0; m < 4; ++m) { const size_t idx = (size_t)(row0 + ai * HALF + m * 16) * D + col0;
#pragma unroll
                for (int bj = 0; bj < 2; ++bj) { const u32x4 g = *(const u32x4*)(ga + idx + bj * HALF);
                    const f32x4 v0 = sig4lo(g.x, g.y) * acc[ai][bj][m][0], v1 = sig4lo(g.z, g.w) * acc[ai][bj][m][1];
                    u32x4 w; w.x = cvt_pk_bf16(v0[0], v0[1]); w.y = cvt_pk_bf16(v0[2], v0[3]); w.z = cvt_pk_bf16(v1[0], v1[1]); w.w = cvt_pk_bf16(v1[2], v1[3]);
                    *(u32x4*)(part + idx + bj * HALF) = w; } }
    }
};
__device__ __forceinline__ f32x4 bf4lo(unsigned a, unsigned b) { return (f32x4){bflo(a), bfhi(a), bflo(b), bfhi(b)}; }
struct EpiOutB {
    static constexpr bool PERM = true, AFTER_DRAIN = false;
    const bf16_t* gb; const bf16_t* part; bf16_t* mrg;
    __device__ __forceinline__ void operator()(const f32x4 (&acc)[2][2][4][2], const Unit& u, int wr, int wc, int fr, int fq) const {
        const int row0 = u.pm * BM + wr * 64 + fr, col0 = u.pn * BM + wc * 32 + 8 * fq;
#pragma unroll
        for (int ai = 0; ai < 2; ++ai)
#pragma unroll
            for (int m = 0; m < 4; ++m) { const size_t idx = (size_t)(row0 + ai * HALF + m * 16) * D + col0;
#pragma unroll
                for (int bj = 0; bj < 2; ++bj) { const u32x4 g = *(const u32x4*)(gb + idx + bj * HALF), pw = *(const u32x4*)(part + idx + bj * HALF);
                    const f32x4 v0 = bf4lo(pw.x, pw.y) + sig4lo(g.x, g.y) * acc[ai][bj][m][0], v1 = bf4lo(pw.z, pw.w) + sig4lo(g.z, g.w) * acc[ai][bj][m][1];
                    u32x4 w; w.x = cvt_pk_bf16(v0[0], v0[1]); w.y = cvt_pk_bf16(v0[2], v0[3]); w.z = cvt_pk_bf16(v1[0], v1[1]); w.w = cvt_pk_bf16(v1[2], v1[3]);
                    *(u32x4*)(mrg + idx + bj * HALF) = w; } }
    }
};
__device__ __forceinline__ float sq4(const f32x4 v) { return (v[0] * v[0] + v[1] * v[1]) + (v[2] * v[2] + v[3] * v[3]); }
struct EpiWo {
    static constexpr bool PERM = true, AFTER_DRAIN = false;
    const float* x; bf16_t* x1b; float* ssp;
    __device__ __forceinline__ void operator()(const f32x4 (&acc)[2][2][4][2], const Unit& u, int wr, int wc, int fr, int fq) const {
        const int row0 = u.pm * BM + wr * 64 + fr, col0 = u.pn * BM + wc * 32 + 8 * fq;
#pragma unroll
        for (int ai = 0; ai < 2; ++ai)
#pragma unroll
            for (int m = 0; m < 4; ++m) { const int row = row0 + ai * HALF + m * 16; const size_t idx = (size_t)row * D + col0; float s = 0.f;
#pragma unroll
                for (int bj = 0; bj < 2; ++bj) { const f32x4 v0 = *(const f32x4*)(x + idx + bj * HALF) + acc[ai][bj][m][0], v1 = *(const f32x4*)(x + idx + bj * HALF + 4) + acc[ai][bj][m][1];
                    s += sq4(v0) + sq4(v1);
                    u32x4 w; w.x = cvt_pk_bf16(v0[0], v0[1]); w.y = cvt_pk_bf16(v0[2], v0[3]); w.z = cvt_pk_bf16(v1[0], v1[1]); w.w = cvt_pk_bf16(v1[2], v1[3]);
                    *(u32x4*)(x1b + idx + bj * HALF) = w; }
                s += __shfl_xor(s, 16); s += __shfl_xor(s, 32);
                if (fq == 0) ssp[(size_t)row * 16 + u.pn * 4 + wc] = s; }
    }
};
struct EpiPP {
    static constexpr bool PERM = true, AFTER_DRAIN = false;
    bf16_t* pp;
    __device__ __forceinline__ void operator()(const f32x4 (&acc)[2][2][4][2], const Unit& u, int wr, int wc, int fr, int fq) const {
        const int row0 = u.pm * BM + wr * 64 + fr, col0 = u.pn * BM + wc * 32 + 8 * fq;
#pragma unroll
        for (int ai = 0; ai < 2; ++ai)
#pragma unroll
            for (int m = 0; m < 4; ++m) { const size_t idx = (size_t)(row0 + ai * HALF + m * 16) * D + col0;
#pragma unroll
                for (int bj = 0; bj < 2; ++bj) { const f32x4 v0 = acc[ai][bj][m][0], v1 = acc[ai][bj][m][1];
                    u32x4 w; w.x = cvt_pk_bf16(v0[0], v0[1]); w.y = cvt_pk_bf16(v0[2], v0[3]); w.z = cvt_pk_bf16(v1[0], v1[1]); w.w = cvt_pk_bf16(v1[2], v1[3]);
                    *(u32x4*)(pp + idx + bj * HALF) = w; } }
    }
};
struct EpiGate {
    static constexpr bool PERM = true, AFTER_DRAIN = false;
    const bf16_t* x1b; const bf16_t* pp; bf16_t* x2b; const float* ssp1; float* ssp2;
    __device__ __forceinline__ void operator()(const f32x4 (&acc)[2][2][4][2], const Unit& u, int wr, int wc, int fr, int fq) const {
        const int row0 = u.pm * BM + wr * 64 + fr, col0 = u.pn * BM + wc * 32 + 8 * fq;
#pragma unroll
        for (int ai = 0; ai < 2; ++ai)
#pragma unroll
            for (int m = 0; m < 4; ++m) { const int row = row0 + ai * HALF + m * 16; const size_t idx = (size_t)row * D + col0;
                const f32x4* sp = (const f32x4*)(ssp1 + (size_t)row * 16); const f32x4 t4 = (sp[0] + sp[1]) + (sp[2] + sp[3]);
                const float r1 = rsqrtf(((t4[0] + t4[1]) + (t4[2] + t4[3])) * (1.f / D) + EPS); float s = 0.f;
#pragma unroll
                for (int bj = 0; bj < 2; ++bj) { const u32x4 pw = *(const u32x4*)(pp + idx + bj * HALF), xw = *(const u32x4*)(x1b + idx + bj * HALF); const f32x4 a0 = acc[ai][bj][m][0] * r1, a1 = acc[ai][bj][m][1] * r1;
                    const f32x4 g0 = (f32x4){sigmoidf_(a0[0]), sigmoidf_(a0[1]), sigmoidf_(a0[2]), sigmoidf_(a0[3])}, g1 = (f32x4){sigmoidf_(a1[0]), sigmoidf_(a1[1]), sigmoidf_(a1[2]), sigmoidf_(a1[3])};
                    const f32x4 v0 = bf4lo(xw.x, xw.y) + g0 * bf4lo(pw.x, pw.y), v1 = bf4lo(xw.z, xw.w) + g1 * bf4lo(pw.z, pw.w);
                    s += sq4(v0) + sq4(v1);
                    u32x4 w; w.x = cvt_pk_bf16(v0[0], v0[1]); w.y = cvt_pk_bf16(v0[2], v0[3]); w.z = cvt_pk_bf16(v1[0], v1[1]); w.w = cvt_pk_bf16(v1[2], v1[3]);
                    *(u32x4*)(x2b + idx + bj * HALF) = w; }
                s += __shfl_xor(s, 16); s += __shfl_xor(s, 32);
                if (fq == 0) ssp2[(size_t)row * 16 + u.pn * 4 + wc] = s; }
    }
};
template <class Epi, class Sched, bool ALIGN_EPI = false, bool SP2 = false>
__device__ __forceinline__ void gemm_phase(PG8_LAS unsigned char* lds, const Gemm g, const Sched& S, const Epi& E) {
    int tid_ = threadIdx.x; asm volatile("" : "+v"(tid_));
    const int tid = tid_, wid = __builtin_amdgcn_readfirstlane(tid >> 6), lane = tid & 63, wr = wid >> 2, wc = wid & 3, fr = lane & 15, fq = lane >> 4;
    int K_ = g.K; asm volatile("" : "+s"(K_));
    const int K = K_, nt = K / BK;
    unsigned voffA[2], voffB[2];
#pragma unroll
    for (int i = 0; i < 2; ++i) { int R, C; stage_rc(tid * 16 + i * 8192, R, C); const int Rb = Epi::PERM ? ((R & ~31) + perm32(R & 31)) : R;
        voffA[i] = (unsigned)(R * K + C) * 2u; voffB[i] = (unsigned)(Rb * K + C) * 2u; }
    const size_t kstep = (size_t)(BK * 2);
    const size_t hstep = (size_t)HALF * K * 2;
    const size_t tstep = 2 * hstep;
    const unsigned ldsw = (unsigned)wid * 1024u;
    const int aoff = lds_byte(wr * 64 + fr, fq * 8), boff = lds_byte(wc * 32 + fr, fq * 8);
#define PG8_SA(b, h) (((b) * 2 + (h)) * HTB)
#define PG8_SB(b, h) ((4 + (b) * 2 + (h)) * HTB)
#define PG8_STAGE(bufoff, gbase, voff) do { _Pragma("unroll") for (int _i = 0; _i < 2; ++_i) \
        __builtin_amdgcn_global_load_lds((const unsigned*)((const char*)(gbase) + (voff)[_i]), (PG8_LAS unsigned*)(lds + (bufoff) + ldsw + _i * 8192), 16, 0, 0); } while (0)
#define PG8_LDA(dst, b, h) do { _Pragma("unroll") for (int m = 0; m < 4; ++m) _Pragma("unroll") for (int k = 0; k < 2; ++k) dst[m][k] = *(const PG8_LAS bf16x8*)(lds + PG8_SA(b, h) + aoff + m * 2048 + k * 1024); } while (0)
#define PG8_LDB(dst, b, h) do { _Pragma("unroll") for (int n = 0; n < 2; ++n) _Pragma("unroll") for (int k = 0; k < 2; ++k) dst[n][k] = *(const PG8_LAS bf16x8*)(lds + PG8_SB(b, h) + boff + n * 2048 + k * 1024); } while (0)
#define PG8_MMA(ai, bj, At, Bt) do { __builtin_amdgcn_s_setprio(1); _Pragma("unroll") for (int m = 0; m < 4; ++m) _Pragma("unroll") for (int n = 0; n < 2; ++n) _Pragma("unroll") for (int k = 0; k < 2; ++k) \
        acc[ai][bj][m][n] = __builtin_amdgcn_mfma_f32_16x16x32_bf16(Bt[n][k], At[m][k], acc[ai][bj][m][n], 0, 0, 0); __builtin_amdgcn_s_setprio(0); } while (0)
#define PG8_WAIT_V(n) asm volatile("s_waitcnt vmcnt(" #n ")" ::: "memory")
#define PG8_WAIT_L(n) asm volatile("s_waitcnt lgkmcnt(" #n ")" ::: "memory")
#define PG8_BAR __builtin_amdgcn_s_barrier()
#define PG8_SCHED __builtin_amdgcn_sched_barrier(0)
    Unit cur, nxt; int ui = 0;
    if (!S.next(0, cur)) return;
    f32x4 acc[2][2][4][2];
#pragma unroll
    for (int a = 0; a < 2; ++a)
#pragma unroll
        for (int b = 0; b < 2; ++b)
#pragma unroll
            for (int m = 0; m < 4; ++m)
#pragma unroll
                for (int n = 0; n < 2; ++n) acc[a][b][m][n] = (f32x4){0.f, 0.f, 0.f, 0.f};
    bf16x8 At[4][2], B0[2][2], B1[2][2];
    const char* cA = (const char*)g.A + (size_t)cur.pm * tstep; const char* cB = (const char*)g.Bt + (size_t)cur.pn * tstep;
    S.a_ready(cur);
    if constexpr (SP2) {
        PG8_STAGE(PG8_SB(0, 0), cB, voffB); PG8_STAGE(PG8_SB(0, 1), cB + hstep, voffB); PG8_STAGE(PG8_SA(0, 0), cA, voffA); PG8_STAGE(PG8_SA(0, 1), cA + hstep, voffA);
        if (wr == 1) PG8_BAR;
        PG8_WAIT_V(2); PG8_BAR;
        PG8_STAGE(PG8_SB(1, 0), cB + kstep, voffB); PG8_STAGE(PG8_SA(1, 0), cA + kstep, voffA); PG8_STAGE(PG8_SB(1, 1), cB + hstep + kstep, voffB);
        PG8_WAIT_V(6); PG8_BAR;
    } else {
        PG8_STAGE(PG8_SB(0, 0), cB, voffB); PG8_STAGE(PG8_SA(0, 0), cA, voffA); PG8_STAGE(PG8_SB(0, 1), cB + hstep, voffB); PG8_STAGE(PG8_SA(0, 1), cA + hstep, voffA);
        if (wr == 1) PG8_BAR;
        PG8_WAIT_V(4); PG8_BAR;
        PG8_STAGE(PG8_SB(1, 0), cB + kstep, voffB); PG8_STAGE(PG8_SA(1, 0), cA + kstep, voffA); PG8_STAGE(PG8_SB(1, 1), cB + hstep + kstep, voffB);
        PG8_WAIT_V(6); PG8_BAR;
    }
    for (;;) {
        const bool has_next = S.next(ui + 1, nxt);
        const char* nA = has_next ? (const char*)g.A + (size_t)nxt.pm * tstep : cA; const char* nB = has_next ? (const char*)g.Bt + (size_t)nxt.pn * tstep : cB;
        for (int t = 0; t < nt; t += 2) {
            const bool last = (t == nt - 2);
            const char* a1 = cA + (size_t)(t + 1) * kstep;
            const char* a2 = last ? nA : cA + (size_t)(t + 2) * kstep; const char* b2 = last ? nB : cB + (size_t)(t + 2) * kstep;
            const char* a3 = a2 + kstep; const char* b3 = b2 + kstep;
            if (last && has_next) S.a_ready(nxt);
            if constexpr (SP2) {
            PG8_LDB(B0, 0, 0); PG8_LDB(B1, 0, 1); PG8_SCHED; PG8_LDA(At, 0, 0); PG8_STAGE(PG8_SA(1, 1), a1 + hstep, voffA);
            PG8_WAIT_V(8); PG8_WAIT_L(0); PG8_BAR; PG8_MMA(0, 0, At, B0); PG8_MMA(0, 1, At, B1); PG8_BAR; PG8_SCHED;
            PG8_LDA(At, 0, 1); PG8_STAGE(PG8_SB(0, 0), b2, voffB); PG8_STAGE(PG8_SB(0, 1), b2 + hstep, voffB); PG8_STAGE(PG8_SA(0, 0), a2, voffA);
            PG8_WAIT_V(8); PG8_WAIT_L(0); PG8_BAR; PG8_MMA(1, 0, At, B0); PG8_MMA(1, 1, At, B1); PG8_BAR; PG8_SCHED;
            PG8_LDB(B0, 1, 0); PG8_LDB(B1, 1, 1); PG8_SCHED; PG8_LDA(At, 1, 0); PG8_STAGE(PG8_SA(0, 1), a2 + hstep, voffA);
            PG8_WAIT_V(8); PG8_WAIT_L(0); PG8_BAR; PG8_MMA(0, 0, At, B0); PG8_MMA(0, 1, At, B1); PG8_BAR; PG8_SCHED;
            PG8_LDA(At, 1, 1); PG8_STAGE(PG8_SB(1, 0), b3, voffB); PG8_STAGE(PG8_SB(1, 1), b3 + hstep, voffB); PG8_STAGE(PG8_SA(1, 0), a3, voffA);
            PG8_WAIT_V(8); PG8_WAIT_L(0); PG8_BAR; PG8_MMA(1, 0, At, B0); PG8_MMA(1, 1, At, B1); PG8_BAR; PG8_SCHED;
            } else {
            PG8_LDB(B0, 0, 0); PG8_SCHED; PG8_LDA(At, 0, 0); PG8_STAGE(PG8_SA(1, 1), a1 + hstep, voffA);
            PG8_WAIT_L(8); PG8_BAR; PG8_WAIT_L(0); PG8_MMA(0, 0, At, B0); PG8_BAR; PG8_SCHED;
            PG8_LDB(B1, 0, 1); PG8_STAGE(PG8_SB(0, 0), b2, voffB);
            PG8_BAR; PG8_WAIT_L(0); PG8_MMA(0, 1, At, B1); PG8_BAR;
            PG8_LDA(At, 0, 1); PG8_STAGE(PG8_SA(0, 0), a2, voffA);
            PG8_BAR; PG8_WAIT_L(0); PG8_MMA(1, 0, At, B0); PG8_BAR; PG8_SCHED;
            PG8_STAGE(PG8_SB(0, 1), b2 + hstep, voffB);
            PG8_WAIT_V(6); PG8_BAR; PG8_MMA(1, 1, At, B1); PG8_BAR;
            PG8_LDB(B0, 1, 0); PG8_SCHED; PG8_LDA(At, 1, 0); PG8_STAGE(PG8_SA(0, 1), a2 + hstep, voffA);
            PG8_WAIT_L(8); PG8_BAR; PG8_WAIT_L(0); PG8_MMA(0, 0, At, B0); PG8_BAR; PG8_SCHED;
            PG8_LDB(B1, 1, 1); PG8_STAGE(PG8_SB(1, 0), b3, voffB);
            PG8_BAR; PG8_WAIT_L(0); PG8_MMA(0, 1, At, B1); PG8_BAR;
            PG8_LDA(At, 1, 1); PG8_STAGE(PG8_SA(1, 0), a3, voffA);
            PG8_BAR; PG8_WAIT_L(0); PG8_MMA(1, 0, At, B0); PG8_BAR; PG8_SCHED;
            PG8_STAGE(PG8_SB(1, 1), b3 + hstep, voffB);
            PG8_WAIT_V(6); PG8_BAR; PG8_MMA(1, 1, At, B1); PG8_BAR;
            }
        }
        if constexpr (ALIGN_EPI) { if (wr == 0) PG8_BAR; }
        if constexpr (!Epi::AFTER_DRAIN) { E(acc, cur, wr, wc, fr, fq); S.done(cur); }
        if (!has_next) break;
#pragma unroll
        for (int a = 0; a < 2; ++a)
#pragma unroll
            for (int b = 0; b < 2; ++b)
#pragma unroll
                for (int m = 0; m < 4; ++m)
#pragma unroll
                    for (int n = 0; n < 2; ++n) acc[a][b][m][n] = (f32x4){0.f, 0.f, 0.f, 0.f};
        cur = nxt; cA = nA; cB = nB; ++ui;
        if constexpr (ALIGN_EPI) { if (wr == 1) PG8_BAR; }
    }
    PG8_WAIT_V(0);
    if constexpr (!ALIGN_EPI) { if (wr == 0) PG8_BAR; }
    PG8_BAR;
    if constexpr (Epi::AFTER_DRAIN) { E.fused(acc, cur, wr, wc, fr, fq, lds, wid, lane); S.done(cur); }
#undef PG8_SA
#undef PG8_SB
#undef PG8_STAGE
#undef PG8_LDA
#undef PG8_LDB
#undef PG8_MMA
#undef PG8_WAIT_V
#undef PG8_WAIT_L
#undef PG8_BAR
#undef PG8_SCHED
}
}
#define XB_TMO      128
#define XB_XCNT(j)  (256  + 64 * (j))
#define XB_XSUB(j)  (1280 + 64 * (j))
#define XB_XGEN(j)  (2304 + 64 * (j))
#define XB_TOP      3328
#define XB_TOPGEN   3392
#define XCD_BAR_WORDS 3456
#define XB_SPIN_CAP (1u << 18)

__device__ __forceinline__ unsigned xb_ld(unsigned* p)              { return __hip_atomic_load(p, __ATOMIC_RELAXED, __HIP_MEMORY_SCOPE_AGENT); }
__device__ __forceinline__ unsigned xb_add(unsigned* p, unsigned v) { return __hip_atomic_fetch_add(p, v, __ATOMIC_RELAXED, __HIP_MEMORY_SCOPE_AGENT); }
__device__ __forceinline__ unsigned xb_xcc_id() { return (unsigned)__builtin_amdgcn_s_getreg((3 << 11) | 20) & 0xFu; }
#define XB_SPIN(cond, bar) do { unsigned _sp = 0; while (cond) { __builtin_amdgcn_s_sleep(1); \
    if ((++_sp & 255u) == 0u) { if (xb_ld(&(bar)[XB_TMO])) break; if (_sp > XB_SPIN_CAP) { atomicAdd(&(bar)[XB_TMO], 1u); break; } } } } while (0)

struct XcdBarrier {
    unsigned* bar; unsigned x;
    volatile LAS unsigned* st;
};

__device__ __forceinline__ XcdBarrier xcd_barrier_post(unsigned* bar, volatile LAS unsigned* st) {
    XcdBarrier b; b.bar = bar; b.x = xb_xcc_id(); b.st = st;
    if (threadIdx.x == 0) (void)xb_add(&bar[XB_XCNT(b.x)], 1u);
    return b;
}
__device__ __forceinline__ void xcd_barrier_complete(unsigned* bar, unsigned x, unsigned& nloc, unsigned& nx) {
    const unsigned G = gridDim.x * gridDim.y * gridDim.z;
    unsigned sum, cnt, mine, sp = 0u;
    for (;;) {
        sum = 0u; cnt = 0u; mine = 0u;
#pragma unroll
        for (unsigned j = 0; j < 16; ++j) { const unsigned c = xb_ld(&bar[XB_XCNT(j)]); sum += c; cnt += (c > 0u) ? 1u : 0u; mine = (j == x) ? c : mine; }
        if (sum == G) break;
        __builtin_amdgcn_s_sleep(1);
        if ((++sp & 255u) == 0u) { if (xb_ld(&bar[XB_TMO])) break; if (sp > XB_SPIN_CAP) { atomicAdd(&bar[XB_TMO], 1u); break; } }
    }
    nloc = mine > 0u ? mine : 1u; nx = cnt > 0u ? cnt : 1u;
}

__device__ __forceinline__ void xcd_barrier(const XcdBarrier& b) {
    asm volatile("s_waitcnt vmcnt(0)" ::: "memory");
    __syncthreads();
    if (threadIdx.x == 0) {
        unsigned* bar = b.bar;
        __builtin_amdgcn_s_waitcnt(0);
        unsigned nloc = b.st[0], nx = b.st[1];
        if (nloc == 0u) { xcd_barrier_complete(bar, b.x, nloc, nx); b.st[0] = nloc; b.st[1] = nx; }
        const unsigned old = xb_add(&bar[XB_XSUB(b.x)], 1u);
        const unsigned gen = old / nloc;
        if (old + 1u == (gen + 1u) * nloc) {
            __builtin_amdgcn_fence(__ATOMIC_RELEASE, "agent");
            asm volatile("s_waitcnt vmcnt(0)" ::: "memory");
            const unsigned og = xb_add(&bar[XB_TOP], 1u);
            const unsigned tg = og / nx;
            if (og + 1u == (tg + 1u) * nx) xb_add(&bar[XB_TOPGEN], 1u);
            else XB_SPIN(xb_ld(&bar[XB_TOPGEN]) == tg, bar);
            __builtin_amdgcn_fence(__ATOMIC_ACQUIRE, "agent");
            xb_add(&bar[XB_XGEN(b.x)], 1u);
            asm volatile("s_waitcnt vmcnt(0)" ::: "memory");
        } else {
            XB_SPIN(xb_ld(&bar[XB_XGEN(b.x)]) == gen, bar);
            __builtin_amdgcn_fence(__ATOMIC_ACQUIRE, "agent");
            asm volatile("s_waitcnt vmcnt(0)" ::: "memory");
        }
    }
    __syncthreads();
}
constexpr int NWAVES = 8;
constexpr int RING_OFF = 0, RING_BYTES = 131072;
constexpr int LDSCTL_OFF = RING_BYTES, MISC_OFF = LDSCTL_OFF + 320;
constexpr int LDS_BYTES = 147456;

struct Frame {
    LAS unsigned char* lds; volatile LAS unsigned* MISC;
    int tid, lane, wave, G, vcu;
    const float* in[15]; float* out; unsigned char* ws;
};

__device__ __forceinline__ void prep_w_item(const float* W, const float* gain, int K, int Nsrc, bool map, bf16_t* Wt, LAS float* scr, int item, int nblk, int lane) {
    const int kb = item / nblk, nb = item % nblk, k0 = 64 * kb, n0 = 32 * nb;
    const int nn = n0 + (lane & 31); const int e = map ? inmap(nn) : nn;
#pragma unroll 8
    for (int i = 0; i < 32; ++i) { const int kk = 2 * i + (lane >> 5); float v = 0.f;
        if (e >= 0) v = W[(size_t)(k0 + kk) * Nsrc + e] * (gain ? gain[k0 + kk] : 1.f);
        scr[kk * 33 + (lane & 31)] = v; }
    LDS_WAIT(); asm volatile("" ::: "memory");
    const int c = lane & 7;
#pragma unroll
    for (int j = 0; j < 4; ++j) { const int n = (lane >> 3) + 8 * j; const LAS float* s = scr + (8 * c) * 33 + n;
        u32x4 o; o.x = pk2(s[0 * 33], s[1 * 33]); o.y = pk2(s[2 * 33], s[3 * 33]); o.z = pk2(s[4 * 33], s[5 * 33]); o.w = pk2(s[6 * 33], s[7 * 33]);
        *(u32x4*)(Wt + (size_t)(n0 + n) * K + k0 + 8 * c) = o; }
    LDS_WAIT(); asm volatile("" ::: "memory");
}
__device__ __forceinline__ void p0_prep(Frame& F) {
    LAS float* scr = (LAS float*)(F.lds + RING_OFF + F.wave * 16384);
    int tid_ = threadIdx.x; asm volatile("" : "+v"(tid_));
    const int lane = tid_ & 63, gw = F.vcu * NWAVES + __builtin_amdgcn_readfirstlane(tid_ >> 6), NGW = F.G * NWAVES;
    unsigned char* ws = F.ws;
    constexpr int I_IN = (D / 64) * (NINP / 32), I_A = (DC / 64) * (D / 32), I_O = (D / 64) * (D / 32), I_P = (DPLE / 64) * (D / 32);
    constexpr int NITEMS = I_IN + 2 * I_A + 2 * I_O + I_P;
    for (int it = gw; it < NITEMS; it += NGW) {
        int r = it;
        if (r < I_IN) { prep_w_item(F.in[3], F.in[2], D, NIN, true, (bf16_t*)(ws + WS_WIN), scr, r, NINP / 32, lane); continue; } r -= I_IN;
        if (r < I_A) { prep_w_item(F.in[8], nullptr, DC, D, false, (bf16_t*)(ws + WS_WA), scr, r, D / 32, lane); continue; } r -= I_A;
        if (r < I_A) { prep_w_item(F.in[9], nullptr, DC, D, false, (bf16_t*)(ws + WS_WB), scr, r, D / 32, lane); continue; } r -= I_A;
        if (r < I_O) { prep_w_item(F.in[10], nullptr, D, D, false, (bf16_t*)(ws + WS_WO), scr, r, D / 32, lane); continue; } r -= I_O;
        if (r < I_O) { prep_w_item(F.in[12], F.in[11], D, D, false, (bf16_t*)(ws + WS_WG), scr, r, D / 32, lane); continue; } r -= I_O;
        prep_w_item(F.in[13], nullptr, DPLE, D, false, (bf16_t*)(ws + WS_WP), scr, r, D / 32, lane);
    }
    const float* x = F.in[0]; const float* p = F.in[1]; bf16_t* xb = (bf16_t*)(ws + WS_XB); bf16_t* pb = (bf16_t*)(ws + WS_PB); float* rinv = (float*)(ws + WS_RINV);
    for (int m = gw; m < M; m += NGW) {
        const f32x4* xr = (const f32x4*)(x + (size_t)m * D) + lane; f32x4 v[4]; float s = 0.f;
#pragma unroll
        for (int j = 0; j < 4; ++j) { v[j] = xr[64 * j]; s += (v[j].x * v[j].x + v[j].y * v[j].y) + (v[j].z * v[j].z + v[j].w * v[j].w); }
        s = wave_sum(s);
        if (lane == 0) rinv[m] = rsqrtf(s * (1.f / D) + EPS);
        u32x2* o = (u32x2*)(xb + (size_t)m * D) + lane;
#pragma unroll
        for (int j = 0; j < 4; ++j) { u32x2 w; w.x = pk2(v[j].x, v[j].y); w.y = pk2(v[j].z, v[j].w); o[64 * j] = w; }
        const f32x4 pv = ((const f32x4*)(p + (size_t)m * DPLE))[lane];
        u32x2 w; w.x = pk2(pv.x, pv.y); w.y = pk2(pv.z, pv.w); ((u32x2*)(pb + (size_t)m * DPLE))[lane] = w;
    }
}

typedef float f32x2v __attribute__((ext_vector_type(2)));
constexpr int CF_TOK = 128;
__device__ __forceinline__ float wave_sum_dpp(float v) {
    v += __builtin_bit_cast(float, __builtin_amdgcn_update_dpp(0, __builtin_bit_cast(int, v), 0xB1, 0xf, 0xf, false));
    v += __builtin_bit_cast(float, __builtin_amdgcn_update_dpp(0, __builtin_bit_cast(int, v), 0x4E, 0xf, 0xf, false));
    v += __builtin_bit_cast(float, __builtin_amdgcn_update_dpp(0, __builtin_bit_cast(int, v), 0x141, 0xf, 0xf, false));
    v += __builtin_bit_cast(float, __builtin_amdgcn_update_dpp(0, __builtin_bit_cast(int, v), 0x140, 0xf, 0xf, false));
    v += __shfl_xor(v, 16); v += __shfl_xor(v, 32);
    return v;
}
__device__ __forceinline__ void p2_conformer(Frame& F) {
    const bf16_t* ub = (const bf16_t*)(F.ws + WS_CIN); const bf16_t* cz = (const bf16_t*)(F.ws + WS_CZ); bf16_t* ya = (bf16_t*)(F.ws + WS_YA);
    const float* conv_w = F.in[4];
    int tid_ = threadIdx.x; asm volatile("" : "+v"(tid_));
    const int cp = tid_ & 255, th = tid_ >> 8, lane = tid_ & 63, wv = __builtin_amdgcn_readfirstlane(tid_ >> 6);
    f32x2v w2[CWID];
#pragma unroll
    for (int j = 0; j < CWID; ++j) w2[j] = *(const f32x2v*)(conv_w + j * DC + 2 * cp);
    const f32x2v cb2 = *(const f32x2v*)(F.in[5] + 2 * cp);
    f32x4 lg[2], lb[2];
    lg[0] = *(const f32x4*)(F.in[6] + 8 * lane); lg[1] = *(const f32x4*)(F.in[6] + 8 * lane + 4); lb[0] = *(const f32x4*)(F.in[7] + 8 * lane); lb[1] = *(const f32x4*)(F.in[7] + 8 * lane + 4);
    for (int item = F.vcu; item < M / CF_TOK; item += F.G) {
        const int b = item / (SEQ / CF_TOK), t0 = (item % (SEQ / CF_TOK)) * CF_TOK; const size_t rowb = (size_t)b * SEQ; const int ts = t0 + 64 * th;
        f32x2v win[38];
#pragma unroll
        for (int i = 0; i < 30; ++i) { const int t = ts - 30 + i; unsigned v = 0u; if (t >= 0) v = *(const unsigned*)(ub + (rowb + t) * 512 + 2 * cp); win[i] = (f32x2v){bflo(v), bfhi(v)}; }
        unsigned nx[8];
#pragma unroll
        for (int i = 0; i < 8; ++i) nx[i] = *(const unsigned*)(ub + (rowb + ts + i) * 512 + 2 * cp);
        const int erow = 2 * wv, eth = erow >> 3, ei = erow & 7;
        for (int st = 0; st < 8; ++st) {
            LAS unsigned char* ct = F.lds + RING_OFF + (st & 1) * 32768;
#pragma unroll
            for (int i = 0; i < 8; ++i) win[30 + i] = (f32x2v){bflo(nx[i]), bfhi(nx[i])};
            if (st < 7) {
#pragma unroll
                for (int i = 0; i < 8; ++i) nx[i] = *(const unsigned*)(ub + (rowb + ts + 8 * (st + 1) + i) * 512 + 2 * cp); }
            const size_t er0 = rowb + t0 + 64 * eth + 8 * st + ei;
            const u32x4 z0 = *(const u32x4*)(cz + er0 * 512 + 8 * lane), z1 = *(const u32x4*)(cz + (er0 + 1) * 512 + 8 * lane);
#pragma unroll
            for (int i = 0; i < 8; ++i) { f32x2v c = cb2;
#pragma unroll
                for (int j = 0; j < CWID; ++j) c = __builtin_elementwise_fma(w2[j], win[i + j], c);
                *(LAS f32x2v*)(ct + (th * 8 + i) * 2048 + cp * 8) = c; }
#pragma unroll
            for (int i = 0; i < 30; ++i) win[i] = win[i + 8];
            __syncthreads();
#pragma unroll
            for (int k = 0; k < 2; ++k) {
                const f32x4 c0 = *(const LAS f32x4*)(ct + (erow + k) * 2048 + lane * 32), c1 = *(const LAS f32x4*)(ct + (erow + k) * 2048 + lane * 32 + 16);
                float s1 = (c0[0] + c0[1]) + (c0[2] + c0[3]) + (c1[0] + c1[1]) + (c1[2] + c1[3]);
                float s2 = (c0[0] * c0[0] + c0[1] * c0[1]) + (c0[2] * c0[2] + c0[3] * c0[3]) + (c1[0] * c1[0] + c1[1] * c1[1]) + (c1[2] * c1[2] + c1[3] * c1[3]);
                s1 = wave_sum_dpp(s1); s2 = wave_sum_dpp(s2);
                const float mu = s1 * (1.f / DC), var = fmaxf(s2 * (1.f / DC) - mu * mu, 0.f), rs = rsqrtf(var + EPS);
                const u32x4 zz = k ? z1 : z0;
                const f32x4 y0 = (c0 - mu) * rs * lg[0] + lb[0], y1 = (c1 - mu) * rs * lg[1] + lb[1];
                const f32x4 zf0 = (f32x4){bflo(zz.x), bfhi(zz.x), bflo(zz.y), bfhi(zz.y)}, zf1 = (f32x4){bflo(zz.z), bfhi(zz.z), bflo(zz.w), bfhi(zz.w)};
                u32x4 o; o.x = pk2(siluf_(y0[0]) * siluf_(zf0[0]), siluf_(y0[1]) * siluf_(zf0[1])); o.y = pk2(siluf_(y0[2]) * siluf_(zf0[2]), siluf_(y0[3]) * siluf_(zf0[3]));
                o.z = pk2(siluf_(y1[0]) * siluf_(zf1[0]), siluf_(y1[1]) * siluf_(zf1[1])); o.w = pk2(siluf_(y1[2]) * siluf_(zf1[2]), siluf_(y1[3]) * siluf_(zf1[3]));
                *(u32x4*)(ya + (er0 + k) * 512 + 8 * lane) = o; }
        }
        __syncthreads();
    }
}

#ifndef REP_PASS1
#define REP_PASS1 1
#endif
#ifndef REP_SEL
#define REP_SEL 1
#endif
#ifndef REP_PASS2
#define REP_PASS2 1
#endif
__device__ __forceinline__ float max3f_(float a, float b, float c) { float r; asm("v_max3_f32 %0, %1, %2, %3" : "=v"(r) : "v"(a), "v"(b), "v"(c)); return r; }
__device__ __forceinline__ float relu_(float a) { float r; asm("v_max_f32_e32 %0, 0, %1" : "=v"(r) : "v"(a)); return r; }
typedef short bf16x8 __attribute__((ext_vector_type(8)));
typedef float f32x16 __attribute__((ext_vector_type(16)));
__device__ __forceinline__ unsigned skey(float f) { const unsigned u = __float_as_uint(f + 0.f); return (u & 0x80000000u) ? ~u : (u | 0x80000000u); }
__device__ __forceinline__ int half_sum(int v) {
    v += __builtin_amdgcn_update_dpp(0, v, 0xB1, 0xf, 0xf, false);
    v += __builtin_amdgcn_update_dpp(0, v, 0x4E, 0xf, 0xf, false);
    v += __builtin_amdgcn_update_dpp(0, v, 0x141, 0xf, 0xf, false);
    v += __builtin_amdgcn_update_dpp(0, v, 0x140, 0xf, 0xf, false);
    v += __shfl_xor(v, 16);
    return v;
}
__device__ __forceinline__ void pk_count_below4(unsigned& acc, unsigned cand2, unsigned k0, unsigned k1, unsigned k2, unsigned k3, unsigned one2) {
    unsigned t0, t1;
    asm("v_pk_sub_u16 %0, %3, %4 clamp\n\tv_pk_sub_u16 %1, %3, %5 clamp\n\tv_pk_min_u16 %0, %0, %8\n\tv_pk_min_u16 %1, %1, %8\n\tv_pk_add_u16 %2, %2, %0\n\tv_pk_add_u16 %2, %2, %1\n\t"
        "v_pk_sub_u16 %0, %3, %6 clamp\n\tv_pk_sub_u16 %1, %3, %7 clamp\n\tv_pk_min_u16 %0, %0, %8\n\tv_pk_min_u16 %1, %1, %8\n\tv_pk_add_u16 %2, %2, %0\n\tv_pk_add_u16 %2, %2, %1"
        : "=&v"(t0), "=&v"(t1), "+v"(acc) : "v"(cand2), "v"(k0), "v"(k1), "v"(k2), "v"(k3), "v"(one2));
}
__device__ __forceinline__ void attn_pass1_select(Frame& F, int b, int qb, LAS unsigned char* lds, unsigned (&mAo)[2], unsigned (&mBo)[2]) {
    int tid_ = threadIdx.x; asm volatile("" : "+v"(tid_));
    const int lane = tid_ & 63, w = __builtin_amdgcn_readfirstlane(tid_ >> 6), col = lane & 31, half = lane >> 5;
    const bf16_t* iq = (const bf16_t*)(F.ws + WS_IQ); const bf16_t* sm = (const bf16_t*)(F.ws + WS_SM);
    const size_t rowb = (size_t)b * SEQ; const int t0 = 32 * qb; const size_t m0w = rowb + t0 + 4 * w;
    bf16x8 aq[4];
    { const int r = col, half_r = (r >> 2) & 1, qsel = r >> 4, head = (r & 3) + 4 * ((r >> 3) & 1), ql = 2 * half_r + qsel;
#pragma unroll
      for (int ks = 0; ks < 4; ++ks) aq[ks] = *(const bf16x8*)(iq + (m0w + ql) * 512 + head * 64 + 16 * ks + 8 * half); }
    float wr[16];
    { const u32x4 va = *(const u32x4*)(sm + (m0w + 2 * half) * 256 + 192), vb = *(const u32x4*)(sm + (m0w + 2 * half + 1) * 256 + 192);
      const float wa[8] = {bflo(va.x), bfhi(va.x), bflo(va.y), bfhi(va.y), bflo(va.z), bfhi(va.z), bflo(va.w), bfhi(va.w)};
      const float wb[8] = {bflo(vb.x), bfhi(vb.x), bflo(vb.y), bfhi(vb.y), bflo(vb.z), bfhi(vb.z), bflo(vb.w), bfhi(vb.w)};
      const float sc = 0.125f * 0.35355339059327373f;
#pragma unroll
      for (int i = 0; i < 8; ++i) { wr[i] = wa[(i & 3) + 4 * (i >> 2)] * sc; wr[8 + i] = wb[(i & 3) + 4 * (i >> 2)] * sc; } }
    LAS f32x4* wl = (LAS f32x4*)(lds + 65536 + w * 128 + half * 64);
    if (col == 0) {
#pragma unroll
        for (int i = 0; i < 4; ++i) wl[i] = (f32x4){wr[4 * i], wr[4 * i + 1], wr[4 * i + 2], wr[4 * i + 3]}; }
    int offk[4];
#pragma unroll
    for (int ks = 0; ks < 4; ++ks) offk[ks] = col * 128 + ((((2 * ks + half) ^ ((col >> 1) & 7))) << 4);
    const int nch = qb / 8 + 1;
    unsigned vok[2];
#pragma unroll
    for (int i_ = 0; i_ < 2; ++i_) vok[i_] = (unsigned)((lane >> 3) * 512 + 16 * ((lane & 7) ^ ((4 * i_ + (lane >> 4)) & 7)));
#define AT_STAGE(c, bufsel) do { _Pragma("unroll") for (int i_ = 0; i_ < 4; ++i_) { const int seg = 4 * w + i_; unsigned vo_ = vok[i_ & 1]; asm volatile("" : "+v"(vo_)); \
        __builtin_amdgcn_global_load_lds((const unsigned*)((const char*)sm + ((rowb + 256 * (c) + 8 * seg) * 256 + 128) * 2 + vo_), (LAS unsigned*)(lds + (bufsel) * 32768 + seg * 1024), 16, 0, 0); } } while (0)
    unsigned kA[64], kB[64];
    const int sh = 8 * (8 - nch);
    for (int rep1_ = 0; rep1_ < REP_PASS1; ++rep1_) {
#pragma unroll
    for (int i = 0; i < 64; ++i) { kA[i] = 0u; kB[i] = 0u; }
    AT_STAGE(0, 0);
    asm volatile("s_waitcnt vmcnt(0)" ::: "memory"); __syncthreads();
    for (int c = 0; c < nch; ++c) {
        if (c + 1 < nch) AT_STAGE(c + 1, (c + 1) & 1);
#pragma unroll
        for (int i = 0; i < 56; ++i) { kA[i] = kA[i + 8]; kB[i] = kB[i + 8]; }
        const LAS unsigned char* img = lds + (c & 1) * 32768;
#pragma unroll
        for (int jj = 0; jj < 8; ++jj) { const int dq = qb - (8 * c + jj);
            bf16x8 bk[4];
#pragma unroll
            for (int ks = 0; ks < 4; ++ks) bk[ks] = *(const LAS bf16x8*)(img + jj * 4096 + offk[ks]);
            f32x16 acc = {0.f, 0.f, 0.f, 0.f, 0.f, 0.f, 0.f, 0.f, 0.f, 0.f, 0.f, 0.f, 0.f, 0.f, 0.f, 0.f};
#pragma unroll
            for (int ks = 0; ks < 4; ++ks) acc = __builtin_amdgcn_mfma_f32_32x32x16_bf16(aq[ks], bk[ks], acc, 0, 0, 0);
            float sA = 0.f, sB = 0.f;
            { const f32x4 w0 = wl[0], w1 = wl[1], w2 = wl[2], w3 = wl[3];
#pragma unroll
              for (int i = 0; i < 4; ++i) { sA = fmaf(w0[i], __builtin_amdgcn_fmed3f(acc[i], 0.f, INFINITY), sA); sA = fmaf(w1[i], __builtin_amdgcn_fmed3f(acc[4 + i], 0.f, INFINITY), sA);
                                            sB = fmaf(w2[i], __builtin_amdgcn_fmed3f(acc[8 + i], 0.f, INFINITY), sB); sB = fmaf(w3[i], __builtin_amdgcn_fmed3f(acc[12 + i], 0.f, INFINITY), sB); } }
            const int limA = dq > 0 ? 31 : (dq == 0 ? 4 * w + 2 * half : -1), limB = dq > 0 ? 31 : (dq == 0 ? 4 * w + 2 * half + 1 : -1);
            kA[56 + jj] = (col <= limA) ? skey(sA) : 0u; kB[56 + jj] = (col <= limB) ? skey(sB) : 0u;
            __builtin_amdgcn_sched_barrier(0);
        }
        asm volatile("s_waitcnt vmcnt(0)" ::: "memory"); __syncthreads();
    }
    }
#undef AT_STAGE
    const int nA = t0 + 4 * w + 2 * half + 1, nB = nA + 1;
    unsigned prefA = 0u, prefB = 0u, thrA = 1u, thrB = 1u; bool exA = nA <= TOPK, exB = nB <= TOPK;
    unsigned pA[32], pB[32];
#pragma unroll
    for (int i = 0; i < 32; ++i) { pA[i] = (kA[2 * i] >> 16) | (kA[2 * i + 1] & 0xffff0000u); pB[i] = (kB[2 * i] >> 16) | (kB[2 * i + 1] & 0xffff0000u); }
    const int nproc = 8 * nch;
    for (int reps_ = 0; reps_ < REP_SEL; ++reps_) {
    prefA = 0u; prefB = 0u; thrA = 1u; thrB = 1u; exA = nA <= TOPK; exB = nB <= TOPK; asm volatile("" : "+v"(prefA), "+v"(prefB));
    for (int bit = 31; bit >= 16; --bit) {
        if (__all(exA && exB)) break;
        const unsigned candA = prefA | (1u << bit), candB = prefB | (1u << bit);
        const unsigned cA2 = (candA >> 16) * 0x10001u, cB2 = (candB >> 16) * 0x10001u; unsigned one2 = 0x00010001u; asm volatile("" : "+v"(one2));
        unsigned aA = 0u, aB = 0u;
#pragma unroll
        for (int g = 0; g < 8; ++g) if (g >= 8 - nch) {
            pk_count_below4(aA, cA2, pA[4 * g], pA[4 * g + 1], pA[4 * g + 2], pA[4 * g + 3], one2); pk_count_below4(aB, cB2, pB[4 * g], pB[4 * g + 1], pB[4 * g + 2], pB[4 * g + 3], one2); }
        const int cA = half_sum(nproc - (int)(aA & 0xffffu) - (int)(aA >> 16)), cB = half_sum(nproc - (int)(aB & 0xffffu) - (int)(aB >> 16));
        if (!exA) { if (cA == TOPK) { thrA = candA; exA = true; } else if (cA > TOPK) prefA = candA; }
        if (!exB) { if (cB == TOPK) { thrB = candB; exB = true; } else if (cB > TOPK) prefB = candB; }
    }
    for (int bit = 15; bit >= 0; --bit) {
        if (__all(exA && exB)) break;
        const unsigned candA = prefA | (1u << bit), candB = prefB | (1u << bit);
        int cA = 0, cB = 0;
#pragma unroll
        for (int g = 0; g < 8; ++g) if (g >= 8 - nch) {
#pragma unroll
            for (int jj = 0; jj < 8; ++jj) { cA += (kA[8 * g + jj] >= candA) ? 1 : 0; cB += (kB[8 * g + jj] >= candB) ? 1 : 0; } }
        cA = half_sum(cA); cB = half_sum(cB);
        if (!exA) { if (cA == TOPK) { thrA = candA; exA = true; } else if (cA > TOPK) prefA = candA; }
        if (!exB) { if (cB == TOPK) { thrB = candB; exB = true; } else if (cB > TOPK) prefB = candB; }
    }
    }
    const unsigned tA = exA ? thrA : prefA + 1u, tB = exB ? thrB : prefB + 1u;
    unsigned mA[2] = {0u, 0u}, mB[2] = {0u, 0u};
#pragma unroll
    for (int j = 0; j < 64; ++j) { mA[j >> 5] |= (kA[j] >= tA) ? (1u << (j & 31)) : 0u; mB[j >> 5] |= (kB[j] >= tB) ? (1u << (j & 31)) : 0u; }
    if (!__all(exA && exB)) {
        const int needA = TOPK - half_sum(__popc(mA[0]) + __popc(mA[1])), needB = TOPK - half_sum(__popc(mB[0]) + __popc(mB[1]));
        int befA = 0, befB = 0; const unsigned below = (1u << col) - 1u;
#pragma unroll
        for (int j = 0; j < 64; ++j) {
            const bool eA = !exA && kA[j] == prefA, eB = !exB && kB[j] == prefB;
            const unsigned long long balA = __ballot(eA), balB = __ballot(eB);
            const unsigned hA = half ? (unsigned)(balA >> 32) : (unsigned)balA, hB = half ? (unsigned)(balB >> 32) : (unsigned)balB;
            if (eA && befA + __popc(hA & below) < needA) mA[j >> 5] |= 1u << (j & 31);
            if (eB && befB + __popc(hB & below) < needB) mB[j >> 5] |= 1u << (j & 31);
            befA += __popc(hA); befB += __popc(hB);
        }
    }
#ifdef SELCHECK
    { unsigned mnA = 0xffffffffu, mxA = 0u, mnB = 0xffffffffu, mxB = 0u;
#pragma unroll
      for (int i = 0; i < 64; ++i) { const bool sa = (mA[i >> 5] >> (i & 31)) & 1u, sb = (mB[i >> 5] >> (i & 31)) & 1u;
          if (sa) mnA = min(mnA, kA[i]); else mxA = max(mxA, kA[i]); if (sb) mnB = min(mnB, kB[i]); else mxB = max(mxB, kB[i]); }
#pragma unroll
      for (int o = 1; o < 32; o <<= 1) { mnA = min(mnA, (unsigned)__shfl_xor((int)mnA, o)); mxA = max(mxA, (unsigned)__shfl_xor((int)mxA, o)); mnB = min(mnB, (unsigned)__shfl_xor((int)mnB, o)); mxB = max(mxB, (unsigned)__shfl_xor((int)mxB, o)); }
      const int csA = half_sum(__popc(mA[0]) + __popc(mA[1])), csB = half_sum(__popc(mB[0]) + __popc(mB[1]));
      const bool bad = csA != (nA < TOPK ? nA : TOPK) || csB != (nB < TOPK ? nB : TOPK) || mxA > mnA || mxB > mnB || mnA == 0u || mnB == 0u;
      if (bad) atomicOr((unsigned*)(F.ws + WS_CTL + 8192), 1u); }
#endif
    { const unsigned long long a64 = (((unsigned long long)mA[1] << 32) | mA[0]) >> sh, b64 = (((unsigned long long)mB[1] << 32) | mB[0]) >> sh;
      mA[0] = (unsigned)a64; mA[1] = (unsigned)(a64 >> 32); mB[0] = (unsigned)b64; mB[1] = (unsigned)(b64 >> 32); }
    mAo[0] = mA[0]; mAo[1] = mA[1]; mBo[0] = mB[0]; mBo[1] = mB[1];
}
__device__ __forceinline__ void attn_pass2(Frame& F, int b, int qb, LAS unsigned char* lds, unsigned (&mA)[2], unsigned (&mB)[2]) {
    int tid_ = threadIdx.x; asm volatile("" : "+v"(tid_), "+v"(mA[0]), "+v"(mA[1]), "+v"(mB[0]), "+v"(mB[1]));
    const int lane = tid_ & 63, w = __builtin_amdgcn_readfirstlane(tid_ >> 6), col = lane & 31, half = lane >> 5;
    const bf16_t* sm = (const bf16_t*)(F.ws + WS_SM);
    const size_t rowb = (size_t)b * SEQ; const int t0 = 32 * qb; const size_t m0w = rowb + t0 + 4 * w;
    const int nch = qb / 8 + 1;
    int offk[4];
#pragma unroll
    for (int ks = 0; ks < 4; ++ks) offk[ks] = col * 128 + ((((2 * ks + half) ^ ((col >> 1) & 7))) << 4);
    const bf16_t* qbuf = (const bf16_t*)(F.ws + WS_Q); const bf16_t* vt = (const bf16_t*)(F.ws + WS_VT); const bf16_t* az = (const bf16_t*)(F.ws + WS_AZ); bf16_t* yb = (bf16_t*)(F.ws + WS_YB);
    typedef unsigned long long u64;
    u64 mq[4];
    { const unsigned oa0 = __shfl_xor(mA[0], 32), oa1 = __shfl_xor(mA[1], 32), ob0 = __shfl_xor(mB[0], 32), ob1 = __shfl_xor(mB[1], 32);
      const u64 ownA = ((u64)mA[1] << 32) | mA[0], ownB = ((u64)mB[1] << 32) | mB[0], othA = ((u64)oa1 << 32) | oa0, othB = ((u64)ob1 << 32) | ob0;
      mq[0] = half ? othA : ownA; mq[1] = half ? othB : ownB; mq[2] = half ? ownA : othA; mq[3] = half ? ownB : othB; }
    const int qlc = col >> 3, hd = col & 7;
    bf16x8 bq[4];
#pragma unroll
    for (int ks = 0; ks < 4; ++ks) bq[ks] = *(const bf16x8*)(qbuf + (m0w + qlc) * 512 + hd * 64 + 16 * ks + 8 * half);
    const float cslope = exp2f(-(float)(hd + 1)) * 1.4426950408889634f;
    const unsigned c_hi = f2bf(cslope), c_lo = f2bf(cslope - bf2f((bf16_t)c_hi));
    float mref = cslope * (float)(t0 + 4 * w + qlc);
    u32x4 bau;
#define AT_MPIECES(mval) do { const float v_ = -(mval); const unsigned uh_ = __float_as_uint(v_) & 0xffff0000u; const float r_ = v_ - __uint_as_float(uh_); \
        const unsigned um_ = __float_as_uint(r_) & 0xffff0000u; const float r2_ = r_ - __uint_as_float(um_); bau.z = half ? ((uh_ >> 16) | um_) : 0u; bau.w = half ? (unsigned)f2bf(r2_) : 0u; } while (0)
    if (half) { bau.x = (unsigned)f2bf(16.f * bf2f((bf16_t)c_hi)) | ((unsigned)f2bf(16.f * bf2f((bf16_t)c_lo)) << 16); bau.y = c_hi | (c_lo << 16); }
    else { bau.x = (qlc == 0 ? 0x3f80u : 0u) | (qlc == 1 ? 0x3f800000u : 0u); bau.y = (qlc == 2 ? 0x3f80u : 0u) | (qlc == 3 ? 0x3f800000u : 0u); }
    AT_MPIECES(mref);
    const unsigned slo_b = __float_as_uint((float)(col & 15)) >> 16, slo2 = slo_b | (slo_b << 16);
    int offv[2][2];
#pragma unroll
    for (int dt = 0; dt < 2; ++dt)
#pragma unroll
        for (int s2 = 0; s2 < 2; ++s2) offv[dt][s2] = (32 * dt + col) * 64 + ((((2 * s2 + half) ^ ((col >> 2) & 3))) << 4);
    f32x16 oacc[2]; float lsum; bool anch;
    const f32x16 zero16 = {0.f, 0.f, 0.f, 0.f, 0.f, 0.f, 0.f, 0.f, 0.f, 0.f, 0.f, 0.f, 0.f, 0.f, 0.f, 0.f};
    unsigned vok[2], vov[4];
#pragma unroll
    for (int i_ = 0; i_ < 2; ++i_) vok[i_] = (unsigned)((lane >> 3) * 512 + 16 * ((lane & 7) ^ ((4 * i_ + (lane >> 4)) & 7)));
#pragma unroll
    for (int i_ = 0; i_ < 4; ++i_) { const int dd_ = 16 * i_ + (lane >> 2); vov[i_] = (unsigned)(dd_ * (SEQ * 2) + 16 * ((lane & 3) ^ ((dd_ >> 2) & 3))); }
#define AT_STAGE2(c, bufsel) do { _Pragma("unroll") for (int i_ = 0; i_ < 4; ++i_) { const int seg = 4 * w + i_; unsigned vo_ = vok[i_ & 1], vv_ = vov[i_]; asm volatile("" : "+v"(vo_), "+v"(vv_)); \
        __builtin_amdgcn_global_load_lds((const unsigned*)((const char*)sm + ((rowb + 256 * (c) + 8 * seg) * 256) * 2 + vo_), (LAS unsigned*)(lds + (bufsel) * 32768 + seg * 1024), 16, 0, 0); \
        __builtin_amdgcn_global_load_lds((const unsigned*)((const char*)vt + ((size_t)b * 64 * SEQ + 256 * (c) + 32 * w) * 2 + vv_), (LAS unsigned*)(lds + 65536 + (bufsel) * 32768 + seg * 1024), 16, 0, 0); } } while (0)
    for (int rep2_ = 0; rep2_ < REP_PASS2; ++rep2_) {
#pragma unroll
    for (int dt = 0; dt < 2; ++dt)
#pragma unroll
        for (int i = 0; i < 16; ++i) oacc[dt][i] = 0.f;
    lsum = 0.f; anch = false; mref = cslope * (float)(t0 + 4 * w + qlc); AT_MPIECES(mref);
    __syncthreads();
    AT_STAGE2(nch - 1, (nch - 1) & 1);
    asm volatile("s_waitcnt vmcnt(0)" ::: "memory"); __syncthreads();
    for (int c = nch - 1; c >= 0; --c) {
        if (c > 0) AT_STAGE2(c - 1, (c - 1) & 1);
        const LAS unsigned char* kimg = lds + (c & 1) * 32768; const LAS unsigned char* vimg = lds + 65536 + (c & 1) * 32768;
        for (int jj = 7; jj >= 0; --jj) { const int j = 8 * c + jj;
            if (j > qb) continue;
            bf16x8 ak[4];
#pragma unroll
            for (int ks = 0; ks < 4; ++ks) ak[ks] = *(const LAS bf16x8*)(kimg + jj * 4096 + offk[ks]);
            u32x4 aau;
            { const unsigned p0 = (unsigned)(~(mq[0] >> j) & 1ull) * 0xc700u, p1 = (unsigned)(~(mq[1] >> j) & 1ull) * 0xc700u, p2 = (unsigned)(~(mq[2] >> j) & 1ull) * 0xc700u, p3 = (unsigned)(~(mq[3] >> j) & 1ull) * 0xc700u;
              const unsigned shi_b = __float_as_uint((float)(2 * j + (col >> 4))) >> 16;
              aau.x = half ? (shi_b | (shi_b << 16)) : (p0 | (p1 << 16)); aau.y = half ? slo2 : (p2 | (p3 << 16)); aau.z = half ? 0x3f803f80u : 0u; aau.w = half ? 0x00003f80u : 0u; }
            f32x16 x = __builtin_amdgcn_mfma_f32_32x32x16_bf16(ak[0], bq[0], zero16, 0, 0, 0);
#pragma unroll
            for (int ks = 1; ks < 4; ++ks) x = __builtin_amdgcn_mfma_f32_32x32x16_bf16(ak[ks], bq[ks], x, 0, 0, 0);
            x = __builtin_amdgcn_mfma_f32_32x32x16_bf16(__builtin_bit_cast(bf16x8, aau), __builtin_bit_cast(bf16x8, bau), x, 0, 0, 0);
            asm volatile("s_nop 11" : "+v"(x));
            float lmax = max3f_(x[0], x[1], x[2]), lmx2 = max3f_(x[3], x[4], x[5]);
            lmax = max3f_(lmax, x[6], x[7]); lmx2 = max3f_(lmx2, x[8], x[9]); lmax = max3f_(lmax, x[10], x[11]); lmx2 = max3f_(lmx2, x[12], x[13]); lmax = max3f_(lmax, x[14], x[15]); lmax = max3f_(lmax, lmx2, lmx2);
            lmax = fmaxf(lmax, __shfl_xor(lmax, 32));
            const bool need = anch ? (lmax > 8.f) : (lmax > -30000.f);
            if (__any(need)) {
                const float dl = need ? lmax : 0.f, f = (need && anch) ? __builtin_amdgcn_exp2f(-dl) : 1.f;
                mref += dl; lsum *= f; anch = anch || need;
#pragma unroll
                for (int i = 0; i < 16; ++i) { x[i] -= dl; oacc[0][i] *= f; oacc[1][i] *= f; }
                AT_MPIECES(mref);
            }
            unsigned pw[8];
#pragma unroll
            for (int i = 0; i < 16; i += 2) { const float e0 = __builtin_amdgcn_exp2f(x[i]), e1 = __builtin_amdgcn_exp2f(x[i + 1]); lsum += e0 + e1; pw[i >> 1] = pk2(e0, e1); }
            const u32x4 pf0 = {pw[0], pw[1], pw[2], pw[3]}, pf1 = {pw[4], pw[5], pw[6], pw[7]};
#pragma unroll
            for (int dt = 0; dt < 2; ++dt) {
                const bf16x8 av0 = *(const LAS bf16x8*)(vimg + jj * 4096 + offv[dt][0]), av1 = *(const LAS bf16x8*)(vimg + jj * 4096 + offv[dt][1]);
                oacc[dt] = __builtin_amdgcn_mfma_f32_32x32x16_bf16(av0, __builtin_bit_cast(bf16x8, pf0), oacc[dt], 0, 0, 0);
                oacc[dt] = __builtin_amdgcn_mfma_f32_32x32x16_bf16(av1, __builtin_bit_cast(bf16x8, pf1), oacc[dt], 0, 0, 0); }
        }
        asm volatile("s_waitcnt vmcnt(0)" ::: "memory"); __syncthreads();
    }
    }
#undef AT_STAGE2
#undef AT_MPIECES
    { const float inv = __builtin_amdgcn_rcpf(lsum + __shfl_xor(lsum, 32)); const size_t mrow = (m0w + qlc) * 512 + hd * 64;
#pragma unroll
      for (int dt = 0; dt < 2; ++dt)
#pragma unroll
          for (int g4 = 0; g4 < 4; ++g4) { const int d0 = 32 * dt + 8 * g4 + 4 * half; const u32x2 zz = *(const u32x2*)(az + mrow + d0);
              const float y0 = oacc[dt][4 * g4 + 0] * inv * siluf_(bflo(zz.x)), y1 = oacc[dt][4 * g4 + 1] * inv * siluf_(bfhi(zz.x)), y2 = oacc[dt][4 * g4 + 2] * inv * siluf_(bflo(zz.y)), y3 = oacc[dt][4 * g4 + 3] * inv * siluf_(bfhi(zz.y));
              u32x2 o; o.x = pk2(y0, y1); o.y = pk2(y2, y3); *(u32x2*)(yb + mrow + d0) = o; } }
}
__device__ __forceinline__ void p2_attn(Frame& F) {
    const int b = F.vcu >> 4, r = F.vcu & 15;
    for (int i = 0; i < 4; ++i) { const int qb = (i == 0) ? r : (i == 1) ? 31 - r : (i == 2) ? 32 + r : 63 - r;
        unsigned mA[2], mB[2];
        attn_pass1_select(F, b, qb, F.lds + RING_OFF, mA, mB);
        attn_pass2(F, b, qb, F.lds + RING_OFF, mA, mB);
    }
}

__device__ __forceinline__ void p6_final(Frame& F) {
    float* out = F.out; const float* ssp2 = (const float*)(F.ws + WS_SSP2); const float* fg = F.in[14]; const bf16_t* x2b = (const bf16_t*)(F.ws + WS_X2B);
    int tid_ = threadIdx.x; asm volatile("" : "+v"(tid_));
    const int lane = tid_ & 63, gw = F.vcu * NWAVES + __builtin_amdgcn_readfirstlane(tid_ >> 6), NGW = F.G * NWAVES;
#ifdef SELCHECK
    const float poison = (*(volatile unsigned*)(F.ws + WS_CTL + 8192)) ? __builtin_nanf("") : 1.f;
#else
    const float poison = 1.f;
#endif
    for (int m = gw; m < M; m += NGW) { float s = (lane < 16) ? ssp2[(size_t)m * 16 + lane] : 0.f; s = wave_sum(s);
        const float r = rsqrtf(s * (1.f / D) + EPS) * poison; f32x4* o = (f32x4*)(out + (size_t)m * D); const u32x4* xi = (const u32x4*)(x2b + (size_t)m * D);
#pragma unroll
        for (int j = 0; j < 2; ++j) { const u32x4 xw = xi[lane + 64 * j]; const f32x4 g0 = ((const f32x4*)fg)[2 * (lane + 64 * j)], g1 = ((const f32x4*)fg)[2 * (lane + 64 * j) + 1];
            o[2 * (lane + 64 * j)] = (f32x4){bflo(xw.x), bfhi(xw.x), bflo(xw.y), bfhi(xw.y)} * r * g0; o[2 * (lane + 64 * j) + 1] = (f32x4){bflo(xw.z), bfhi(xw.z), bflo(xw.w), bfhi(xw.w)} * r * g1; } }
}

#ifndef REP_P0
#define REP_P0 1
#endif
#ifndef REP_P1
#define REP_P1 1
#endif
#ifndef REP_P2A
#define REP_P2A 1
#endif
#ifndef REP_P2B
#define REP_P2B 1
#endif
#ifndef REP_P4
#define REP_P4 1
#endif
struct Args { const float* in[15]; float* out; unsigned char* ws; };
__global__ void __launch_bounds__(NWAVES * 64, 2) fwd_kernel(Args args) {
    extern __shared__ __attribute__((aligned(16))) unsigned char lds_raw[];
    Frame F;
    F.lds = (LAS unsigned char*)lds_raw; F.MISC = (volatile LAS unsigned*)(F.lds + MISC_OFF);
    F.tid = threadIdx.x; F.lane = F.tid & 63; F.wave = __builtin_amdgcn_readfirstlane(F.tid >> 6);
    F.G = gridDim.x; { const int bx = blockIdx.x; F.vcu = (F.G % 8 == 0) ? (bx % 8) * (F.G / 8) + bx / 8 : bx; }
#pragma unroll
    for (int i = 0; i < 15; ++i) F.in[i] = args.in[i];
    F.out = args.out; F.ws = args.ws;
    unsigned char* ws = args.ws;
    for (int u = F.tid; u < (LDS_BYTES - LDSCTL_OFF) / 4; u += NWAVES * 64) ((LAS unsigned*)(F.lds + LDSCTL_OFF))[u] = 0u;
    __syncthreads();
    XcdBarrier bar = xcd_barrier_post((unsigned*)(ws + WS_CTL) + CW_BAR, F.MISC + 8);

    for (int rep_ = 0; rep_ < REP_P0; ++rep_) { p0_prep(F); if (rep_ + 1 < REP_P0) __syncthreads(); }
    xcd_barrier(bar);
    { pg8::Gemm g{(const bf16_t*)(ws + WS_XB), (const bf16_t*)(ws + WS_WIN), M, NINP, D}; pg8::StaticOrder S; S.init(M, NINP, F.G, (int)blockIdx.x);
      pg8::EpiInProj E{(const float*)(ws + WS_RINV), ws};
      for (int rep_ = 0; rep_ < REP_P1; ++rep_) pg8::gemm_phase<pg8::EpiInProj, pg8::StaticOrder, true, true>(F.lds + RING_OFF, g, S, E);
    }
    xcd_barrier(bar);
    for (int rep_ = 0; rep_ < REP_P2A; ++rep_) p2_conformer(F);
    for (int rep_ = 0; rep_ < REP_P2B; ++rep_) p2_attn(F);
    xcd_barrier(bar);
    { pg8::Gemm g{(const bf16_t*)(ws + WS_YA), (const bf16_t*)(ws + WS_WA), M, D, DC}; pg8::StaticOrder S; S.init(M, D, F.G, (int)blockIdx.x);
      pg8::EpiOutA E{(const bf16_t*)(ws + WS_GA), (bf16_t*)(ws + WS_PART)};
      pg8::gemm_phase<pg8::EpiOutA, pg8::StaticOrder, true, true>(F.lds + RING_OFF, g, S, E);
    }
    { pg8::Gemm g{(const bf16_t*)(ws + WS_YB), (const bf16_t*)(ws + WS_WB), M, D, DC}; pg8::StaticOrder S; S.init(M, D, F.G, (int)blockIdx.x);
      pg8::EpiOutB E{(const bf16_t*)(ws + WS_GB), (const bf16_t*)(ws + WS_PART), (bf16_t*)(ws + WS_MRG)};
      pg8::gemm_phase<pg8::EpiOutB, pg8::StaticOrder, true, true>(F.lds + RING_OFF, g, S, E);
    }
    xcd_barrier(bar);
    { pg8::Gemm g{(const bf16_t*)(ws + WS_MRG), (const bf16_t*)(ws + WS_WO), M, D, D}; pg8::StaticOrder S; S.init(M, D, F.G, (int)blockIdx.x);
      pg8::EpiWo E{F.in[0], (bf16_t*)(ws + WS_X1B), (float*)(ws + WS_SSP1)};
      for (int rep_ = 0; rep_ < REP_P4; ++rep_) pg8::gemm_phase<pg8::EpiWo, pg8::StaticOrder, true, true>(F.lds + RING_OFF, g, S, E);
    }
    xcd_barrier(bar);
    { pg8::Gemm g{(const bf16_t*)(ws + WS_PB), (const bf16_t*)(ws + WS_WP), M, D, DPLE}; pg8::StaticOrder S; S.init(M, D, F.G, (int)blockIdx.x);
      pg8::EpiPP E{(bf16_t*)(ws + WS_PP)};
      pg8::gemm_phase<pg8::EpiPP, pg8::StaticOrder, true, true>(F.lds + RING_OFF, g, S, E);
    }
    __builtin_amdgcn_sched_barrier(0); asm volatile("" ::: "memory");
    { pg8::Gemm g{(const bf16_t*)(ws + WS_X1B), (const bf16_t*)(ws + WS_WG), M, D, D}; pg8::StaticOrder S; S.init(M, D, F.G, (int)blockIdx.x);
      pg8::EpiGate E{(const bf16_t*)(ws + WS_X1B), (const bf16_t*)(ws + WS_PP), (bf16_t*)(ws + WS_X2B), (const float*)(ws + WS_SSP1), (float*)(ws + WS_SSP2)};
      pg8::gemm_phase<pg8::EpiGate, pg8::StaticOrder, true, true>(F.lds + RING_OFF, g, S, E);
    }
    xcd_barrier(bar);
    p6_final(F);
}

extern "C" void kernel_launch(void* const* d_in, const int* in_sizes, int n_in, void* d_out, int out_size, void* d_ws, size_t ws_size, hipStream_t stream) {
    static int grid = 0;
    if (grid == 0) {
        if (n_in != 15 || out_size != M * D || ws_size < WS_END) { fprintf(stderr, "kernel_launch: unexpected sizes n_in %d out %d ws %zu\n", n_in, out_size, ws_size); grid = -1; return; }
        int dev = 0, cus = 0, per_cu = 0;
        if (hipGetDevice(&dev) != hipSuccess || hipDeviceGetAttribute(&cus, hipDeviceAttributeMultiprocessorCount, dev) != hipSuccess) { grid = -1; return; }
        if (hipFuncSetAttribute((const void*)fwd_kernel, hipFuncAttributeMaxDynamicSharedMemorySize, LDS_BYTES) != hipSuccess) { fprintf(stderr, "kernel_launch: hipFuncSetAttribute failed\n"); grid = -1; return; }
        if (hipOccupancyMaxActiveBlocksPerMultiprocessor(&per_cu, (const void*)fwd_kernel, NWAVES * 64, LDS_BYTES) != hipSuccess || per_cu < 1) { fprintf(stderr, "kernel_launch: occupancy query reports %d blocks per CU\n", per_cu); (void)hipGetLastError(); grid = -1; return; }
        grid = cus;
        if (M % grid != 0 || grid % 8 != 0) { fprintf(stderr, "kernel_launch: unsupported CU count %d\n", grid); grid = -1; return; }
    }
    if (grid < 0) return;
    (void)hipMemsetAsync((char*)d_ws + WS_CTL, 0, CTL_ZERO_BYTES, stream);
    Args a{};
    for (int i = 0; i < 15; ++i) a.in[i] = (const float*)d_in[i];
    a.out = (float*)d_out; a.ws = (unsigned char*)d_ws;
    hipLaunchKernelGGL(fwd_kernel, dim3(grid), dim3(NWAVES * 64), LDS_BYTES, stream, a);
}
```
